# Optimizing an MI355X kernel written in HIP

```python
import math
import jax, jax.numpy as jnp
from jax import lax
import numpy as np

D_MODEL = 1024
BATCH = 2
SEQ = 8192
DEPTH = 1

CHUNK = 64
Q_BLOCK = 128
GDN_HEADS = 4
GDN_DK = 128
GDN_DV = 128
GDN_CONV = 4
DIFF_HEADS = 4
DIFF_DH = 64
N_EXPERTS = 256
TOP_K = 8
N_GROUPS = 8
TOPK_GROUPS = 4
EXPERT_FF = 256
SHARED_FF = 256
ROUTED_SCALE = 2.5
EXPERT_BLOCK = 128
NORM_EPS = 1e-6

GDN_QK = GDN_HEADS * GDN_DK
GDN_V = GDN_HEADS * GDN_DV
CONV_CH = 2 * GDN_QK + GDN_V
DIFF_QK = DIFF_HEADS * 2 * DIFF_DH
DIFF_V = DIFF_HEADS * 2 * DIFF_DH
IN_SPLITS = (GDN_QK, GDN_QK, GDN_V, GDN_V, GDN_HEADS, GDN_HEADS, DIFF_QK, DIFF_QK, DIFF_V, D_MODEL, D_MODEL)
IN_COLS = sum(IN_SPLITS)

kernel_name = "hybrid_gdn_diffattn_moe_block"


def rms_norm(x, gain):
    xf = x.astype(jnp.float32)
    y = xf * lax.rsqrt(jnp.mean(xf * xf, axis=-1, keepdims=True) + NORM_EPS)
    return (y * gain.astype(jnp.float32)).astype(x.dtype)


def l2_normalize(x):
    xf = x.astype(jnp.float32)
    return (xf * lax.rsqrt(jnp.sum(xf * xf, axis=-1, keepdims=True) + NORM_EPS)).astype(x.dtype)


def causal_depthwise_conv(x, w):
    taps = w.shape[0]
    return lax.conv_general_dilated(
        x, w[:, None, :].astype(x.dtype), window_strides=(1,), padding=[(taps - 1, 0)],
        dimension_numbers=("NWC", "WIO", "NWC"), feature_group_count=x.shape[-1])


def gated_delta_rule_chunked(q, k, v, g, beta):
    b, s, h, dk = q.shape
    dv = v.shape[-1]
    n = s // CHUNK
    f32 = jnp.float32

    def chunks(t):
        return t.astype(f32).reshape(b, n, CHUNK, h, -1).transpose(0, 3, 1, 2, 4)

    q, k, v = chunks(q), chunks(k), chunks(v)
    g = chunks(g[..., None])[..., 0]
    beta = chunks(beta[..., None])[..., 0]
    G = jnp.cumsum(g, axis=-1)
    ii = jnp.arange(CHUNK)
    causal = ii[:, None] >= ii[None, :]
    strict = ii[:, None] > ii[None, :]
    decay = jnp.exp(jnp.where(causal, G[..., :, None] - G[..., None, :], -jnp.inf))
    kk = jnp.einsum("bhnik,bhnjk->bhnij", k, k)
    lower = jnp.where(strict, beta[..., :, None] * kk * decay, 0.0)
    a_mat = jnp.eye(CHUNK, dtype=f32) + lower
    rhs = jnp.concatenate([v * beta[..., None], k * (beta * jnp.exp(G))[..., None]], axis=-1)
    sol = lax.linalg.triangular_solve(a_mat, rhs, left_side=True, lower=True, unit_diagonal=True)
    u, w = sol[..., :dv], sol[..., dv:]
    a_qk = jnp.einsum("bhnik,bhnjk->bhnij", q, k) * decay

    def step(state, inp):
        qc, kc, uc, wc, gc, ac = inp
        v_new = uc - jnp.einsum("bhck,bhkv->bhcv", wc, state)
        out = (jnp.einsum("bhck,bhkv->bhcv", qc * jnp.exp(gc)[..., None], state)
               + jnp.einsum("bhcj,bhjv->bhcv", ac, v_new))
        g_last = gc[..., -1:]
        state = (state * jnp.exp(g_last)[..., None]
                 + jnp.einsum("bhck,bhcv->bhkv", kc * jnp.exp(g_last - gc)[..., None], v_new))
        return state, out

    mv = lambda t: jnp.moveaxis(t, 2, 0)
    state0 = jnp.zeros((b, h, dk, dv), f32)
    _, o = lax.scan(step, state0, (mv(q), mv(k), mv(u), mv(w), mv(G), mv(a_qk)))
    return o.transpose(1, 0, 3, 2, 4).reshape(b, s, h, dv)


def differential_attention(q, k, v, lam):
    b, s, h, _, d = q.shape
    n_blocks = s // Q_BLOCK
    pos = jnp.arange(s)
    slopes = 2.0 ** (-8.0 * jnp.arange(1, h + 1, dtype=jnp.float32) / h)
    scale = d ** -0.5

    def one_block(bi):
        start = bi * Q_BLOCK
        qb = lax.dynamic_slice_in_dim(q, start, Q_BLOCK, axis=1)
        tq = start + jnp.arange(Q_BLOCK)
        sc = jnp.einsum("bqhcd,bkhcd->bhcqk", qb, k, preferred_element_type=jnp.float32) * scale
        dist = jnp.abs(tq[:, None] - pos[None, :]).astype(jnp.float32)
        allowed = (pos[None, :] // CHUNK) <= (tq[:, None] // CHUNK)
        sc = jnp.where(allowed, sc - slopes[:, None, None, None] * dist, -jnp.inf)
        p = jax.nn.softmax(sc, axis=-1)
        a = p[:, :, 0] - lam * p[:, :, 1]
        return jnp.einsum("bhqk,bkhe->bqhe", a.astype(v.dtype), v)

    o = lax.map(one_block, jnp.arange(n_blocks))
    return o.transpose(1, 0, 2, 3, 4).reshape(b, s, h, 2 * d)


def hybrid_mixer(h, w_in, conv_w, a_log, dt_bias, gdn_norm_g, w_o_gdn, q_norm_g, k_norm_g,
                 lambda_q1, lambda_k1, lambda_q2, lambda_k2, subln_g, w_o_diff, w_out, lam_init):
    b, s, _ = h.shape
    f32 = jnp.float32
    proj = jnp.einsum("bsd,de->bse", h, w_in)
    split_at = np.cumsum(IN_SPLITS)[:-1].tolist()
    (qa, ka, va, za, beta_lin, decay_lin, qb, kb, vb, gate_a, gate_b) = jnp.split(proj, split_at, axis=-1)

    qkv = jax.nn.silu(causal_depthwise_conv(jnp.concatenate([qa, ka, va], axis=-1), conv_w))
    qa, ka, va = jnp.split(qkv, [GDN_QK, 2 * GDN_QK], axis=-1)
    qa = l2_normalize(qa.reshape(b, s, GDN_HEADS, GDN_DK)) * (GDN_DK ** -0.5)
    ka = l2_normalize(ka.reshape(b, s, GDN_HEADS, GDN_DK))
    va = va.reshape(b, s, GDN_HEADS, GDN_DV)
    beta = jax.nn.sigmoid(beta_lin.astype(f32))
    log_decay = -jnp.exp(a_log.astype(f32)) * jax.nn.softplus(decay_lin.astype(f32) + dt_bias.astype(f32))
    oa = gated_delta_rule_chunked(qa, ka, va, log_decay, beta)
    oa = rms_norm(oa, gdn_norm_g) * jax.nn.silu(za.reshape(b, s, GDN_HEADS, GDN_DV).astype(f32))
    ya = jnp.einsum("bse,ed->bsd", oa.reshape(b, s, GDN_V).astype(h.dtype), w_o_gdn)

    qb = rms_norm(qb.reshape(b, s, DIFF_HEADS, 2, DIFF_DH), q_norm_g)
    kb = rms_norm(kb.reshape(b, s, DIFF_HEADS, 2, DIFF_DH), k_norm_g)
    vb = vb.reshape(b, s, DIFF_HEADS, 2 * DIFF_DH)
    lam = (jnp.exp(jnp.sum(lambda_q1.astype(f32) * lambda_k1.astype(f32)))
           - jnp.exp(jnp.sum(lambda_q2.astype(f32) * lambda_k2.astype(f32))) + lam_init)
    ob = differential_attention(qb, kb, vb, lam)
    ob = rms_norm(ob, subln_g) * (1.0 - lam_init)
    yb = jnp.einsum("bse,ed->bsd", ob.reshape(b, s, DIFF_V), w_o_diff)

    merged = jax.nn.sigmoid(gate_a) * ya + jax.nn.sigmoid(gate_b) * yb
    return jnp.einsum("bsd,de->bse", merged, w_out)


def moe_ffn(h, w_router, router_bias, w_gate_up, w_down, ws_gate_up, ws_down):
    b, s, d = h.shape
    t = b * s
    f32 = jnp.float32
    hf = h.reshape(t, d)
    scores = jax.nn.sigmoid(jnp.einsum("td,de->te", hf, w_router, preferred_element_type=f32))
    choice = scores + router_bias.astype(f32)
    per_group = N_EXPERTS // N_GROUPS
    group_score = lax.top_k(choice.reshape(t, N_GROUPS, per_group), 2)[0].sum(-1)
    _, top_groups = lax.top_k(group_score, TOPK_GROUPS)
    group_mask = jnp.any(top_groups[..., None] == jnp.arange(N_GROUPS), axis=-2)
    expert_mask = jnp.repeat(group_mask, per_group, axis=-1)
    _, top_idx = lax.top_k(jnp.where(expert_mask, choice, -jnp.inf), TOP_K)
    top_w = jnp.take_along_axis(scores, top_idx, axis=-1)
    top_w = top_w / jnp.sum(top_w, axis=-1, keepdims=True) * ROUTED_SCALE

    n_assign = t * TOP_K
    flat_e = top_idx.reshape(-1).astype(jnp.int32)
    flat_tok = jnp.repeat(jnp.arange(t, dtype=jnp.int32), TOP_K)
    flat_w = top_w.reshape(-1)
    order = jnp.argsort(flat_e)
    sorted_e = flat_e[order]
    counts = jax.ops.segment_sum(jnp.ones_like(flat_e), flat_e, num_segments=N_EXPERTS)
    padded = (counts + EXPERT_BLOCK - 1) // EXPERT_BLOCK * EXPERT_BLOCK
    starts = jnp.cumsum(counts) - counts
    padded_ends = jnp.cumsum(padded)
    padded_starts = padded_ends - padded
    dest = padded_starts[sorted_e] + jnp.arange(n_assign, dtype=jnp.int32) - starts[sorted_e]
    n_blocks = -(-n_assign // EXPERT_BLOCK) + N_EXPERTS
    rows = n_blocks * EXPERT_BLOCK
    row_tok = jnp.zeros((rows,), jnp.int32).at[dest].set(flat_tok[order])
    row_w = jnp.zeros((rows,), f32).at[dest].set(flat_w[order])
    block_e = jnp.minimum(
        jnp.searchsorted(padded_ends, jnp.arange(n_blocks, dtype=jnp.int32) * EXPERT_BLOCK, side="right"),
        N_EXPERTS - 1)

    def expert_block(acc, blk):
        tok, wt, e = blk
        xb = hf[tok]
        gate, up = jnp.split(xb @ w_gate_up[e], 2, axis=-1)
        yb = (jax.nn.silu(gate) * up) @ w_down[e]
        return acc.at[tok].add(yb.astype(f32) * wt[:, None]), None

    routed, _ = lax.scan(expert_block, jnp.zeros((t, d), f32),
                         (row_tok.reshape(n_blocks, EXPERT_BLOCK), row_w.reshape(n_blocks, EXPERT_BLOCK), block_e))
    sg, su = jnp.split(hf @ ws_gate_up, 2, axis=-1)
    shared = (jax.nn.silu(sg) * su) @ ws_down
    return (routed + shared.astype(f32)).astype(h.dtype).reshape(b, s, d)


def setup_inputs(seed: int = 0) -> dict:
    key = jax.random.key(seed)
    ks = jax.random.split(key, 32)
    f32 = jnp.float32
    L = DEPTH

    def normal(k, shape, scale):
        return jax.random.normal(k, shape, f32) * scale

    def gain(k, shape):
        return 1.0 + 0.01 * jax.random.normal(k, shape, f32)

    dt = jnp.exp(jax.random.uniform(ks[8], (L, GDN_HEADS), f32, minval=math.log(1e-3), maxval=math.log(1e-1)))
    return {
        "x": normal(ks[0], (BATCH, SEQ, D_MODEL), 1.0),
        "c": normal(ks[1], (BATCH, D_MODEL), 1.0),
        "w_ada": normal(ks[2], (L, D_MODEL, 6 * D_MODEL), 0.5 * D_MODEL ** -0.5),
        "b_ada": normal(ks[3], (L, 6 * D_MODEL), 0.01),
        "norm1_g": gain(ks[4], (L, D_MODEL)),
        "w_in": normal(ks[5], (L, D_MODEL, IN_COLS), D_MODEL ** -0.5),
        "conv_w": normal(ks[6], (L, GDN_CONV, CONV_CH), GDN_CONV ** -0.5),
        "a_log": jnp.log(jax.random.uniform(ks[7], (L, GDN_HEADS), f32, minval=1.0, maxval=16.0)),
        "dt_bias": dt + jnp.log(-jnp.expm1(-dt)),
        "gdn_norm_g": gain(ks[9], (L, GDN_DV)),
        "w_o_gdn": normal(ks[10], (L, GDN_V, D_MODEL), GDN_V ** -0.5),
        "q_norm_g": gain(ks[11], (L, DIFF_DH)),
        "k_norm_g": gain(ks[12], (L, DIFF_DH)),
        "lambda_q1": normal(ks[13], (L, DIFF_DH), 0.1),
        "lambda_k1": normal(ks[14], (L, DIFF_DH), 0.1),
        "lambda_q2": normal(ks[15], (L, DIFF_DH), 0.1),
        "lambda_k2": normal(ks[16], (L, DIFF_DH), 0.1),
        "subln_g": gain(ks[17], (L, 2 * DIFF_DH)),
        "w_o_diff": normal(ks[18], (L, DIFF_V, D_MODEL), DIFF_V ** -0.5),
        "w_out": normal(ks[19], (L, D_MODEL, D_MODEL), D_MODEL ** -0.5),
        "norm2_g": gain(ks[20], (L, D_MODEL)),
        "w_router": normal(ks[21], (L, D_MODEL, N_EXPERTS), D_MODEL ** -0.5),
        "router_bias": normal(ks[22], (L, N_EXPERTS), 0.01),
        "w_exp_gate_up": normal(ks[23], (L, N_EXPERTS, D_MODEL, 2 * EXPERT_FF), D_MODEL ** -0.5),
        "w_exp_down": normal(ks[24], (L, N_EXPERTS, EXPERT_FF, D_MODEL), EXPERT_FF ** -0.5),
        "w_shared_gate_up": normal(ks[25], (L, D_MODEL, 2 * SHARED_FF), D_MODEL ** -0.5),
        "w_shared_down": normal(ks[26], (L, SHARED_FF, D_MODEL), SHARED_FF ** -0.5),
    }


def reference(x, c, w_ada, b_ada, norm1_g, w_in, conv_w, a_log, dt_bias, gdn_norm_g, w_o_gdn,
              q_norm_g, k_norm_g, lambda_q1, lambda_k1, lambda_q2, lambda_k2, subln_g, w_o_diff,
              w_out, norm2_g, w_router, router_bias, w_exp_gate_up, w_exp_down,
              w_shared_gate_up, w_shared_down):
    for layer in range(DEPTH):
        mod = jnp.einsum("bd,de->be", jax.nn.silu(c), w_ada[layer]) + b_ada[layer]
        shift1, scale1, gate1, shift2, scale2, gate2 = jnp.split(mod[:, None, :], 6, axis=-1)
        lam_init = 0.8 - 0.6 * math.exp(-0.3 * layer)

        h = rms_norm(x, norm1_g[layer]) * (1.0 + scale1) + shift1
        y = hybrid_mixer(h, w_in[layer], conv_w[layer], a_log[layer], dt_bias[layer], gdn_norm_g[layer],
                         w_o_gdn[layer], q_norm_g[layer], k_norm_g[layer], lambda_q1[layer], lambda_k1[layer],
                         lambda_q2[layer], lambda_k2[layer], subln_g[layer], w_o_diff[layer], w_out[layer],
                         lam_init)
        x = x + gate1 * y

        h = rms_norm(x, norm2_g[layer]) * (1.0 + scale2) + shift2
        y = moe_ffn(h, w_router[layer], router_bias[layer], w_exp_gate_up[layer], w_exp_down[layer],
                    w_shared_gate_up[layer], w_shared_down[layer])
        x = x + gate2 * y
    return x
```

```cpp
#include <hip/hip_runtime.h>
#include <stdint.h>
#include <cstdio>

typedef unsigned short bf16_t;
constexpr int D = 1024, NB = 2, S = 8192, T = NB * S;
constexpr int INC = 5640;
constexpr int LDP = 5632;
constexpr int C_QA = 0, C_KA = 512, C_VA = 1024, C_ZA = 1536, C_QB = 2048, C_KB = 2560, C_VB = 3072, C_GA = 3584, C_GB = 4608;
constexpr int NE = 256, TOPK = 8, NA = T * TOPK;
constexpr float EPS = 1e-6f;
constexpr float LAM_INIT = 0.2f;
__device__ __forceinline__ float bf2f(bf16_t v) { return __uint_as_float(((unsigned)v) << 16); }
__device__ __forceinline__ float siluf(float x) { return x / (1.f + __expf(-x)); }
__device__ __forceinline__ float sigmf(float x) { return 1.f / (1.f + __expf(-x)); }
__device__ __forceinline__ float softplusf(float x) { return x > 20.f ? x : log1pf(__expf(x)); }
__device__ __forceinline__ float wave_sum(float v) {
#pragma unroll
  for (int o = 1; o < 64; o <<= 1) v += __shfl_xor(v, o);
  return v;
}
constexpr size_t MiB = 1u << 20;
constexpr size_t WS_CTL = 0, CTL_ZERO_BYTES = 1 * MiB;
constexpr size_t WS_MODP = 1 * MiB;
constexpr size_t WS_MOD = 1 * MiB + 256 * 1024;
constexpr size_t WS_SCAL = 1 * MiB + 320 * 1024;
constexpr size_t WS_WIN = 2 * MiB;
constexpr size_t WS_WOA = 13 * MiB, WS_WOB = 14 * MiB;
constexpr size_t WS_WOUT = 15 * MiB;
constexpr size_t WS_W9 = 17 * MiB;
constexpr size_t WS_WSD = 19 * MiB;
constexpr size_t WS_BD = 20 * MiB;
constexpr size_t WS_H = 32 * MiB;
constexpr size_t WS_P = 64 * MiB;
constexpr size_t WS_OAN = 240 * MiB, WS_OBN = 256 * MiB;
constexpr size_t WS_TMPB = 272 * MiB;
constexpr size_t WS_MERGED = 304 * MiB;
constexpr size_t WS_X1 = 336 * MiB;
constexpr size_t WS_LOGITS = 400 * MiB;
constexpr size_t WS_SACT = 416 * MiB;
constexpr size_t WS_TOPI = 424 * MiB, WS_TOPW = 425 * MiB;
constexpr size_t WS_Y = 432 * MiB;
constexpr size_t WS_ACTB = 704 * MiB;
constexpr size_t WS_LIST = 768 * MiB;
constexpr size_t WS_QN = 800 * MiB, WS_KN = 816 * MiB;
constexpr size_t WS_OB = 832 * MiB;
constexpr size_t WS_OA = 864 * MiB;
constexpr size_t WS_GDN = 896 * MiB;
constexpr size_t WS_END = 992 * MiB;
constexpr int CW_BAR = 4096;

#define GAS __attribute__((address_space(1)))
#define LAS __attribute__((address_space(3)))
typedef unsigned v4u __attribute__((ext_vector_type(4)));
typedef float f32x4 __attribute__((ext_vector_type(4)));
typedef short bf16x8 __attribute__((ext_vector_type(8)));
typedef GAS unsigned gu32;
typedef GAS unsigned long long gu64;
#define RLX_AGENT __ATOMIC_RELAXED, __HIP_MEMORY_SCOPE_AGENT
#define LDS_WAIT() asm volatile("s_waitcnt lgkmcnt(0)" ::: "memory")
#define VM_WAIT() asm volatile("s_waitcnt vmcnt(0)" ::: "memory")
__device__ __forceinline__ unsigned f2bf(float f) { unsigned u = __builtin_bit_cast(unsigned, f); return (u + 0x7fffu + ((u >> 16) & 1u)) >> 16; }
__device__ __forceinline__ unsigned pk2(float lo, float hi) { return f2bf(lo) | (f2bf(hi) << 16); }

constexpr int NWAVES = 8;
constexpr int LDS_BYTES = 147456;
constexpr int MISC_OFF = 131072 + 320;

struct Frame {
    LAS unsigned char* lds;
    volatile LAS unsigned* MISC;
    int tid, lane, wave, vcu, G;
    float* out; unsigned char* ws;
};
struct Args { const float* in[27]; float* out; unsigned char* ws; int ph_lo, ph_hi; };
namespace pg8 {
#define PG8_LAS __attribute__((address_space(3)))
typedef unsigned short bf16_t;
typedef short bf16x8 __attribute__((ext_vector_type(8)));
typedef float f32x4 __attribute__((ext_vector_type(4)));
typedef unsigned u32x4 __attribute__((ext_vector_type(4)));
constexpr int BM = 256, BK = 64, HALF = 128, HTB = HALF * BK * 2  , STAGE_BYTES = 8 * HTB, NXCD = 8, WGM = 8;

__host__ __device__ __forceinline__ int lds_byte(int r, int c) { const int st = (r >> 4) * 2 + (c >> 5), rr = r & 15, cc = c & 31, ob = rr * 64 + cc * 2; return st * 1024 + (ob ^ (((ob >> 9) & 1) << 5)); }
__host__ __device__ __forceinline__ void stage_rc(int b, int& R, int& C) { const int st = b / 1024, sb = b % 1024, swz = sb ^ (((sb >> 9) & 1) << 5); R = (st >> 1) * 16 + swz / 64; C = (st & 1) * 32 + (swz % 64) / 2; }
__host__ __device__ __forceinline__ int perm32(int rho) { const int n = rho >> 4, i = rho & 15; return 8 * (i >> 2) + 4 * n + (i & 3); }

struct Unit { int pm, pn; };
struct Gemm { const bf16_t* A; const bf16_t* Bt; int M, N, K; };

struct StaticOrder {
    int nM, nN, nwg, G, c;
    __host__ __device__ void init(int M, int N, int G_, int c_) { nM = M / BM; nN = N / BM; nwg = nM * nN; G = G_; c = c_; }
    __host__ __device__ bool next(int i, Unit& u) const {
        const long L = (long)i * G + c; if (L >= nwg) return false;
        int wgid = (int)L; { const int q = nwg / NXCD, r = nwg % NXCD, xcd = wgid % NXCD, off = wgid / NXCD; wgid = (xcd < r ? xcd * (q + 1) : r * (q + 1) + (xcd - r) * q) + off; }
        const int nig = WGM * nN, gid = wgid / nig, fm = gid * WGM, gsz = (nM - fm) < WGM ? (nM - fm) : WGM;
        u.pm = fm + ((wgid % nig) % gsz); u.pn = (wgid % nig) / gsz; return true;
    }
    __device__ __forceinline__ void a_ready(const Unit&) const {}
    __device__ __forceinline__ void done(const Unit&) const {}
};

__device__ __forceinline__ unsigned cvt_pk_bf16(float lo, float hi) { unsigned r; asm volatile("v_cvt_pk_bf16_f32 %0, %1, %2" : "=v"(r) : "v"(lo), "v"(hi)); return r; }
typedef float f32x2 __attribute__((ext_vector_type(2)));
template <class Epi, class Sched, bool ALIGN_EPI = false, bool SP2 = false>
__device__ __forceinline__ void gemm_phase(PG8_LAS unsigned char* lds, const Gemm g, const Sched& S, const Epi& E) {
    const int tid = threadIdx.x, wid = __builtin_amdgcn_readfirstlane(tid >> 6), lane = tid & 63, wr = wid >> 2, wc = wid & 3, fr = lane & 15, fq = lane >> 4;
    const int K = g.K, nt = K / BK;
    unsigned voffA[2], voffB[2];
#pragma unroll
    for (int i = 0; i < 2; ++i) { int R, C; stage_rc(tid * 16 + i * 8192, R, C); const int Rb = Epi::PERM ? ((R & ~31) + perm32(R & 31)) : R;
        voffA[i] = (unsigned)(R * K + C) * 2u; voffB[i] = (unsigned)(Rb * K + C) * 2u; }
    const size_t kstep = (size_t)(BK * 2);
    const size_t hstep = (size_t)HALF * K * 2;
    const size_t tstep = 2 * hstep;
    const unsigned ldsw = (unsigned)wid * 1024u;
    const int aoff = lds_byte(wr * 64 + fr, fq * 8), boff = lds_byte(wc * 32 + fr, fq * 8);
#define PG8_SA(b, h) (((b) * 2 + (h)) * HTB)
#define PG8_SB(b, h) ((4 + (b) * 2 + (h)) * HTB)
#define PG8_STAGE(bufoff, gbase, voff) do { _Pragma("unroll") for (int _i = 0; _i < 2; ++_i) \
        __builtin_amdgcn_global_load_lds((const unsigned*)((const char*)(gbase) + (voff)[_i]), (PG8_LAS unsigned*)(lds + (bufoff) + ldsw + _i * 8192), 16, 0, 0); } while (0)
#define PG8_LDA(dst, b, h) do { _Pragma("unroll") for (int m = 0; m < 4; ++m) _Pragma("unroll") for (int k = 0; k < 2; ++k) dst[m][k] = *(const PG8_LAS bf16x8*)(lds + PG8_SA(b, h) + aoff + m * 2048 + k * 1024); } while (0)
#define PG8_LDB(dst, b, h) do { _Pragma("unroll") for (int n = 0; n < 2; ++n) _Pragma("unroll") for (int k = 0; k < 2; ++k) dst[n][k] = *(const PG8_LAS bf16x8*)(lds + PG8_SB(b, h) + boff + n * 2048 + k * 1024); } while (0)
#define PG8_MMA(ai, bj, At, Bt) do { __builtin_amdgcn_s_setprio(1); _Pragma("unroll") for (int m = 0; m < 4; ++m) _Pragma("unroll") for (int n = 0; n < 2; ++n) _Pragma("unroll") for (int k = 0; k < 2; ++k) \
        acc[ai][bj][m][n] = __builtin_amdgcn_mfma_f32_16x16x32_bf16(Bt[n][k], At[m][k], acc[ai][bj][m][n], 0, 0, 0); __builtin_amdgcn_s_setprio(0); } while (0)
#define PG8_WAIT_V(n) asm volatile("s_waitcnt vmcnt(" #n ")" ::: "memory")
#define PG8_WAIT_L(n) asm volatile("s_waitcnt lgkmcnt(" #n ")" ::: "memory")
#define PG8_BAR __builtin_amdgcn_s_barrier()
#define PG8_SCHED __builtin_amdgcn_sched_barrier(0)
    Unit cur, nxt; int ui = 0;
    if (!S.next(0, cur)) return;
    f32x4 acc[2][2][4][2];
#pragma unroll
    for (int a = 0; a < 2; ++a)
#pragma unroll
        for (int b = 0; b < 2; ++b)
#pragma unroll
            for (int m = 0; m < 4; ++m)
#pragma unroll
                for (int n = 0; n < 2; ++n) acc[a][b][m][n] = (f32x4){0.f, 0.f, 0.f, 0.f};
    bf16x8 At[4][2], B0[2][2], B1[2][2];
    const char* cA = (const char*)g.A + (size_t)cur.pm * tstep; const char* cB = (const char*)g.Bt + (size_t)cur.pn * tstep;
    S.a_ready(cur);
    if constexpr (SP2) {
        PG8_STAGE(PG8_SB(0, 0), cB, voffB); PG8_STAGE(PG8_SB(0, 1), cB + hstep, voffB); PG8_STAGE(PG8_SA(0, 0), cA, voffA); PG8_STAGE(PG8_SA(0, 1), cA + hstep, voffA);
        if (wr == 1) PG8_BAR;
        PG8_WAIT_V(2); PG8_BAR;
        PG8_STAGE(PG8_SB(1, 0), cB + kstep, voffB); PG8_STAGE(PG8_SA(1, 0), cA + kstep, voffA); PG8_STAGE(PG8_SB(1, 1), cB + hstep + kstep, voffB);
        PG8_WAIT_V(6); PG8_BAR;
    } else {
        PG8_STAGE(PG8_SB(0, 0), cB, voffB); PG8_STAGE(PG8_SA(0, 0), cA, voffA); PG8_STAGE(PG8_SB(0, 1), cB + hstep, voffB); PG8_STAGE(PG8_SA(0, 1), cA + hstep, voffA);
        if (wr == 1) PG8_BAR;
        PG8_WAIT_V(4); PG8_BAR;
        PG8_STAGE(PG8_SB(1, 0), cB + kstep, voffB); PG8_STAGE(PG8_SA(1, 0), cA + kstep, voffA); PG8_STAGE(PG8_SB(1, 1), cB + hstep + kstep, voffB);
        PG8_WAIT_V(6); PG8_BAR;
    }
    for (;;) {
        const bool has_next = S.next(ui + 1, nxt);
        const char* nA = has_next ? (const char*)g.A + (size_t)nxt.pm * tstep : cA; const char* nB = has_next ? (const char*)g.Bt + (size_t)nxt.pn * tstep : cB;
        for (int t = 0; t < nt; t += 2) {
            const bool last = (t == nt - 2);
            const char* a1 = cA + (size_t)(t + 1) * kstep;
            const char* a2 = last ? nA : cA + (size_t)(t + 2) * kstep; const char* b2 = last ? nB : cB + (size_t)(t + 2) * kstep;
            const char* a3 = a2 + kstep; const char* b3 = b2 + kstep;
            if (last && has_next) S.a_ready(nxt);
            if constexpr (SP2) {
            PG8_LDB(B0, 0, 0); PG8_LDB(B1, 0, 1); PG8_SCHED; PG8_LDA(At, 0, 0); PG8_STAGE(PG8_SA(1, 1), a1 + hstep, voffA);
            PG8_WAIT_V(8); PG8_WAIT_L(0); PG8_BAR; PG8_MMA(0, 0, At, B0); PG8_MMA(0, 1, At, B1); PG8_BAR; PG8_SCHED;
            PG8_LDA(At, 0, 1); PG8_STAGE(PG8_SB(0, 0), b2, voffB); PG8_STAGE(PG8_SB(0, 1), b2 + hstep, voffB); PG8_STAGE(PG8_SA(0, 0), a2, voffA);
            PG8_WAIT_V(8); PG8_WAIT_L(0); PG8_BAR; PG8_MMA(1, 0, At, B0); PG8_MMA(1, 1, At, B1); PG8_BAR; PG8_SCHED;
            PG8_LDB(B0, 1, 0); PG8_LDB(B1, 1, 1); PG8_SCHED; PG8_LDA(At, 1, 0); PG8_STAGE(PG8_SA(0, 1), a2 + hstep, voffA);
            PG8_WAIT_V(8); PG8_WAIT_L(0); PG8_BAR; PG8_MMA(0, 0, At, B0); PG8_MMA(0, 1, At, B1); PG8_BAR; PG8_SCHED;
            PG8_LDA(At, 1, 1); PG8_STAGE(PG8_SB(1, 0), b3, voffB); PG8_STAGE(PG8_SB(1, 1), b3 + hstep, voffB); PG8_STAGE(PG8_SA(1, 0), a3, voffA);
            PG8_WAIT_V(8); PG8_WAIT_L(0); PG8_BAR; PG8_MMA(1, 0, At, B0); PG8_MMA(1, 1, At, B1); PG8_BAR; PG8_SCHED;
            } else {
            PG8_LDB(B0, 0, 0); PG8_SCHED; PG8_LDA(At, 0, 0); PG8_STAGE(PG8_SA(1, 1), a1 + hstep, voffA);
            PG8_WAIT_L(8); PG8_BAR; PG8_WAIT_L(0); PG8_MMA(0, 0, At, B0); PG8_BAR; PG8_SCHED;
            PG8_LDB(B1, 0, 1); PG8_STAGE(PG8_SB(0, 0), b2, voffB);
            PG8_BAR; PG8_WAIT_L(0); PG8_MMA(0, 1, At, B1); PG8_BAR;
            PG8_LDA(At, 0, 1); PG8_STAGE(PG8_SA(0, 0), a2, voffA);
            PG8_BAR; PG8_WAIT_L(0); PG8_MMA(1, 0, At, B0); PG8_BAR; PG8_SCHED;
            PG8_STAGE(PG8_SB(0, 1), b2 + hstep, voffB);
            PG8_WAIT_V(6); PG8_BAR; PG8_MMA(1, 1, At, B1); PG8_BAR;
            PG8_LDB(B0, 1, 0); PG8_SCHED; PG8_LDA(At, 1, 0); PG8_STAGE(PG8_SA(0, 1), a2 + hstep, voffA);
            PG8_WAIT_L(8); PG8_BAR; PG8_WAIT_L(0); PG8_MMA(0, 0, At, B0); PG8_BAR; PG8_SCHED;
            PG8_LDB(B1, 1, 1); PG8_STAGE(PG8_SB(1, 0), b3, voffB);
            PG8_BAR; PG8_WAIT_L(0); PG8_MMA(0, 1, At, B1); PG8_BAR;
            PG8_LDA(At, 1, 1); PG8_STAGE(PG8_SA(1, 0), a3, voffA);
            PG8_BAR; PG8_WAIT_L(0); PG8_MMA(1, 0, At, B0); PG8_BAR; PG8_SCHED;
            PG8_STAGE(PG8_SB(1, 1), b3 + hstep, voffB);
            PG8_WAIT_V(6); PG8_BAR; PG8_MMA(1, 1, At, B1); PG8_BAR;
            }
        }
        if constexpr (ALIGN_EPI) { if (wr == 0) PG8_BAR; }
        if constexpr (!Epi::AFTER_DRAIN) { E(acc, cur, wr, wc, fr, fq); S.done(cur); }
        if (!has_next) break;
#pragma unroll
        for (int a = 0; a < 2; ++a)
#pragma unroll
            for (int b = 0; b < 2; ++b)
#pragma unroll
                for (int m = 0; m < 4; ++m)
#pragma unroll
                    for (int n = 0; n < 2; ++n) acc[a][b][m][n] = (f32x4){0.f, 0.f, 0.f, 0.f};
        cur = nxt; cA = nA; cB = nB; ++ui;
        if constexpr (ALIGN_EPI) { if (wr == 1) PG8_BAR; }
    }
    PG8_WAIT_V(0);
    if constexpr (!ALIGN_EPI) { if (wr == 0) PG8_BAR; }
    PG8_BAR;
    if constexpr (Epi::AFTER_DRAIN) { E.fused(acc, cur, wr, wc, fr, fq, lds, wid, lane); S.done(cur); }
#undef PG8_SA
#undef PG8_SB
#undef PG8_STAGE
#undef PG8_LDA
#undef PG8_LDB
#undef PG8_MMA
#undef PG8_WAIT_V
#undef PG8_WAIT_L
#undef PG8_BAR
#undef PG8_SCHED
}
}
namespace pg8 {
struct EpiStoreBf16 {
    static constexpr bool PERM = true, AFTER_DRAIN = false;
    bf16_t* O; int ldc; int pad;
    __device__ __forceinline__ void operator()(const f32x4 (&acc)[2][2][4][2], const Unit& u, int wr, int wc, int fr, int fq) const {
        const int row0 = u.pm * BM + wr * 64 + fr, col0 = u.pn * BM + wc * 32 + 8 * fq;
#pragma unroll
        for (int ai = 0; ai < 2; ++ai)
#pragma unroll
            for (int m = 0; m < 4; ++m) { bf16_t* rowp = O + (size_t)(row0 + ai * HALF + m * 16) * ldc + col0;
#pragma unroll
                for (int bj = 0; bj < 2; ++bj) { const f32x4 v0 = acc[ai][bj][m][0], v1 = acc[ai][bj][m][1];
                    u32x4 w; w.x = cvt_pk_bf16(v0[0], v0[1]); w.y = cvt_pk_bf16(v0[2], v0[3]); w.z = cvt_pk_bf16(v1[0], v1[1]); w.w = cvt_pk_bf16(v1[2], v1[3]);
                    *(u32x4*)(rowp + bj * HALF) = w; } }
    }
};
__device__ __forceinline__ float bflo(unsigned w) { return __uint_as_float(w << 16); }
__device__ __forceinline__ float bfhi(unsigned w) { return __uint_as_float(w & 0xffff0000u); }
__device__ __forceinline__ float sigm(float x) { return __builtin_amdgcn_rcpf(1.f + __expf(-x)); }
template <bool ADD> struct EpiGate {
    static constexpr bool PERM = true, AFTER_DRAIN = false;
    const bf16_t* gate; const bf16_t* prev; bf16_t* O; int ldg; int pad;
    __device__ __forceinline__ void operator()(const f32x4 (&acc)[2][2][4][2], const Unit& u, int wr, int wc, int fr, int fq) const {
        const int row0 = u.pm * BM + wr * 64 + fr, col0 = u.pn * BM + wc * 32 + 8 * fq;
#pragma unroll
        for (int ai = 0; ai < 2; ++ai)
#pragma unroll
            for (int m = 0; m < 4; ++m) { const size_t r = (size_t)(row0 + ai * HALF + m * 16);
#pragma unroll
                for (int bj = 0; bj < 2; ++bj) { const int c = col0 + bj * HALF;
                    const u32x4 gw = *(const u32x4*)(gate + r * ldg + c);
                    const f32x4 v0 = acc[ai][bj][m][0], v1 = acc[ai][bj][m][1];
                    float o[8];
                    o[0] = sigm(bflo(gw.x)) * v0[0]; o[1] = sigm(bfhi(gw.x)) * v0[1]; o[2] = sigm(bflo(gw.y)) * v0[2]; o[3] = sigm(bfhi(gw.y)) * v0[3];
                    o[4] = sigm(bflo(gw.z)) * v1[0]; o[5] = sigm(bfhi(gw.z)) * v1[1]; o[6] = sigm(bflo(gw.w)) * v1[2]; o[7] = sigm(bfhi(gw.w)) * v1[3];
                    if (ADD) { const u32x4 pw = *(const u32x4*)(prev + r * 1024 + c);
                        o[0] += bflo(pw.x); o[1] += bfhi(pw.x); o[2] += bflo(pw.y); o[3] += bfhi(pw.y); o[4] += bflo(pw.z); o[5] += bfhi(pw.z); o[6] += bflo(pw.w); o[7] += bfhi(pw.w); }
                    u32x4 w; w.x = cvt_pk_bf16(o[0], o[1]); w.y = cvt_pk_bf16(o[2], o[3]); w.z = cvt_pk_bf16(o[4], o[5]); w.w = cvt_pk_bf16(o[6], o[7]);
                    *(u32x4*)(O + r * 1024 + c) = w; } }
    }
};
struct EpiResid {
    static constexpr bool PERM = false, AFTER_DRAIN = false;
    const float* base; const float* gvec; float* out;
    __device__ __forceinline__ void operator()(const f32x4 (&acc)[2][2][4][2], const Unit& u, int wr, int wc, int fr, int fq) const {
        const int row0 = u.pm * BM + wr * 64 + fr, col0 = u.pn * BM + wc * 32 + 4 * fq;
        const float* gv = gvec + ((u.pm * BM) / 8192) * 6144;
#pragma unroll
        for (int bj = 0; bj < 2; ++bj)
#pragma unroll
            for (int n = 0; n < 2; ++n) { const int c = col0 + bj * HALF + n * 16; const f32x4 g = *(const f32x4*)(gv + c);
#pragma unroll
                for (int ai = 0; ai < 2; ++ai)
#pragma unroll
                    for (int m = 0; m < 4; ++m) { const size_t off = (size_t)(row0 + ai * HALF + m * 16) * 1024 + c;
                        const f32x4 b = *(const f32x4*)(base + off); *(f32x4*)(out + off) = b + g * acc[ai][bj][m][n]; } }
    }
};
struct EpiSharedRouter {
    static constexpr bool PERM = true, AFTER_DRAIN = false;
    bf16_t* sact; float* logits;
    __device__ __forceinline__ void operator()(const f32x4 (&acc)[2][2][4][2], const Unit& u, int wr, int wc, int fr, int fq) const {
        const int row0 = u.pm * BM + wr * 64 + fr;
        if (u.pn < 2) {
#pragma unroll
            for (int ai = 0; ai < 2; ++ai)
#pragma unroll
                for (int m = 0; m < 4; ++m) { const size_t r = (size_t)(row0 + ai * HALF + m * 16);
#pragma unroll
                    for (int bj = 0; bj < 2; ++bj) { const int c8 = (u.pn * BM + bj * HALF + wc * 32 + 8 * fq) >> 1;
                        const f32x4 g = acc[ai][bj][m][0], up = acc[ai][bj][m][1];
                        float a0 = g[0] * sigm(g[0]) * up[0], a1 = g[1] * sigm(g[1]) * up[1], a2 = g[2] * sigm(g[2]) * up[2], a3 = g[3] * sigm(g[3]) * up[3];
                        uint2 w; w.x = cvt_pk_bf16(a0, a1); w.y = cvt_pk_bf16(a2, a3);
                        *(uint2*)(sact + r * 256 + c8) = w; } }
        } else {
#pragma unroll
            for (int ai = 0; ai < 2; ++ai)
#pragma unroll
                for (int m = 0; m < 4; ++m) { const size_t r = (size_t)(row0 + ai * HALF + m * 16);
#pragma unroll
                    for (int bj = 0; bj < 2; ++bj) { const int c = bj * HALF + wc * 32 + 8 * fq;
                        *(f32x4*)(logits + r * 256 + c) = acc[ai][bj][m][0]; *(f32x4*)(logits + r * 256 + c + 4) = acc[ai][bj][m][1]; } }
        }
    }
};
struct EpiFinal {
    static constexpr bool PERM = false, AFTER_DRAIN = false;
    const float* x1; const float* gvec; const bf16_t* Y; float* out;
    __device__ __forceinline__ void operator()(const f32x4 (&acc)[2][2][4][2], const Unit& u, int wr, int wc, int fr, int fq) const {
        const int row0 = u.pm * BM + wr * 64 + fr, col0 = u.pn * BM + wc * 32 + 4 * fq;
        const float* gv = gvec + ((u.pm * BM) / 8192) * 6144;
#pragma unroll
        for (int ai = 0; ai < 2; ++ai)
#pragma unroll
            for (int m = 0; m < 4; ++m) { const size_t r = (size_t)(row0 + ai * HALF + m * 16);
#pragma unroll
                for (int bj = 0; bj < 2; ++bj)
#pragma unroll
                    for (int n = 0; n < 2; ++n) { const int c = col0 + bj * HALF + n * 16;
                        f32x4 s = acc[ai][bj][m][n];
#pragma unroll
                        for (int k = 0; k < 8; ++k) { const uint2 yw = *(const uint2*)(Y + (r * 8 + k) * 1024 + c);
                            s[0] += bflo(yw.x); s[1] += bfhi(yw.x); s[2] += bflo(yw.y); s[3] += bfhi(yw.y); }
                        const f32x4 g = *(const f32x4*)(gv + c); const f32x4 b = *(const f32x4*)(x1 + r * 1024 + c);
                        *(f32x4*)(out + r * 1024 + c) = b + g * s; } }
    }
};
}
#define XB_TMO      128
#define XB_XCNT(j)  (256  + 64 * (j))
#define XB_XSUB(j)  (1280 + 64 * (j))
#define XB_XGEN(j)  (2304 + 64 * (j))
#define XB_TOP      3328
#define XB_TOPGEN   3392
#define XCD_BAR_WORDS 3456
#define XB_SPIN_CAP (1u << 18)

__device__ __forceinline__ unsigned xb_ld(unsigned* p)              { return __hip_atomic_load(p, __ATOMIC_RELAXED, __HIP_MEMORY_SCOPE_AGENT); }
__device__ __forceinline__ unsigned xb_add(unsigned* p, unsigned v) { return __hip_atomic_fetch_add(p, v, __ATOMIC_RELAXED, __HIP_MEMORY_SCOPE_AGENT); }
__device__ __forceinline__ unsigned xb_xcc_id() { return (unsigned)__builtin_amdgcn_s_getreg((3 << 11) | 20) & 0xFu; }
#define XB_SPIN(cond, bar) do { unsigned _sp = 0; while (cond) { __builtin_amdgcn_s_sleep(1); \
    if ((++_sp & 255u) == 0u) { if (xb_ld(&(bar)[XB_TMO])) break; if (_sp > XB_SPIN_CAP) { atomicAdd(&(bar)[XB_TMO], 1u); break; } } } } while (0)

struct XcdBarrier {
    unsigned* bar; unsigned x;
    volatile LAS unsigned* st;
};

__device__ __forceinline__ XcdBarrier xcd_barrier_post(unsigned* bar, volatile LAS unsigned* st) {
    XcdBarrier b; b.bar = bar; b.x = xb_xcc_id(); b.st = st;
    if (threadIdx.x == 0) (void)xb_add(&bar[XB_XCNT(b.x)], 1u);
    return b;
}
__device__ __forceinline__ void xcd_barrier_complete(unsigned* bar, unsigned x, unsigned& nloc, unsigned& nx) {
    const unsigned G = gridDim.x * gridDim.y * gridDim.z;
    unsigned sum, cnt, mine, sp = 0u;
    for (;;) {
        sum = 0u; cnt = 0u; mine = 0u;
#pragma unroll
        for (unsigned j = 0; j < 16; ++j) { const unsigned c = xb_ld(&bar[XB_XCNT(j)]); sum += c; cnt += (c > 0u) ? 1u : 0u; mine = (j == x) ? c : mine; }
        if (sum == G) break;
        __builtin_amdgcn_s_sleep(1);
        if ((++sp & 255u) == 0u) { if (xb_ld(&bar[XB_TMO])) break; if (sp > XB_SPIN_CAP) { atomicAdd(&bar[XB_TMO], 1u); break; } }
    }
    nloc = mine > 0u ? mine : 1u; nx = cnt > 0u ? cnt : 1u;
}

__device__ __forceinline__ void xcd_barrier(const XcdBarrier& b) {
    asm volatile("s_waitcnt vmcnt(0)" ::: "memory");
    __syncthreads();
    if (threadIdx.x == 0) {
        unsigned* bar = b.bar;
        __builtin_amdgcn_s_waitcnt(0);
        unsigned nloc = b.st[0], nx = b.st[1];
        if (nloc == 0u) { xcd_barrier_complete(bar, b.x, nloc, nx); b.st[0] = nloc; b.st[1] = nx; }
        const unsigned old = xb_add(&bar[XB_XSUB(b.x)], 1u);
        const unsigned gen = old / nloc;
        if (old + 1u == (gen + 1u) * nloc) {
            __builtin_amdgcn_fence(__ATOMIC_RELEASE, "agent");
            asm volatile("s_waitcnt vmcnt(0)" ::: "memory");
            const unsigned og = xb_add(&bar[XB_TOP], 1u);
            const unsigned tg = og / nx;
            if (og + 1u == (tg + 1u) * nx) xb_add(&bar[XB_TOPGEN], 1u);
            else XB_SPIN(xb_ld(&bar[XB_TOPGEN]) == tg, bar);
            __builtin_amdgcn_fence(__ATOMIC_ACQUIRE, "agent");
            xb_add(&bar[XB_XGEN(b.x)], 1u);
            asm volatile("s_waitcnt vmcnt(0)" ::: "memory");
        } else {
            XB_SPIN(xb_ld(&bar[XB_XGEN(b.x)]) == gen, bar);
            __builtin_amdgcn_fence(__ATOMIC_ACQUIRE, "agent");
            asm volatile("s_waitcnt vmcnt(0)" ::: "memory");
        }
    }
    __syncthreads();
}
template <class Map>
__device__ __forceinline__ void transpose_item(const float* W, int ldw, int K, bf16_t* WT, int row_off, int nblk, LAS float* scr, int item, int lane, Map srccol) {
    const int kb = item / nblk, nb = item % nblk, k0 = 64 * kb, n0 = 32 * nb;
    const int sc = srccol(n0 + (lane & 31));
#pragma unroll 8
    for (int i = 0; i < 32; ++i) { const int kk = 2 * i + (lane >> 5); scr[kk * 33 + (lane & 31)] = W[(size_t)(k0 + kk) * ldw + sc]; }
    LDS_WAIT(); asm volatile("" ::: "memory");
    const int c = lane & 7;
#pragma unroll
    for (int j = 0; j < 4; ++j) { const int n = (lane >> 3) + 8 * j; const LAS float* s = scr + (8 * c) * 33 + n;
        v4u o; o.x = pk2(s[0 * 33], s[1 * 33]); o.y = pk2(s[2 * 33], s[3 * 33]); o.z = pk2(s[4 * 33], s[5 * 33]); o.w = pk2(s[6 * 33], s[7 * 33]);
        *(v4u*)(WT + (size_t)(row_off + n0 + n) * K + k0 + 8 * c) = o; }
    LDS_WAIT(); asm volatile("" ::: "memory");
}
__device__ __forceinline__ void p0_phase(Frame& F, const Args& A) {
    LAS float* scr = (LAS float*)(F.lds + F.wave * 16384);
    const int gw = F.vcu * NWAVES + F.wave, NGW = F.G * NWAVES, lane = F.lane;
    const float* c = A.in[1]; const float* w_ada = A.in[2]; const float* w_in = A.in[5];
    const float* w_o_gdn = A.in[10]; const float* w_o_diff = A.in[18]; const float* w_out = A.in[19]; const float* w_router = A.in[21];
    const float* ws_gu = A.in[25]; const float* ws_dn = A.in[26];
    constexpr int I_MOD = 96 * 4, I_WIN = 16 * 176, I_WOA = 8 * 32, I_WOB = 8 * 32, I_WOUT = 16 * 32, I_SGU = 16 * 16, I_RT = 16 * 8, I_SD = 4 * 32;
    constexpr int NITEMS = I_MOD + I_WIN + I_WOA + I_WOB + I_WOUT + I_SGU + I_RT + I_SD;
    for (int it = gw; it < NITEMS; it += NGW) {
        int r = it;
        if (r < I_MOD) {
            const int eb = r >> 2, dc = r & 3, e = eb * 64 + lane; float a0 = 0.f, a1 = 0.f;
#pragma unroll 8
            for (int d = dc * 256; d < dc * 256 + 256; ++d) { const float w = w_ada[(size_t)d * 6144 + e]; a0 += siluf(c[d]) * w; a1 += siluf(c[D + d]) * w; }
            float* modp = (float*)(F.ws + WS_MODP) + dc * 12288; modp[e] = a0; modp[6144 + e] = a1; continue; }
        r -= I_MOD;
        if (r < I_WIN) { transpose_item(w_in, INC, 1024, (bf16_t*)(F.ws + WS_WIN), 0, 176, scr, r, lane, [](int n) { return n < 2048 ? n : n + 8; }); continue; } r -= I_WIN;
        if (r < I_WOA) { transpose_item(w_o_gdn, 1024, 512, (bf16_t*)(F.ws + WS_WOA), 0, 32, scr, r, lane, [](int n) { return n; }); continue; } r -= I_WOA;
        if (r < I_WOB) { transpose_item(w_o_diff, 1024, 512, (bf16_t*)(F.ws + WS_WOB), 0, 32, scr, r, lane, [](int n) { return n; }); continue; } r -= I_WOB;
        if (r < I_WOUT) { transpose_item(w_out, 1024, 1024, (bf16_t*)(F.ws + WS_WOUT), 0, 32, scr, r, lane, [](int n) { return n; }); continue; } r -= I_WOUT;
        if (r < I_SGU) { transpose_item(ws_gu, 512, 1024, (bf16_t*)(F.ws + WS_W9), 0, 16, scr, r, lane, [](int n) { const int i8 = n >> 3, j = n & 7; return j < 4 ? 4 * i8 + j : 256 + 4 * i8 + (j - 4); }); continue; } r -= I_SGU;
        if (r < I_RT) { transpose_item(w_router, 256, 1024, (bf16_t*)(F.ws + WS_W9), 512, 8, scr, r, lane, [](int n) { return n; }); continue; } r -= I_RT;
        transpose_item(ws_dn, 1024, 256, (bf16_t*)(F.ws + WS_WSD), 0, 32, scr, r, lane, [](int n) { return n; });
    }
    if (gw == 0) {
        const float s1 = wave_sum(A.in[13][lane] * A.in[14][lane]), s2 = wave_sum(A.in[15][lane] * A.in[16][lane]);
        float qm = fabsf(A.in[11][lane]), km = fabsf(A.in[12][lane]);
#pragma unroll
        for (int o = 1; o < 64; o <<= 1) { qm = fmaxf(qm, __shfl_xor(qm, o)); km = fmaxf(km, __shfl_xor(km, o)); }
        if (lane == 0) { float* sc = (float*)(F.ws + WS_SCAL); sc[0] = expf(s1) - expf(s2) + LAM_INIT; sc[1] = 8.f * qm * km * 1.4426950408889634f; }
    }
}
__device__ __forceinline__ float mod_reduce(const float* modp, const float* b_ada, int idx) {
    return ((modp[idx] + modp[12288 + idx]) + (modp[2 * 12288 + idx] + modp[3 * 12288 + idx])) + b_ada[idx % 6144];
}
template <bool FROM_PARTIALS, bool WITH_BD>
__device__ __forceinline__ void norm_mod_phase(Frame& F, const Args& A, const float* src, const float* gain, int sh_off, int sc_off, bf16_t* dst) {
    LAS float* shs = (LAS float*)F.lds;
    LAS float* scs = shs + 2048;
    LAS float* wbd = scs + 2048;
    const float* modp = (const float*)(F.ws + WS_MODP); const float* b_ada = A.in[3]; float* mod = (float*)(F.ws + WS_MOD);
    for (int i = F.tid; i < 4096; i += NWAVES * 64) { const int b = i >> 11, r = i & 2047; const int idx = b * 6144 + (r < 1024 ? sh_off + r : sc_off + r - 1024);
        const float v = FROM_PARTIALS ? mod_reduce(modp, b_ada, idx) : mod[idx];
        if (r < 1024) shs[b * 1024 + r] = v; else scs[b * 1024 + r - 1024] = v; }
    if (WITH_BD) { const float* w_in = A.in[5]; for (int i = F.tid; i < 8192; i += NWAVES * 64) wbd[i] = w_in[(size_t)(i >> 3) * INC + 2048 + (i & 7)]; }
    if (FROM_PARTIALS) for (int idx = blockIdx.x * (NWAVES * 64) + F.tid; idx < 12288; idx += F.G * NWAVES * 64) mod[idx] = mod_reduce(modp, b_ada, idx);
    __syncthreads();
    const int gw = F.vcu * NWAVES + F.wave, NGW = F.G * NWAVES, lane = F.lane;
    for (int row = gw; row < T; row += NGW) {
        const int b = row / S; const float* xr = src + (size_t)row * D;
        f32x4 v[4]; float ss = 0.f;
#pragma unroll
        for (int j = 0; j < 4; ++j) { v[j] = *(const f32x4*)(xr + j * 256 + lane * 4); ss += (v[j][0] * v[j][0] + v[j][1] * v[j][1]) + (v[j][2] * v[j][2] + v[j][3] * v[j][3]); }
        const float rs = rsqrtf(wave_sum(ss) * (1.f / D) + EPS);
        float bacc[8];
#pragma unroll
        for (int q = 0; q < 8; ++q) bacc[q] = 0.f;
#pragma unroll
        for (int j = 0; j < 4; ++j) { const int col = j * 256 + lane * 4; const f32x4 gn = *(const f32x4*)(gain + col);
            const f32x4 sh = *(const LAS f32x4*)(shs + b * 1024 + col), sc = *(const LAS f32x4*)(scs + b * 1024 + col);
            f32x4 hv = (v[j] * rs * gn) * (sc + 1.f) + sh;
            uint2 w; w.x = pk2(hv[0], hv[1]); w.y = pk2(hv[2], hv[3]);
            *(uint2*)(dst + (size_t)row * D + col) = w;
            if (WITH_BD) {
#pragma unroll
                for (int i = 0; i < 4; ++i) { const f32x4 w0 = *(const LAS f32x4*)(wbd + (col + i) * 8), w1 = *(const LAS f32x4*)(wbd + (col + i) * 8 + 4);
                    bacc[0] += hv[i] * w0[0]; bacc[1] += hv[i] * w0[1]; bacc[2] += hv[i] * w0[2]; bacc[3] += hv[i] * w0[3];
                    bacc[4] += hv[i] * w1[0]; bacc[5] += hv[i] * w1[1]; bacc[6] += hv[i] * w1[2]; bacc[7] += hv[i] * w1[3]; } } }
        if (WITH_BD) {
#pragma unroll
            for (int q = 0; q < 8; ++q) bacc[q] = wave_sum(bacc[q]);
            if (lane == 0) { float* bd = (float*)(F.ws + WS_BD) + (size_t)row * 8; *(f32x4*)bd = (f32x4){bacc[0], bacc[1], bacc[2], bacc[3]}; *(f32x4*)(bd + 4) = (f32x4){bacc[4], bacc[5], bacc[6], bacc[7]}; } }
    }
}
__device__ __forceinline__ void route_phase(Frame& F, const Args& A) {
    const float* logits = (const float*)(F.ws + WS_LOGITS); const float* rbias = A.in[22];
    int* top_idx = (int*)(F.ws + WS_TOPI); float* top_w = (float*)(F.ws + WS_TOPW);
    const int gw = F.vcu * NWAVES + F.wave, NGW = F.G * NWAVES, lane = F.lane;
    const f32x4 rb = *(const f32x4*)(rbias + lane * 4);
    for (int t = gw; t < T; t += NGW) {
        float sc[4], ch[4];
        const f32x4 lg = *(const f32x4*)(logits + (size_t)t * 256 + lane * 4);
#pragma unroll
        for (int i = 0; i < 4; ++i) { sc[i] = 1.f / (1.f + __expf(-lg[i])); ch[i] = sc[i] + rb[i]; }
        float a1 = fmaxf(ch[0], ch[1]), a2 = fminf(ch[0], ch[1]);
        { const float b1 = fmaxf(ch[2], ch[3]), b2 = fminf(ch[2], ch[3]); const float m1 = fmaxf(a1, b1), m2 = fmaxf(fminf(a1, b1), fmaxf(a2, b2)); a1 = m1; a2 = m2; }
#pragma unroll
        for (int o = 1; o < 8; o <<= 1) { const float b1 = __shfl_xor(a1, o), b2 = __shfl_xor(a2, o); const float m1 = fmaxf(a1, b1), m2 = fmaxf(fminf(a1, b1), fmaxf(a2, b2)); a1 = m1; a2 = m2; }
        const float gs = a1 + a2; const int g = lane >> 3;
        int rank = 0;
#pragma unroll
        for (int gg = 0; gg < 8; ++gg) { const float o = __shfl(gs, gg * 8); rank += (o > gs || (o == gs && gg < g)) ? 1 : 0; }
        const bool sel = rank < 4;
        float mc[4];
#pragma unroll
        for (int i = 0; i < 4; ++i) mc[i] = sel ? ch[i] : -INFINITY;
        int my_idx = 0; float my_sc = 0.f, sum = 0.f;
#pragma unroll
        for (int r = 0; r < 8; ++r) {
            float bv = mc[0]; int bi = 0;
#pragma unroll
            for (int i = 1; i < 4; ++i) if (mc[i] > bv) { bv = mc[i]; bi = i; }
            int be = lane * 4 + bi;
#pragma unroll
            for (int o = 1; o < 64; o <<= 1) { const float ov = __shfl_xor(bv, o); const int oe = __shfl_xor(be, o); if (ov > bv || (ov == bv && oe < be)) { bv = ov; be = oe; } }
            float s = 0.f;
            if ((be >> 2) == lane) { const int b2 = be & 3;
                s = b2 == 0 ? sc[0] : b2 == 1 ? sc[1] : b2 == 2 ? sc[2] : sc[3];
                if (b2 == 0) mc[0] = -INFINITY; else if (b2 == 1) mc[1] = -INFINITY; else if (b2 == 2) mc[2] = -INFINITY; else mc[3] = -INFINITY; }
            s = __shfl(s, be >> 2);
            sum += s;
            if (lane == r) { my_idx = be; my_sc = s; }
        }
        if (lane < 8) { top_idx[t * 8 + lane] = my_idx; top_w[t * 8 + lane] = my_sc / sum * 2.5f; }
    }
}

typedef float f32x16 __attribute__((ext_vector_type(16)));
constexpr int XM = 512;
constexpr int XA_KG = (XM + 8) * 16;
constexpr int XA_BYTES = 4 * XA_KG;
constexpr int XW_BYTES = 4 * 128 * 16;
constexpr int X_BUF = XA_BYTES + XW_BYTES;
__device__ __forceinline__ int xw_lane(int n31) { const int i = n31 & 3, x = n31 >> 2; return (8 * i + (x ^ (i >> 1))) * 16; }

template <int KDIM, class ColMap>
__device__ __forceinline__ void xgemm_tile(Frame& F, f32x16 (&acc)[4][2], const unsigned char* src, const int* list, int r0, int total, int aid_shift, unsigned row_bytes, const float* W, int ldw, ColMap colmap) {
    const int tid = F.tid, lane = F.lane, wave = F.wave;
    LAS unsigned char* lds = F.lds;
    const int a_kg = tid & 3, a_r = tid >> 2;
    const int w_n4 = tid & 31, w_kp = tid >> 5;
    const float* wp = W + colmap(w_n4 * 4) + (size_t)(2 * w_kp) * ldw;
    unsigned rowoff[4];
#pragma unroll
    for (int i = 0; i < 4; ++i) { int r = r0 + a_r + 128 * i; r = r < total ? r : r0; rowoff[i] = (unsigned)(list[r] >> aid_shift) * row_bytes + a_kg * 16; }
#pragma unroll
    for (int nt = 0; nt < 4; ++nt)
#pragma unroll
        for (int tt = 0; tt < 2; ++tt)
#pragma unroll
            for (int q = 0; q < 16; ++q) acc[nt][tt][q] = 0.f;
    const int st_a = a_kg * XA_KG + (a_r + 2 * a_kg) * 16;
    const int st_w0 = XA_BYTES + (w_kp >> 2) * 2048 + (w_n4 >> 3) * 512 + ((w_n4 & 7)) * 16 + (w_kp & 3) * 4;
    const int st_w1 = XA_BYTES + (w_kp >> 2) * 2048 + (w_n4 >> 3) * 512 + ((w_n4 & 7) ^ 1) * 16 + (w_kp & 3) * 4 + 256;
    const int rd_a = (lane >> 5) * (XA_KG + 32) + (wave * 64 + (lane & 31)) * 16;
    const int rd_w = XA_BYTES + (lane >> 5) * 2048 + xw_lane(lane & 31);
    v4u ra[4]; f32x4 rw[2];
    auto gload = [&](int k0) {
#pragma unroll
        for (int i = 0; i < 4; ++i) ra[i] = *(const v4u*)(src + rowoff[i] + k0 * 2);
        rw[0] = *(const f32x4*)(wp + (size_t)k0 * ldw); rw[1] = *(const f32x4*)(wp + (size_t)(k0 + 1) * ldw);
    };
    auto lstore = [&](int buf) {
        LAS unsigned char* b = lds + buf * X_BUF;
#pragma unroll
        for (int i = 0; i < 4; ++i) *(LAS v4u*)(b + st_a + i * 2048) = ra[i];
        *(LAS unsigned*)(b + st_w0) = pk2(rw[0][0], rw[1][0]); *(LAS unsigned*)(b + st_w0 + 128) = pk2(rw[0][1], rw[1][1]);
        *(LAS unsigned*)(b + st_w1) = pk2(rw[0][2], rw[1][2]); *(LAS unsigned*)(b + st_w1 + 128) = pk2(rw[0][3], rw[1][3]);
    };
    constexpr int NS = KDIM / 32;
    gload(0); lstore(0); __syncthreads();
    for (int s = 0; s < NS; ++s) {
        if (s + 1 < NS) gload((s + 1) * 32);
        const LAS unsigned char* b = lds + (s & 1) * X_BUF;
#pragma unroll
        for (int ks = 0; ks < 2; ++ks) {
            bf16x8 tf[2], wf[4];
#pragma unroll
            for (int tt = 0; tt < 2; ++tt) tf[tt] = *(const LAS bf16x8*)(b + rd_a + ks * (2 * XA_KG + 64) + tt * 512);
#pragma unroll
            for (int nt = 0; nt < 4; ++nt) wf[nt] = *(const LAS bf16x8*)(b + rd_w + ks * 4096 + nt * 512);
#pragma unroll
            for (int nt = 0; nt < 4; ++nt)
#pragma unroll
                for (int tt = 0; tt < 2; ++tt) acc[nt][tt] = __builtin_amdgcn_mfma_f32_32x32x16_bf16(wf[nt], tf[tt], acc[nt][tt], 0, 0, 0);
        }
        if (s + 1 < NS) lstore((s + 1) & 1);
        __syncthreads();
    }
}

__device__ __forceinline__ void moe_phase(Frame& F, const Args& A) {
    const int tid = F.tid, lane = F.lane, wave = F.wave;
    const int* top_idx = (const int*)(F.ws + WS_TOPI); const float* top_w = (const float*)(F.ws + WS_TOPW);
    const unsigned char* hsrc = F.ws + WS_H; unsigned char* actb = F.ws + WS_ACTB; bf16_t* Y = (bf16_t*)(F.ws + WS_Y);
    LAS int* wcnt = (LAS int*)(F.lds + 2 * X_BUF);
    for (int e = blockIdx.x; e < NE; e += F.G) {
        int* list = (int*)(F.ws + WS_LIST) + (size_t)e * T;
        const int abase = wave * (NA / NWAVES);
        int c = 0;
        for (int it = 0; it < NA / NWAVES / 256; ++it) { const int4 v = *(const int4*)(top_idx + abase + it * 256 + lane * 4); c += (v.x == e) + (v.y == e) + (v.z == e) + (v.w == e); }
#pragma unroll
        for (int o = 1; o < 64; o <<= 1) c += __shfl_xor(c, o);
        __syncthreads();
        if (lane == 0) wcnt[wave] = c;
        __syncthreads();
        int pos = 0, total = 0;
#pragma unroll
        for (int w = 0; w < NWAVES; ++w) { const int cw = wcnt[w]; pos += (w < wave) ? cw : 0; total += cw; }
        const unsigned long long lt = (1ull << lane) - 1ull;
        for (int it = 0; it < NA / NWAVES / 256; ++it) {
            const int a0 = abase + it * 256 + lane * 4; const int4 v = *(const int4*)(top_idx + a0);
            const bool m0 = v.x == e, m1 = v.y == e, m2 = v.z == e, m3 = v.w == e;
            const unsigned long long b0 = __ballot(m0), b1 = __ballot(m1), b2 = __ballot(m2), b3 = __ballot(m3);
            int p = pos + __popcll(b0 & lt) + __popcll(b1 & lt) + __popcll(b2 & lt) + __popcll(b3 & lt);
            if (m0) list[p++] = a0; if (m1) list[p++] = a0 + 1; if (m2) list[p++] = a0 + 2; if (m3) list[p++] = a0 + 3;
            pos += __popcll(b0) + __popcll(b1) + __popcll(b2) + __popcll(b3);
        }
        __syncthreads();
        const float* W1 = A.in[23] + (size_t)e * 1024 * 512; const float* W2 = A.in[24] + (size_t)e * 256 * 1024;
        for (int r0 = 0; r0 < total; r0 += XM) {
            f32x16 acc[4][2];
            for (int j = 0; j < 4; ++j) {
                xgemm_tile<1024>(F, acc, hsrc, list, r0, total, 3, 2048u, W1, 512, [j](int n) { return n < 64 ? 64 * j + n : 256 + 64 * j + (n - 64); });
#pragma unroll
                for (int tt = 0; tt < 2; ++tt) { const int r = r0 + wave * 64 + tt * 32 + (lane & 31); if (r < total) {
                    bf16_t* dst = (bf16_t*)(actb + (size_t)list[r] * 512) + 64 * j + 4 * (lane >> 5);
#pragma unroll
                    for (int nt = 0; nt < 2; ++nt)
#pragma unroll
                        for (int g = 0; g < 4; ++g) { float a[4];
#pragma unroll
                            for (int q = 0; q < 4; ++q) { const float gt = acc[nt][tt][4 * g + q], up = acc[nt + 2][tt][4 * g + q]; a[q] = gt / (1.f + __expf(-gt)) * up; }
                            uint2 w; w.x = pk2(a[0], a[1]); w.y = pk2(a[2], a[3]); *(uint2*)(dst + 32 * nt + 8 * g) = w; }
                } }
            }
            __syncthreads();
            for (int j = 0; j < 8; ++j) {
                xgemm_tile<256>(F, acc, actb, list, r0, total, 0, 512u, W2, 1024, [j](int n) { return 128 * j + n; });
#pragma unroll
                for (int tt = 0; tt < 2; ++tt) { const int r = r0 + wave * 64 + tt * 32 + (lane & 31); if (r < total) {
                    const int aid = list[r]; const float rw2 = top_w[aid];
                    bf16_t* dst = Y + (size_t)aid * 1024 + 128 * j + 4 * (lane >> 5);
#pragma unroll
                    for (int nt = 0; nt < 4; ++nt)
#pragma unroll
                        for (int g = 0; g < 4; ++g) { uint2 w; w.x = pk2(acc[nt][tt][4 * g] * rw2, acc[nt][tt][4 * g + 1] * rw2); w.y = pk2(acc[nt][tt][4 * g + 2] * rw2, acc[nt][tt][4 * g + 3] * rw2);
                            *(uint2*)(dst + 32 * nt + 8 * g) = w; }
                } }
            }
            __syncthreads();
        }
    }
}
__device__ __forceinline__ void attn_prep_phase(Frame& F, const Args& A) {
    const bf16_t* P = (const bf16_t*)(F.ws + WS_P); bf16_t* QN = (bf16_t*)(F.ws + WS_QN); bf16_t* KN = (bf16_t*)(F.ws + WS_KN);
    const float* qg = A.in[11]; const float* kg = A.in[12];
    const int gw = F.vcu * NWAVES + F.wave, NGW = F.G * NWAVES, lane = F.lane;
    f32x4 gq0 = *(const f32x4*)(qg + (lane & 7) * 8), gq1 = *(const f32x4*)(qg + (lane & 7) * 8 + 4);
    f32x4 gk0 = *(const f32x4*)(kg + (lane & 7) * 8), gk1 = *(const f32x4*)(kg + (lane & 7) * 8 + 4);
    for (int t = gw; t < T; t += NGW) {
#pragma unroll
        for (int which = 0; which < 2; ++which) {
            const v4u w = *(const v4u*)(P + (size_t)t * LDP + (which ? C_KB : C_QB) + lane * 8);
            float v[8] = {pg8::bflo(w.x), pg8::bfhi(w.x), pg8::bflo(w.y), pg8::bfhi(w.y), pg8::bflo(w.z), pg8::bfhi(w.z), pg8::bflo(w.w), pg8::bfhi(w.w)};
            float ss = 0.f;
#pragma unroll
            for (int i = 0; i < 8; ++i) ss += v[i] * v[i];
            ss += __shfl_xor(ss, 1); ss += __shfl_xor(ss, 2); ss += __shfl_xor(ss, 4);
            const float r = rsqrtf(ss * (1.f / 64.f) + EPS) * (which ? 1.f : 0.125f * 1.4426950408889634f);
            const f32x4 g0 = which ? gk0 : gq0, g1 = which ? gk1 : gq1;
            v4u o; o.x = pk2(v[0] * r * g0[0], v[1] * r * g0[1]); o.y = pk2(v[2] * r * g0[2], v[3] * r * g0[3]); o.z = pk2(v[4] * r * g1[0], v[5] * r * g1[1]); o.w = pk2(v[6] * r * g1[2], v[7] * r * g1[3]);
            *(v4u*)((which ? KN : QN) + (size_t)t * 512 + lane * 8) = o;
        }
    }
}

typedef short s16x4 __attribute__((ext_vector_type(4)));
constexpr int AT_KPLANE = 1040;
constexpr int AT_KBYTES = 8 * AT_KPLANE;
constexpr int AT_VROW = 320;
constexpr int AT_VBYTES = 64 * AT_VROW;
constexpr int AT_BUF = AT_KBYTES + AT_VBYTES;
template <int OFF> __device__ __forceinline__ s16x4 tr_read(int vb) {
    s16x4 r; asm volatile("ds_read_b64_tr_b16 %0, %1 offset:%2" : "=&v"(r) : "v"(vb), "i"(OFF) : "memory"); return r;
}
template <int ND> __device__ __forceinline__ void pv_one(f32x16& od, int vb, const bf16x8 (&pf)[4]) {
#define VOFF(mt, s, half) (AT_KBYTES + (32 * (mt) + 16 * (s) + 8 * (half)) * AT_VROW + ND * 64)
    const s16x4 a0 = tr_read<VOFF(0, 0, 0)>(vb), b0 = tr_read<VOFF(0, 0, 1)>(vb), a1 = tr_read<VOFF(0, 1, 0)>(vb), b1 = tr_read<VOFF(0, 1, 1)>(vb);
    const s16x4 a2 = tr_read<VOFF(1, 0, 0)>(vb), b2 = tr_read<VOFF(1, 0, 1)>(vb), a3 = tr_read<VOFF(1, 1, 0)>(vb), b3 = tr_read<VOFF(1, 1, 1)>(vb);
#undef VOFF
    asm volatile("s_waitcnt lgkmcnt(0)" ::: "memory"); __builtin_amdgcn_sched_barrier(0);
#define PK(L, H) (bf16x8){L[0], L[1], L[2], L[3], H[0], H[1], H[2], H[3]}
    od = __builtin_amdgcn_mfma_f32_32x32x16_bf16(PK(a0, b0), pf[0], od, 0, 0, 0);
    od = __builtin_amdgcn_mfma_f32_32x32x16_bf16(PK(a1, b1), pf[1], od, 0, 0, 0);
    od = __builtin_amdgcn_mfma_f32_32x32x16_bf16(PK(a2, b2), pf[2], od, 0, 0, 0);
    od = __builtin_amdgcn_mfma_f32_32x32x16_bf16(PK(a3, b3), pf[3], od, 0, 0, 0);
#undef PK
}
__device__ __forceinline__ void attn_unit(Frame& F, int b, int h, int c, int qb) {
    const int tid = F.tid, lane = F.lane, wave = F.wave, r32 = lane & 31, hi = lane >> 5;
    LAS unsigned char* lds = F.lds;
    const bf16_t* QN = (const bf16_t*)(F.ws + WS_QN); const bf16_t* KN = (const bf16_t*)(F.ws + WS_KN); const bf16_t* P = (const bf16_t*)(F.ws + WS_P);
    const float sl2 = exp2f(-2.f * (float)(h + 1)) * 1.4426950408889634f;
    const float M2 = ((const float*)(F.ws + WS_SCAL))[1];
    const int tq = qb * 256 + wave * 32 + r32;
    const int ctw = 4 * qb + (wave >> 1), ntiles = 4 * qb + 4;
    bf16x8 qf[4];
    { const bf16_t* qp = QN + (size_t)(b * S + tq) * 512 + h * 128 + c * 64 + hi * 8;
#pragma unroll
      for (int ks = 0; ks < 4; ++ks) qf[ks] = *(const bf16x8*)(qp + 16 * ks); }
    float koffs[16];
#pragma unroll
    for (int r = 0; r < 16; ++r) koffs[r] = sl2 * (float)((r & 3) + 8 * (r >> 2) + 4 * hi);
    f32x16 oacc[4];
#pragma unroll
    for (int nd = 0; nd < 4; ++nd)
#pragma unroll
        for (int r = 0; r < 16; ++r) oacc[nd][r] = 0.f;
    float lsum = 0.f;
    const int s_key = tid >> 3, s_kg = tid & 7;
    const bf16_t* kg_src = KN + (size_t)(b * S + s_key) * 512 + h * 128 + c * 64 + s_kg * 8;
    const bf16_t* vg_src = P + (size_t)(b * S + s_key) * LDP + C_VB + h * 128 + s_kg * 8;
    const int st_k = s_kg * AT_KPLANE + s_key * 16, st_v = AT_KBYTES + s_key * AT_VROW + s_kg * 16;
    const int rd_k = hi * AT_KPLANE + r32 * 16;
    const int rd_v = (hi * 4 + ((lane & 15) >> 2)) * AT_VROW + ((lane >> 4) & 1) * 32 + (lane & 3) * 8;
    v4u rk, rv0, rv1;
    auto gload = [&](int tile) { rk = *(const v4u*)(kg_src + (size_t)tile * 64 * 512); const bf16_t* vp = vg_src + (size_t)tile * 64 * LDP; rv0 = *(const v4u*)vp; rv1 = *(const v4u*)(vp + 64); };
    auto lstore = [&](int buf) { LAS unsigned char* bb = lds + buf * AT_BUF; *(LAS v4u*)(bb + st_k) = rk; *(LAS v4u*)(bb + st_v) = rv0; *(LAS v4u*)(bb + st_v + 128) = rv1; };
    __syncthreads();
    gload(0); lstore(0); __syncthreads();
    for (int tile = 0; tile < ntiles; ++tile) {
        if (tile + 1 < ntiles) gload(tile + 1);
        if (tile <= ctw) {
            const LAS unsigned char* kb = lds + (tile & 1) * AT_BUF;
            f32x16 sacc[2];
            if (tile != ctw) {
                const float ct = sl2 * (float)(64 * tile - tq) - M2;
#pragma unroll
                for (int mt = 0; mt < 2; ++mt)
#pragma unroll
                    for (int r = 0; r < 16; ++r) sacc[mt][r] = koffs[r] + (ct + sl2 * 32.f * mt);
            } else {
                const float base = sl2 * (float)(64 * tile - tq);
#pragma unroll
                for (int mt = 0; mt < 2; ++mt)
#pragma unroll
                    for (int r = 0; r < 16; ++r) sacc[mt][r] = -fabsf(koffs[r] + (base + sl2 * 32.f * mt)) - M2;
            }
#pragma unroll
            for (int ks = 0; ks < 4; ++ks)
#pragma unroll
                for (int mt = 0; mt < 2; ++mt) { const bf16x8 kf = *(const LAS bf16x8*)(kb + rd_k + ks * 2 * AT_KPLANE + mt * 512);
                    sacc[mt] = __builtin_amdgcn_mfma_f32_32x32x16_bf16(kf, qf[ks], sacc[mt], 0, 0, 0); }
            bf16x8 pf[4];
#pragma unroll
            for (int mt = 0; mt < 2; ++mt) {
#pragma unroll
                for (int r = 0; r < 16; ++r) { const float p = __builtin_amdgcn_exp2f(sacc[mt][r]); lsum += p; sacc[mt][r] = p; }
#pragma unroll
                for (int s = 0; s < 2; ++s) { v4u w;
                    w.x = pg8::cvt_pk_bf16(sacc[mt][8 * s + 0], sacc[mt][8 * s + 1]); w.y = pg8::cvt_pk_bf16(sacc[mt][8 * s + 2], sacc[mt][8 * s + 3]);
                    w.z = pg8::cvt_pk_bf16(sacc[mt][8 * s + 4], sacc[mt][8 * s + 5]); w.w = pg8::cvt_pk_bf16(sacc[mt][8 * s + 6], sacc[mt][8 * s + 7]);
                    pf[mt * 2 + s] = __builtin_bit_cast(bf16x8, w); }
            }
            const int vb = (int)(uintptr_t)kb + rd_v;
            pv_one<0>(oacc[0], vb, pf); pv_one<1>(oacc[1], vb, pf); pv_one<2>(oacc[2], vb, pf); pv_one<3>(oacc[3], vb, pf);
        }
        if (tile + 1 < ntiles) lstore((tile + 1) & 1);
        __syncthreads();
    }
    lsum += __shfl_xor(lsum, 32);
    const float inv = 1.f / lsum;
    bf16_t* ob = (bf16_t*)(F.ws + WS_OB) + (size_t)c * T * 512 + (size_t)(b * S + tq) * 512 + h * 128 + 4 * hi;
#pragma unroll
    for (int nd = 0; nd < 4; ++nd)
#pragma unroll
        for (int g = 0; g < 4; ++g) { uint2 w; w.x = pk2(oacc[nd][4 * g] * inv, oacc[nd][4 * g + 1] * inv); w.y = pk2(oacc[nd][4 * g + 2] * inv, oacc[nd][4 * g + 3] * inv);
            *(uint2*)(ob + 32 * nd + 8 * g) = w; }
}
__device__ __forceinline__ void post_norm_phase(Frame& F, const Args& A) {
    const float* oa = (const float*)(F.ws + WS_OA); const bf16_t* ob = (const bf16_t*)(F.ws + WS_OB); const bf16_t* P = (const bf16_t*)(F.ws + WS_P);
    bf16_t* oan = (bf16_t*)(F.ws + WS_OAN); bf16_t* obn = (bf16_t*)(F.ws + WS_OBN);
    const float* gg = A.in[9]; const float* sg = A.in[17];
    const float lam = ((const float*)(F.ws + WS_SCAL))[0];
    const int gw = F.vcu * NWAVES + F.wave, NGW = F.G * NWAVES, lane = F.lane;
    const int gc = (lane & 15) * 8;
    const f32x4 g0 = *(const f32x4*)(gg + gc), g1 = *(const f32x4*)(gg + gc + 4), s0 = *(const f32x4*)(sg + gc), s1 = *(const f32x4*)(sg + gc + 4);
    for (int t = gw; t < T; t += NGW) {
        { const f32x4 a0 = *(const f32x4*)(oa + (size_t)t * 512 + lane * 8), a1 = *(const f32x4*)(oa + (size_t)t * 512 + lane * 8 + 4);
          float ss = (a0[0] * a0[0] + a0[1] * a0[1]) + (a0[2] * a0[2] + a0[3] * a0[3]) + (a1[0] * a1[0] + a1[1] * a1[1]) + (a1[2] * a1[2] + a1[3] * a1[3]);
          ss += __shfl_xor(ss, 1); ss += __shfl_xor(ss, 2); ss += __shfl_xor(ss, 4); ss += __shfl_xor(ss, 8);
          const float r = rsqrtf(ss * (1.f / 128.f) + EPS);
          const v4u zw = *(const v4u*)(P + (size_t)t * LDP + C_ZA + lane * 8);
          const float z[8] = {pg8::bflo(zw.x), pg8::bfhi(zw.x), pg8::bflo(zw.y), pg8::bfhi(zw.y), pg8::bflo(zw.z), pg8::bfhi(zw.z), pg8::bflo(zw.w), pg8::bfhi(zw.w)};
          float o[8];
#pragma unroll
          for (int i = 0; i < 4; ++i) { o[i] = a0[i] * r * g0[i] * siluf(z[i]); o[4 + i] = a1[i] * r * g1[i] * siluf(z[4 + i]); }
          v4u w; w.x = pk2(o[0], o[1]); w.y = pk2(o[2], o[3]); w.z = pk2(o[4], o[5]); w.w = pk2(o[6], o[7]);
          *(v4u*)(oan + (size_t)t * 512 + lane * 8) = w; }
        { const v4u w1 = *(const v4u*)(ob + (size_t)t * 512 + lane * 8), w2 = *(const v4u*)(ob + (size_t)T * 512 + (size_t)t * 512 + lane * 8);
          float d[8] = {pg8::bflo(w1.x) - lam * pg8::bflo(w2.x), pg8::bfhi(w1.x) - lam * pg8::bfhi(w2.x), pg8::bflo(w1.y) - lam * pg8::bflo(w2.y), pg8::bfhi(w1.y) - lam * pg8::bfhi(w2.y),
                        pg8::bflo(w1.z) - lam * pg8::bflo(w2.z), pg8::bfhi(w1.z) - lam * pg8::bfhi(w2.z), pg8::bflo(w1.w) - lam * pg8::bflo(w2.w), pg8::bfhi(w1.w) - lam * pg8::bfhi(w2.w)};
          float ss = 0.f;
#pragma unroll
          for (int i = 0; i < 8; ++i) ss += d[i] * d[i];
          ss += __shfl_xor(ss, 1); ss += __shfl_xor(ss, 2); ss += __shfl_xor(ss, 4); ss += __shfl_xor(ss, 8);
          const float r = rsqrtf(ss * (1.f / 128.f) + EPS) * (1.f - LAM_INIT);
          v4u w; w.x = pk2(d[0] * r * s0[0], d[1] * r * s0[1]); w.y = pk2(d[2] * r * s0[2], d[3] * r * s0[3]); w.z = pk2(d[4] * r * s1[0], d[5] * r * s1[1]); w.w = pk2(d[6] * r * s1[2], d[7] * r * s1[3]);
          *(v4u*)(obn + (size_t)t * 512 + lane * 8) = w; }
    }
}
constexpr int GD_KA = 0, GD_QA = 17408, GD_VN = 34816, GD_KB = 55296, GD_LM = 75776, GD_T1 = 93184, GD_T2 = 102400, GD_SC = 111616;
constexpr int GD_SA = 272, GD_SB = 320, GD_SL = 272, GD_ST = 144;
constexpr size_t GDN_WF = 0, GDN_QF = 16384, GDN_AF = 32768, GDN_KF = 40960, GDN_UF = 57344, GDN_EG = 90112, GDN_ITEM = 90368;
__device__ __forceinline__ int perm16_h(int n) { return (n >> 2) & 1; }
__device__ __forceinline__ int perm16_j(int n) { return (n & 3) + 4 * (n >> 3); }

__device__ __forceinline__ void gdn_prep_item(Frame& F, const Args& A, int item) {
    const int tid = F.tid, lane = F.lane, wave = F.wave, r32 = lane & 31, hi = lane >> 5;
    LAS unsigned char* lds = F.lds;
    const int b = item >> 9, h = (item >> 7) & 3, n = item & 127;
    const int t0 = b * S + n * 64;
    const bf16_t* P = (const bf16_t*)(F.ws + WS_P); const float* bd = (const float*)(F.ws + WS_BD);
    unsigned char* gi = F.ws + WS_GDN + (size_t)item * GDN_ITEM;
    LAS float* sc_g = (LAS float*)(lds + GD_SC);
    LAS float* sc_b = sc_g + 64;
    LAS float* sc_e = sc_g + 128;
    LAS float* sc_l = sc_g + 192;
#ifndef NO_S1
    {
        const float* cw = A.in[6];
        float w[3][4][2];
#pragma unroll
        for (int p = 0; p < 3; ++p)
#pragma unroll
            for (int j = 0; j < 4; ++j) { const float2 t = *(const float2*)(cw + j * 1536 + p * 512 + h * 128 + 2 * lane); w[p][j][0] = t.x; w[p][j][1] = t.y; }
        const int rl0 = n * 64 + wave * 8;
#pragma unroll
        for (int p = 0; p < 3; ++p) {
            float x[11][2];
#pragma unroll
            for (int i = 0; i < 11; ++i) { const int tl = rl0 - 3 + i; unsigned u = 0u;
                if (tl >= 0) u = *(const unsigned*)(P + (size_t)(b * S + tl) * LDP + p * 512 + h * 128 + 2 * lane);
                x[i][0] = pg8::bflo(u); x[i][1] = pg8::bfhi(u); }
#pragma unroll
            for (int r = 0; r < 8; ++r) {
                float a0 = 0.f, a1 = 0.f;
#pragma unroll
                for (int j = 0; j < 4; ++j) { a0 += x[r + j][0] * w[p][j][0]; a1 += x[r + j][1] * w[p][j][1]; }
                a0 = siluf(a0); a1 = siluf(a1);
                const int row = wave * 8 + r;
                if (p < 2) { const float ss = wave_sum(a0 * a0 + a1 * a1); const float rs = rsqrtf(ss + EPS) * (p == 0 ? 0.08838834764831845f : 1.f); a0 *= rs; a1 *= rs; }
                const unsigned pk = pk2(a0, a1);
                if (p == 0) *(LAS unsigned*)(lds + GD_QA + row * GD_SA + lane * 4) = pk;
                else if (p == 1) { *(LAS unsigned*)(lds + GD_KA + row * GD_SA + lane * 4) = pk; *(LAS unsigned*)(lds + GD_KB + row * GD_SB + lane * 4) = pk; }
                else *(LAS unsigned*)(lds + GD_VN + row * GD_SB + lane * 4) = pk;
            }
        }
        if (wave == 0) {
            const float bl = bd[(size_t)(t0 + lane) * 8 + h], dl = bd[(size_t)(t0 + lane) * 8 + 4 + h];
            const float beta = 1.f / (1.f + __expf(-bl));
            float g = -expf(A.in[7][h]) * softplusf(dl + A.in[8][h]);
#pragma unroll
            for (int o = 1; o < 64; o <<= 1) { const float up = __shfl_up(g, o); if (lane >= o) g += up; }
            const float glast = __shfl(g, 63);
            sc_g[lane] = g; sc_b[lane] = beta; sc_e[lane] = __expf(g); sc_l[lane] = __expf(glast - g);
            if (lane == 0) *(float*)(gi + GDN_EG) = __expf(glast);
        }
    }
#endif
    __syncthreads();
#ifndef NO_S2
    {
        const int which = wave >> 2, ti = (wave >> 1) & 1, tj = wave & 1;
        f32x16 acc;
#pragma unroll
        for (int r = 0; r < 16; ++r) acc[r] = 0.f;
        if (ti >= tj) {
            const LAS unsigned char* ap = lds + (which ? GD_QA : GD_KA) + (32 * ti + r32) * GD_SA + hi * 16;
            const LAS unsigned char* bp = lds + GD_KA + (32 * tj + r32) * GD_SA + hi * 16;
#pragma unroll
            for (int ks = 0; ks < 8; ++ks) acc = __builtin_amdgcn_mfma_f32_32x32x16_bf16(*(const LAS bf16x8*)(ap + ks * 32), *(const LAS bf16x8*)(bp + ks * 32), acc, 0, 0, 0);
        }
        const int j = 32 * tj + r32; const float Gj = sc_g[j];
        const int ibase = 32 * ti + 4 * hi, dij = ibase - j;
        const LAS float* gp = sc_g + ibase; const LAS float* bp2 = sc_b + ibase;
        if (which == 0) {
            LAS float* lm = (LAS float*)(lds + GD_LM + ibase * GD_SL + j * 4);
#pragma unroll
            for (int r = 0; r < 16; ++r) { const int off = (r & 3) + 8 * (r >> 2);
                const float v = (off + dij > 0) ? bp2[off] * acc[r] * __expf(fminf(gp[off] - Gj, 0.f)) : 0.f;
                lm[off * (GD_SL / 4)] = v; }
        } else {
            const int ks = j >> 4, nn = j & 15, hp = perm16_h(nn), jj = perm16_j(nn);
            bf16_t* af = (bf16_t*)(gi + GDN_AF) + ((ti * 4 + ks) * 64 + hp * 32 + 4 * hi) * 8 + jj;
#pragma unroll
            for (int r = 0; r < 16; ++r) { const int off = (r & 3) + 8 * (r >> 2);
                const float v = (off + dij >= 0) ? acc[r] * __expf(fminf(gp[off] - Gj, 0.f)) : 0.f;
                af[off * 8] = (bf16_t)f2bf(v); }
        }
    }
#endif
    __syncthreads();
#ifndef NO_S3
    if (wave == 0) {
        float t[64];
#pragma unroll
        for (int i = 0; i < 64; ++i) {
            float s = (i == lane) ? 1.f : 0.f;
            const LAS float* Li = (const LAS float*)(lds + GD_LM + i * GD_SL);
#pragma unroll
            for (int j4 = 0; j4 < (i + 3) / 4; ++j4) { const f32x4 l4 = *(const LAS f32x4*)(Li + 4 * j4);
#pragma unroll
                for (int q = 0; q < 4; ++q) if (4 * j4 + q < i) s -= l4[q] * t[4 * j4 + q]; }
            t[i] = s;
            __builtin_amdgcn_sched_barrier(0);
        }
        const float bc = sc_b[lane], bec = bc * sc_e[lane];
#pragma unroll
        for (int i = 0; i < 64; ++i) { *(LAS bf16_t*)(lds + GD_T1 + i * GD_ST + lane * 2) = (bf16_t)f2bf(t[i] * bc); *(LAS bf16_t*)(lds + GD_T2 + i * GD_ST + lane * 2) = (bf16_t)f2bf(t[i] * bec); }
    } else {
        for (int cidx = tid - 64; cidx < 2048; cidx += 448) {
            const bool isK = cidx >= 1024; const int cc = cidx & 1023; const int lp = cc & 63, hp = lp >> 5, rr = lp & 31;
            unsigned wds[4];
            if (!isK) { const int mt = cc >> 9, ks = (cc >> 6) & 7; const int i = 32 * mt + rr; const float e = sc_e[i];
#pragma unroll
                for (int q = 0; q < 4; ++q) { const int j0 = 2 * q, j1 = 2 * q + 1;
                    const int d0 = 16 * ks + 8 * (j0 >> 2) + 4 * hp + (j0 & 3), d1 = 16 * ks + 8 * (j1 >> 2) + 4 * hp + (j1 & 3);
                    wds[q] = pk2(bf2f(*(const LAS bf16_t*)(lds + GD_QA + i * GD_SA + d0 * 2)) * e, bf2f(*(const LAS bf16_t*)(lds + GD_QA + i * GD_SA + d1 * 2)) * e); }
                *(v4u*)(gi + GDN_QF + (size_t)cc * 16) = (v4u){wds[0], wds[1], wds[2], wds[3]};
            } else { const int dt = cc >> 8, ks = (cc >> 6) & 3; const int dk = 32 * dt + rr;
#pragma unroll
                for (int q = 0; q < 4; ++q) { const int j0 = 2 * q, j1 = 2 * q + 1;
                    const int k0 = 16 * ks + 8 * (j0 >> 2) + 4 * hp + (j0 & 3), k1 = 16 * ks + 8 * (j1 >> 2) + 4 * hp + (j1 & 3);
                    wds[q] = pk2(bf2f(*(const LAS bf16_t*)(lds + GD_KA + k0 * GD_SA + dk * 2)) * sc_l[k0], bf2f(*(const LAS bf16_t*)(lds + GD_KA + k1 * GD_SA + dk * 2)) * sc_l[k1]); }
                *(v4u*)(gi + GDN_KF + (size_t)cc * 16) = (v4u){wds[0], wds[1], wds[2], wds[3]};
            }
        }
    }
#endif
    __syncthreads();
#ifndef NO_S4
    {
        const int mt = wave >> 2, nt = wave & 3;
        const int trb = (hi * 8 + ((lane & 15) >> 2)) * GD_SB + (32 * nt + ((lane >> 4) & 1) * 16 + (lane & 3) * 4) * 2;
#pragma unroll
        for (int which = 0; which < 2; ++which) {
            f32x16 acc;
#pragma unroll
            for (int r = 0; r < 16; ++r) acc[r] = 0.f;
            const LAS unsigned char* tp = lds + (which ? GD_T2 : GD_T1) + (32 * mt + r32) * GD_ST + hi * 16;
            const int vb = (int)(uintptr_t)(lds + (which ? GD_KB : GD_VN)) + trb;
            s16x4 lo[4], hh[4];
            lo[0] = tr_read<0 * 16 * GD_SB>(vb); hh[0] = tr_read<0 * 16 * GD_SB + 4 * GD_SB>(vb); lo[1] = tr_read<1 * 16 * GD_SB>(vb); hh[1] = tr_read<1 * 16 * GD_SB + 4 * GD_SB>(vb);
            lo[2] = tr_read<2 * 16 * GD_SB>(vb); hh[2] = tr_read<2 * 16 * GD_SB + 4 * GD_SB>(vb); lo[3] = tr_read<3 * 16 * GD_SB>(vb); hh[3] = tr_read<3 * 16 * GD_SB + 4 * GD_SB>(vb);
            asm volatile("s_waitcnt lgkmcnt(0)" ::: "memory"); __builtin_amdgcn_sched_barrier(0);
#pragma unroll
            for (int ks = 0; ks < 4; ++ks) { const bf16x8 bfr = (bf16x8){lo[ks][0], lo[ks][1], lo[ks][2], lo[ks][3], hh[ks][0], hh[ks][1], hh[ks][2], hh[ks][3]};
                acc = __builtin_amdgcn_mfma_f32_32x32x16_bf16(*(const LAS bf16x8*)(tp + ks * 32), bfr, acc, 0, 0, 0); }
            if (which == 0) {
                float* uf = (float*)(gi + GDN_UF) + (size_t)nt * 2048 + (32 * mt + 4 * hi) * 32 + r32;
#pragma unroll
                for (int r = 0; r < 16; ++r) uf[((r & 3) + 8 * (r >> 2)) * 32] = acc[r];
            } else {
                const int dk = 32 * nt + r32, ks = dk >> 4, nn = dk & 15, hp = perm16_h(nn), jj = perm16_j(nn);
                bf16_t* wf = (bf16_t*)(gi + GDN_WF) + ((mt * 8 + ks) * 64 + hp * 32 + 4 * hi) * 8 + jj;
#pragma unroll
                for (int r = 0; r < 16; ++r) wf[((r & 3) + 8 * (r >> 2)) * 8] = (bf16_t)f2bf(acc[r]);
            }
        }
    }
#endif
    __syncthreads();
}
__device__ __forceinline__ void gdn_prep_phase(Frame& F, const Args& A) {
    for (int item = blockIdx.x; item < 1024; item += F.G) gdn_prep_item(F, A, item);
}

__device__ __forceinline__ bf16x8 pack8(const f32x16& a, int s) {
    v4u w; w.x = pg8::cvt_pk_bf16(a[8 * s + 0], a[8 * s + 1]); w.y = pg8::cvt_pk_bf16(a[8 * s + 2], a[8 * s + 3]); w.z = pg8::cvt_pk_bf16(a[8 * s + 4], a[8 * s + 5]); w.w = pg8::cvt_pk_bf16(a[8 * s + 6], a[8 * s + 7]);
    return __builtin_bit_cast(bf16x8, w);
}
__device__ __forceinline__ void gdn_scan_wave(Frame& F, int task) {
    const int lane = F.lane, r32 = lane & 31, hi = lane >> 5;
    const int bh = task >> 2, sl = task & 3, b = bh >> 2, h = bh & 3;
    float* oa = (float*)(F.ws + WS_OA);
    f32x16 st[4];
#pragma unroll
    for (int dt = 0; dt < 4; ++dt)
#pragma unroll
        for (int r = 0; r < 16; ++r) st[dt][r] = 0.f;
    for (int n = 0; n < 128; ++n) {
        const unsigned char* gi = F.ws + WS_GDN + (size_t)(bh * 128 + n) * GDN_ITEM;
        const bf16x8* wf = (const bf16x8*)(gi + GDN_WF) + lane; const bf16x8* qf = (const bf16x8*)(gi + GDN_QF) + lane;
        const bf16x8* af = (const bf16x8*)(gi + GDN_AF) + lane; const bf16x8* kf = (const bf16x8*)(gi + GDN_KF) + lane;
        const float* ufl = (const float*)(gi + GDN_UF) + (size_t)sl * 2048 + 4 * hi * 32 + r32; const float egl = *(const float*)(gi + GDN_EG);
        float* oap = oa + (size_t)(b * S + n * 64 + 4 * hi) * 512 + h * 128 + sl * 32 + r32;
        bf16x8 sb[8];
#pragma unroll
        for (int dt = 0; dt < 4; ++dt) { sb[2 * dt] = pack8(st[dt], 0); sb[2 * dt + 1] = pack8(st[dt], 1); }
        f32x16 vn[2], oc[2];
#pragma unroll
        for (int mt = 0; mt < 2; ++mt) {
            f32x16 ws_;
#pragma unroll
            for (int r = 0; r < 16; ++r) { ws_[r] = 0.f; oc[mt][r] = 0.f; }
#pragma unroll
            for (int ks = 0; ks < 8; ++ks) { ws_ = __builtin_amdgcn_mfma_f32_32x32x16_bf16(wf[(mt * 8 + ks) * 64], sb[ks], ws_, 0, 0, 0);
                                             oc[mt] = __builtin_amdgcn_mfma_f32_32x32x16_bf16(qf[(mt * 8 + ks) * 64], sb[ks], oc[mt], 0, 0, 0); }
#pragma unroll
            for (int r = 0; r < 16; ++r) vn[mt][r] = ufl[(32 * mt + (r & 3) + 8 * (r >> 2)) * 32] - ws_[r];
        }
        bf16x8 vb[4];
#pragma unroll
        for (int mt = 0; mt < 2; ++mt) { vb[2 * mt] = pack8(vn[mt], 0); vb[2 * mt + 1] = pack8(vn[mt], 1); }
#pragma unroll
        for (int mt = 0; mt < 2; ++mt) {
#pragma unroll
            for (int ks = 0; ks < 4; ++ks) oc[mt] = __builtin_amdgcn_mfma_f32_32x32x16_bf16(af[(mt * 4 + ks) * 64], vb[ks], oc[mt], 0, 0, 0);
#pragma unroll
            for (int r = 0; r < 16; ++r) oap[(size_t)(32 * mt + (r & 3) + 8 * (r >> 2)) * 512] = oc[mt][r];
        }
#pragma unroll
        for (int dt = 0; dt < 4; ++dt) {
#pragma unroll
            for (int r = 0; r < 16; ++r) st[dt][r] *= egl;
#pragma unroll
            for (int ks = 0; ks < 4; ++ks) st[dt] = __builtin_amdgcn_mfma_f32_32x32x16_bf16(kf[(dt * 4 + ks) * 64], vb[ks], st[dt], 0, 0, 0);
        }
    }
}
constexpr int CW_QUEUE = 64;
__device__ __forceinline__ void mixer_phase(Frame& F, const Args& A) {
    if (blockIdx.x < 32 && F.wave == 0) gdn_scan_wave(F, (int)blockIdx.x);
    unsigned* qctr = (unsigned*)(F.ws + WS_CTL) + CW_QUEUE;
    volatile LAS int* slot = (volatile LAS int*)(F.lds + 131072 + 64);
    for (;;) {
        __syncthreads();
        if (F.tid == 0) slot[0] = (int)__hip_atomic_fetch_add(qctr, 1u, __ATOMIC_RELAXED, __HIP_MEMORY_SCOPE_AGENT);
        __syncthreads();
        const int i = slot[0];
        if (i >= 512) break;
        const int qb = 31 - (i >> 4), x = i & 15;
        attn_unit(F, x >> 3, (x >> 1) & 3, x & 1, qb);
    }
}
__global__ void __launch_bounds__(NWAVES * 64, 2) mega(Args args) {
    extern __shared__ __attribute__((aligned(16))) unsigned char lds_raw[];
    Frame F;
    F.lds = (LAS unsigned char*)lds_raw;
    F.MISC = (volatile LAS unsigned*)(F.lds + MISC_OFF);
    F.tid = threadIdx.x; F.lane = F.tid & 63; F.wave = __builtin_amdgcn_readfirstlane(F.tid >> 6);
    F.G = gridDim.x; { const int bx = blockIdx.x; F.vcu = (F.G % 8 == 0) ? (bx % 8) * (F.G / 8) + bx / 8 : bx; }
    F.out = args.out; F.ws = args.ws;
    for (int u = F.tid; u < (LDS_BYTES - 131072) / 4; u += NWAVES * 64) ((LAS unsigned*)(F.lds + 131072))[u] = 0u;
    __syncthreads();
    const int lo = args.ph_lo, hi = args.ph_hi;
    XcdBarrier bar; bar.bar = (unsigned*)(F.ws + WS_CTL) + CW_BAR; bar.x = 0; bar.st = nullptr;
    if (hi - lo > 1) bar = xcd_barrier_post((unsigned*)(F.ws + WS_CTL) + CW_BAR, F.MISC + 8);
#ifndef PHASE_MASK
#define PHASE_MASK 0xffff
#endif
#define IN(k) (((PHASE_MASK >> (k)) & 1) && lo <= (k) && (k) < hi)
    if (IN(0)) { p0_phase(F, args); }
    if (IN(0) && IN(1)) xcd_barrier(bar);
    if (IN(1)) { norm_mod_phase<true, true>(F, args, args.in[0], args.in[4], 0, 1024, (bf16_t*)(F.ws + WS_H)); }
    if (IN(1) && IN(2)) xcd_barrier(bar);
    if (IN(2)) {
        pg8::Gemm g{(const bf16_t*)(F.ws + WS_H), (const bf16_t*)(F.ws + WS_WIN), T, LDP, D}; pg8::StaticOrder So; So.init(T, LDP, F.G, (int)blockIdx.x);
        pg8::EpiStoreBf16 E{(bf16_t*)(F.ws + WS_P), LDP, 0};
        pg8::gemm_phase<pg8::EpiStoreBf16, pg8::StaticOrder, true, true>(F.lds, g, So, E);
    }
    if (IN(2) && IN(3)) xcd_barrier(bar);
    if (IN(3)) { attn_prep_phase(F, args); gdn_prep_phase(F, args); }
    if (IN(3) && IN(4)) xcd_barrier(bar);
    if (IN(4)) { mixer_phase(F, args); }
    if (IN(4) && IN(5)) xcd_barrier(bar);
    if (IN(5)) { post_norm_phase(F, args); }
    if (IN(5) && IN(6)) xcd_barrier(bar);
    if (IN(6)) {
        { pg8::Gemm g{(const bf16_t*)(F.ws + WS_OAN), (const bf16_t*)(F.ws + WS_WOA), T, 1024, 512}; pg8::StaticOrder So; So.init(T, 1024, F.G, (int)blockIdx.x);
          pg8::EpiGate<false> E{(const bf16_t*)(F.ws + WS_P) + C_GA, nullptr, (bf16_t*)(F.ws + WS_TMPB), LDP, 0};
          pg8::gemm_phase<pg8::EpiGate<false>, pg8::StaticOrder, true, true>(F.lds, g, So, E); }
        { pg8::Gemm g{(const bf16_t*)(F.ws + WS_OBN), (const bf16_t*)(F.ws + WS_WOB), T, 1024, 512}; pg8::StaticOrder So; So.init(T, 1024, F.G, (int)blockIdx.x);
          pg8::EpiGate<true> E{(const bf16_t*)(F.ws + WS_P) + C_GB, (const bf16_t*)(F.ws + WS_TMPB), (bf16_t*)(F.ws + WS_MERGED), LDP, 0};
          pg8::gemm_phase<pg8::EpiGate<true>, pg8::StaticOrder, true, true>(F.lds, g, So, E); }
    }
    if (IN(6) && IN(7)) xcd_barrier(bar);
    if (IN(7)) {
        pg8::Gemm g{(const bf16_t*)(F.ws + WS_MERGED), (const bf16_t*)(F.ws + WS_WOUT), T, 1024, 1024}; pg8::StaticOrder So; So.init(T, 1024, F.G, (int)blockIdx.x);
        pg8::EpiResid E{args.in[0], (const float*)(F.ws + WS_MOD) + 2048, (float*)(F.ws + WS_X1)};
        pg8::gemm_phase<pg8::EpiResid, pg8::StaticOrder, true, true>(F.lds, g, So, E);
    }
    if (IN(7) && IN(8)) xcd_barrier(bar);
    if (IN(8)) { norm_mod_phase<false, false>(F, args, (const float*)(F.ws + WS_X1), args.in[20], 3072, 4096, (bf16_t*)(F.ws + WS_H)); }
    if (IN(8) && IN(9)) xcd_barrier(bar);
    if (IN(9)) {
        pg8::Gemm g{(const bf16_t*)(F.ws + WS_H), (const bf16_t*)(F.ws + WS_W9), T, 768, 1024}; pg8::StaticOrder So; So.init(T, 768, F.G, (int)blockIdx.x);
        pg8::EpiSharedRouter E{(bf16_t*)(F.ws + WS_SACT), (float*)(F.ws + WS_LOGITS)};
        pg8::gemm_phase<pg8::EpiSharedRouter, pg8::StaticOrder, true, true>(F.lds, g, So, E);
    }
    if (IN(9) && IN(10)) xcd_barrier(bar);
    if (IN(10)) { route_phase(F, args); }
    if (IN(10) && IN(11)) xcd_barrier(bar);
    if (IN(11)) { moe_phase(F, args); }
    if (IN(11) && IN(12)) xcd_barrier(bar);
    if (IN(12)) {
        pg8::Gemm g{(const bf16_t*)(F.ws + WS_SACT), (const bf16_t*)(F.ws + WS_WSD), T, 1024, 256}; pg8::StaticOrder So; So.init(T, 1024, F.G, (int)blockIdx.x);
        pg8::EpiFinal E{(const float*)(F.ws + WS_X1), (const float*)(F.ws + WS_MOD) + 5120, (const bf16_t*)(F.ws + WS_Y), F.out};
        pg8::gemm_phase<pg8::EpiFinal, pg8::StaticOrder, true, true>(F.lds, g, So, E);
    }
#undef IN
}
extern "C" void kernel_launch(void* const* d_in, const int* in_sizes, int n_in, void* d_out, int out_size, void* d_ws, size_t ws_size, hipStream_t stream) {
  static int grid = 0;
  if (grid == 0) {
    int dev = 0, cus = 0;
    if (n_in != 27 || out_size != T * D || ws_size < WS_END) { fprintf(stderr, "kernel_launch: unexpected problem (n_in %d, out %d, ws %zu < %zu)\n", n_in, out_size, ws_size, (size_t)WS_END); grid = -1; return; }
    if (hipGetDevice(&dev) != hipSuccess || hipDeviceGetAttribute(&cus, hipDeviceAttributeMultiprocessorCount, dev) != hipSuccess) { fprintf(stderr, "kernel_launch: device query failed\n"); grid = -1; return; }
    if (hipFuncSetAttribute((const void*)mega, hipFuncAttributeMaxDynamicSharedMemorySize, LDS_BYTES) != hipSuccess) { fprintf(stderr, "kernel_launch: hipFuncSetAttribute failed\n"); grid = -1; return; }
    int per_cu = 0;
    if (hipOccupancyMaxActiveBlocksPerMultiprocessor(&per_cu, (const void*)mega, NWAVES * 64, LDS_BYTES) != hipSuccess || per_cu < 1) fprintf(stderr, "kernel_launch: occupancy query says %d blocks per CU\n", per_cu);
    (void)hipGetLastError();
    grid = cus;
  }
  if (grid < 0) return;
  (void)hipMemsetAsync((unsigned char*)d_ws + WS_CTL, 0, CTL_ZERO_BYTES, stream);
  Args a{};
  for (int i = 0; i < 27; ++i) a.in[i] = (const float*)d_in[i];
  a.out = (float*)d_out; a.ws = (unsigned char*)d_ws;
#ifndef N_LAUNCH_PHASES
  a.ph_lo = 0; a.ph_hi = 13;
  hipLaunchKernelGGL(mega, dim3(grid), dim3(NWAVES * 64), LDS_BYTES, stream, a);
#else
  for (int ph = 0; ph < 13; ++ph) { a.ph_lo = ph; a.ph_hi = ph + 1; hipLaunchKernelGGL(mega, dim3(grid), dim3(NWAVES * 64), LDS_BYTES, stream, a); }
#endif
}
```

```cpp
#include <hip/hip_runtime.h>
#include <stdint.h>
#include <cstdio>

typedef unsigned short bf16_t;
constexpr int D = 1024, NB = 2, S = 8192, T = NB * S;
constexpr int INC = 5640;
constexpr int LDP = 5632;
constexpr int C_QA = 0, C_KA = 512, C_VA = 1024, C_ZA = 1536, C_QB = 2048, C_KB = 2560, C_VB = 3072, C_GA = 3584, C_GB = 4608;
constexpr int NE = 256, TOPK = 8, NA = T * TOPK;
constexpr float EPS = 1e-6f;
constexpr float LAM_INIT = 0.2f;
__device__ __forceinline__ float bf2f(bf16_t v) { return __uint_as_float(((unsigned)v) << 16); }
__device__ __forceinline__ float siluf(float x) { return x / (1.f + __expf(-x)); }
__device__ __forceinline__ float sigmf(float x) { return 1.f / (1.f + __expf(-x)); }
__device__ __forceinline__ float softplusf(float x) { return x > 20.f ? x : log1pf(__expf(x)); }
__device__ __forceinline__ float wave_sum(float v) {
#pragma unroll
  for (int o = 1; o < 64; o <<= 1) v += __shfl_xor(v, o);
  return v;
}
constexpr size_t MiB = 1u << 20;
constexpr size_t WS_CTL = 0, CTL_ZERO_BYTES = 1 * MiB;
constexpr size_t WS_MODP = 1 * MiB;
constexpr size_t WS_MOD = 1 * MiB + 256 * 1024;
constexpr size_t WS_SCAL = 1 * MiB + 320 * 1024;
constexpr size_t WS_WIN = 2 * MiB;
constexpr size_t WS_WOA = 13 * MiB, WS_WOB = 14 * MiB;
constexpr size_t WS_WOUT = 15 * MiB;
constexpr size_t WS_W9 = 17 * MiB;
constexpr size_t WS_WSD = 19 * MiB;
constexpr size_t WS_BD = 20 * MiB;
constexpr size_t WS_H = 32 * MiB;
constexpr size_t WS_P = 64 * MiB;
constexpr size_t WS_OAN = 240 * MiB, WS_OBN = 256 * MiB;
constexpr size_t WS_TMPB = 272 * MiB;
constexpr size_t WS_MERGED = 304 * MiB;
constexpr size_t WS_X1 = 336 * MiB;
constexpr size_t WS_LOGITS = 400 * MiB;
constexpr size_t WS_SACT = 416 * MiB;
constexpr size_t WS_TOPI = 424 * MiB, WS_TOPW = 425 * MiB;
constexpr size_t WS_Y = 432 * MiB;
constexpr size_t WS_ACTB = 704 * MiB;
constexpr size_t WS_LIST = 768 * MiB;
constexpr size_t WS_QN = 800 * MiB, WS_KN = 816 * MiB;
constexpr size_t WS_OB = 832 * MiB;
constexpr size_t WS_OA = 864 * MiB;
constexpr size_t WS_GDN = 896 * MiB;
constexpr size_t WS_END = 992 * MiB;
constexpr int CW_BAR = 4096;

#define GAS __attribute__((address_space(1)))
#define LAS __attribute__((address_space(3)))
typedef unsigned v4u __attribute__((ext_vector_type(4)));
typedef float f32x4 __attribute__((ext_vector_type(4)));
typedef short bf16x8 __attribute__((ext_vector_type(8)));
typedef GAS unsigned gu32;
typedef GAS unsigned long long gu64;
#define RLX_AGENT __ATOMIC_RELAXED, __HIP_MEMORY_SCOPE_AGENT
#define LDS_WAIT() asm volatile("s_waitcnt lgkmcnt(0)" ::: "memory")
#define VM_WAIT() asm volatile("s_waitcnt vmcnt(0)" ::: "memory")
__device__ __forceinline__ unsigned f2bf(float f) { unsigned u = __builtin_bit_cast(unsigned, f); return (u + 0x7fffu + ((u >> 16) & 1u)) >> 16; }
__device__ __forceinline__ unsigned pk2(float lo, float hi) { return f2bf(lo) | (f2bf(hi) << 16); }

constexpr int NWAVES = 8;
constexpr int LDS_BYTES = 147456;
constexpr int MISC_OFF = 131072 + 320;

struct Frame {
    LAS unsigned char* lds;
    volatile LAS unsigned* MISC;
    int tid, lane, wave, vcu, G;
    float* out; unsigned char* ws;
    const __attribute__((address_space(4))) unsigned char* karg;
};
#define KIN(k) (*(const float* const __attribute__((address_space(4)))*)(F.karg + 8 * (k)))
struct Args { const float* in[27]; float* out; unsigned char* ws; int ph_lo, ph_hi; };
namespace pg8 {
#define PG8_LAS __attribute__((address_space(3)))
typedef unsigned short bf16_t;
typedef short bf16x8 __attribute__((ext_vector_type(8)));
typedef float f32x4 __attribute__((ext_vector_type(4)));
typedef unsigned u32x4 __attribute__((ext_vector_type(4)));
constexpr int BM = 256, BK = 64, HALF = 128, HTB = HALF * BK * 2  , STAGE_BYTES = 8 * HTB, NXCD = 8, WGM = 8;

__host__ __device__ __forceinline__ int lds_byte(int r, int c) { const int st = (r >> 4) * 2 + (c >> 5), rr = r & 15, cc = c & 31, ob = rr * 64 + cc * 2; return st * 1024 + (ob ^ (((ob >> 9) & 1) << 5)); }
__host__ __device__ __forceinline__ void stage_rc(int b, int& R, int& C) { const int st = b / 1024, sb = b % 1024, swz = sb ^ (((sb >> 9) & 1) << 5); R = (st >> 1) * 16 + swz / 64; C = (st & 1) * 32 + (swz % 64) / 2; }
__host__ __device__ __forceinline__ int perm32(int rho) { const int n = rho >> 4, i = rho & 15; return 8 * (i >> 2) + 4 * n + (i & 3); }

struct Unit { int pm, pn; };
struct Gemm { const bf16_t* A; const bf16_t* Bt; int M, N, K; };

struct StaticOrder {
    int nM, nN, nwg, G, c;
    __host__ __device__ void init(int M, int N, int G_, int c_) { nM = M / BM; nN = N / BM; nwg = nM * nN; G = G_; c = c_; }
    __host__ __device__ bool next(int i, Unit& u) const {
        const long L = (long)i * G + c; if (L >= nwg) return false;
        int wgid = (int)L; { const int q = nwg / NXCD, r = nwg % NXCD, xcd = wgid % NXCD, off = wgid / NXCD; wgid = (xcd < r ? xcd * (q + 1) : r * (q + 1) + (xcd - r) * q) + off; }
        const int nig = WGM * nN, gid = wgid / nig, fm = gid * WGM, gsz = (nM - fm) < WGM ? (nM - fm) : WGM;
        u.pm = fm + ((wgid % nig) % gsz); u.pn = (wgid % nig) / gsz; return true;
    }
    __device__ __forceinline__ void a_ready(const Unit&) const {}
    __device__ __forceinline__ void done(const Unit&) const {}
};

__device__ __forceinline__ unsigned cvt_pk_bf16(float lo, float hi) { unsigned r; asm volatile("v_cvt_pk_bf16_f32 %0, %1, %2" : "=v"(r) : "v"(lo), "v"(hi)); return r; }
typedef float f32x2 __attribute__((ext_vector_type(2)));
template <class Epi, class Sched, bool ALIGN_EPI = false, bool SP2 = false>
__device__ __forceinline__ void gemm_phase(PG8_LAS unsigned char* lds, const Gemm g, const Sched& S, const Epi& E) {
    const int tid = threadIdx.x, wid = __builtin_amdgcn_readfirstlane(tid >> 6), lane = tid & 63, wr = wid >> 2, wc = wid & 3, fr = lane & 15, fq = lane >> 4;
    const int K = g.K, nt = K / BK;
    unsigned voffA[2], voffB[2];
#pragma unroll
    for (int i = 0; i < 2; ++i) { int R, C; stage_rc(tid * 16 + i * 8192, R, C); const int Rb = Epi::PERM ? ((R & ~31) + perm32(R & 31)) : R;
        voffA[i] = (unsigned)(R * K + C) * 2u; voffB[i] = (unsigned)(Rb * K + C) * 2u; }
    const size_t kstep = (size_t)(BK * 2);
    const size_t hstep = (size_t)HALF * K * 2;
    const size_t tstep = 2 * hstep;
    const unsigned ldsw = (unsigned)wid * 1024u;
    const int aoff = lds_byte(wr * 64 + fr, fq * 8), boff = lds_byte(wc * 32 + fr, fq * 8);
#define PG8_SA(b, h) (((b) * 2 + (h)) * HTB)
#define PG8_SB(b, h) ((4 + (b) * 2 + (h)) * HTB)
#define PG8_STAGE(bufoff, gbase, voff) do { _Pragma("unroll") for (int _i = 0; _i < 2; ++_i) \
        __builtin_amdgcn_global_load_lds((const unsigned*)((const char*)(gbase) + (voff)[_i]), (PG8_LAS unsigned*)(lds + (bufoff) + ldsw + _i * 8192), 16, 0, 0); } while (0)
#define PG8_LDA(dst, b, h) do { _Pragma("unroll") for (int m = 0; m < 4; ++m) _Pragma("unroll") for (int k = 0; k < 2; ++k) dst[m][k] = *(const PG8_LAS bf16x8*)(lds + PG8_SA(b, h) + aoff + m * 2048 + k * 1024); } while (0)
#define PG8_LDB(dst, b, h) do { _Pragma("unroll") for (int n = 0; n < 2; ++n) _Pragma("unroll") for (int k = 0; k < 2; ++k) dst[n][k] = *(const PG8_LAS bf16x8*)(lds + PG8_SB(b, h) + boff + n * 2048 + k * 1024); } while (0)
#define PG8_MMA(ai, bj, At, Bt) do { __builtin_amdgcn_s_setprio(1); _Pragma("unroll") for (int m = 0; m < 4; ++m) _Pragma("unroll") for (int n = 0; n < 2; ++n) _Pragma("unroll") for (int k = 0; k < 2; ++k) \
        acc[ai][bj][m][n] = __builtin_amdgcn_mfma_f32_16x16x32_bf16(Bt[n][k], At[m][k], acc[ai][bj][m][n], 0, 0, 0); __builtin_amdgcn_s_setprio(0); } while (0)
#define PG8_WAIT_V(n) asm volatile("s_waitcnt vmcnt(" #n ")" ::: "memory")
#define PG8_WAIT_L(n) asm volatile("s_waitcnt lgkmcnt(" #n ")" ::: "memory")
#define PG8_BAR __builtin_amdgcn_s_barrier()
#define PG8_SCHED __builtin_amdgcn_sched_barrier(0)
    Unit cur, nxt; int ui = 0;
    if (!S.next(0, cur)) return;
    f32x4 acc[2][2][4][2];
#pragma unroll
    for (int a = 0; a < 2; ++a)
#pragma unroll
        for (int b = 0; b < 2; ++b)
#pragma unroll
            for (int m = 0; m < 4; ++m)
#pragma unroll
                for (int n = 0; n < 2; ++n) acc[a][b][m][n] = (f32x4){0.f, 0.f, 0.f, 0.f};
    bf16x8 At[4][2], B0[2][2], B1[2][2];
    const char* cA = (const char*)g.A + (size_t)cur.pm * tstep; const char* cB = (const char*)g.Bt + (size_t)cur.pn * tstep;
    S.a_ready(cur);
    if constexpr (SP2) {
        PG8_STAGE(PG8_SB(0, 0), cB, voffB); PG8_STAGE(PG8_SB(0, 1), cB + hstep, voffB); PG8_STAGE(PG8_SA(0, 0), cA, voffA); PG8_STAGE(PG8_SA(0, 1), cA + hstep, voffA);
        if (wr == 1) PG8_BAR;
        PG8_WAIT_V(2); PG8_BAR;
        PG8_STAGE(PG8_SB(1, 0), cB + kstep, voffB); PG8_STAGE(PG8_SA(1, 0), cA + kstep, voffA); PG8_STAGE(PG8_SB(1, 1), cB + hstep + kstep, voffB);
        PG8_WAIT_V(6); PG8_BAR;
    } else {
        PG8_STAGE(PG8_SB(0, 0), cB, voffB); PG8_STAGE(PG8_SA(0, 0), cA, voffA); PG8_STAGE(PG8_SB(0, 1), cB + hstep, voffB); PG8_STAGE(PG8_SA(0, 1), cA + hstep, voffA);
        if (wr == 1) PG8_BAR;
        PG8_WAIT_V(4); PG8_BAR;
        PG8_STAGE(PG8_SB(1, 0), cB + kstep, voffB); PG8_STAGE(PG8_SA(1, 0), cA + kstep, voffA); PG8_STAGE(PG8_SB(1, 1), cB + hstep + kstep, voffB);
        PG8_WAIT_V(6); PG8_BAR;
    }
    for (;;) {
        const bool has_next = S.next(ui + 1, nxt);
        const char* nA = has_next ? (const char*)g.A + (size_t)nxt.pm * tstep : cA; const char* nB = has_next ? (const char*)g.Bt + (size_t)nxt.pn * tstep : cB;
        for (int t = 0; t < nt; t += 2) {
            const bool last = (t == nt - 2);
            const char* a1 = cA + (size_t)(t + 1) * kstep;
            const char* a2 = last ? nA : cA + (size_t)(t + 2) * kstep; const char* b2 = last ? nB : cB + (size_t)(t + 2) * kstep;
            const char* a3 = a2 + kstep; const char* b3 = b2 + kstep;
            if (last && has_next) S.a_ready(nxt);
            if constexpr (SP2) {
            PG8_LDB(B0, 0, 0); PG8_LDB(B1, 0, 1); PG8_SCHED; PG8_LDA(At, 0, 0); PG8_STAGE(PG8_SA(1, 1), a1 + hstep, voffA);
            PG8_WAIT_V(8); PG8_WAIT_L(0); PG8_BAR; PG8_MMA(0, 0, At, B0); PG8_MMA(0, 1, At, B1); PG8_BAR; PG8_SCHED;
            PG8_LDA(At, 0, 1); PG8_STAGE(PG8_SB(0, 0), b2, voffB); PG8_STAGE(PG8_SB(0, 1), b2 + hstep, voffB); PG8_STAGE(PG8_SA(0, 0), a2, voffA);
            PG8_WAIT_V(8); PG8_WAIT_L(0); PG8_BAR; PG8_MMA(1, 0, At, B0); PG8_MMA(1, 1, At, B1); PG8_BAR; PG8_SCHED;
            PG8_LDB(B0, 1, 0); PG8_LDB(B1, 1, 1); PG8_SCHED; PG8_LDA(At, 1, 0); PG8_STAGE(PG8_SA(0, 1), a2 + hstep, voffA);
            PG8_WAIT_V(8); PG8_WAIT_L(0); PG8_BAR; PG8_MMA(0, 0, At, B0); PG8_MMA(0, 1, At, B1); PG8_BAR; PG8_SCHED;
            PG8_LDA(At, 1, 1); PG8_STAGE(PG8_SB(1, 0), b3, voffB); PG8_STAGE(PG8_SB(1, 1), b3 + hstep, voffB); PG8_STAGE(PG8_SA(1, 0), a3, voffA);
            PG8_WAIT_V(8); PG8_WAIT_L(0); PG8_BAR; PG8_MMA(1, 0, At, B0); PG8_MMA(1, 1, At, B1); PG8_BAR; PG8_SCHED;
            } else {
            PG8_LDB(B0, 0, 0); PG8_SCHED; PG8_LDA(At, 0, 0); PG8_STAGE(PG8_SA(1, 1), a1 + hstep, voffA);
            PG8_WAIT_L(8); PG8_BAR; PG8_WAIT_L(0); PG8_MMA(0, 0, At, B0); PG8_BAR; PG8_SCHED;
            PG8_LDB(B1, 0, 1); PG8_STAGE(PG8_SB(0, 0), b2, voffB);
            PG8_BAR; PG8_WAIT_L(0); PG8_MMA(0, 1, At, B1); PG8_BAR;
            PG8_LDA(At, 0, 1); PG8_STAGE(PG8_SA(0, 0), a2, voffA);
            PG8_BAR; PG8_WAIT_L(0); PG8_MMA(1, 0, At, B0); PG8_BAR; PG8_SCHED;
            PG8_STAGE(PG8_SB(0, 1), b2 + hstep, voffB);
            PG8_WAIT_V(6); PG8_BAR; PG8_MMA(1, 1, At, B1); PG8_BAR;
            PG8_LDB(B0, 1, 0); PG8_SCHED; PG8_LDA(At, 1, 0); PG8_STAGE(PG8_SA(0, 1), a2 + hstep, voffA);
            PG8_WAIT_L(8); PG8_BAR; PG8_WAIT_L(0); PG8_MMA(0, 0, At, B0); PG8_BAR; PG8_SCHED;
            PG8_LDB(B1, 1, 1); PG8_STAGE(PG8_SB(1, 0), b3, voffB);
            PG8_BAR; PG8_WAIT_L(0); PG8_MMA(0, 1, At, B1); PG8_BAR;
            PG8_LDA(At, 1, 1); PG8_STAGE(PG8_SA(1, 0), a3, voffA);
            PG8_BAR; PG8_WAIT_L(0); PG8_MMA(1, 0, At, B0); PG8_BAR; PG8_SCHED;
            PG8_STAGE(PG8_SB(1, 1), b3 + hstep, voffB);
            PG8_WAIT_V(6); PG8_BAR; PG8_MMA(1, 1, At, B1); PG8_BAR;
            }
        }
        if constexpr (ALIGN_EPI) { if (wr == 0) PG8_BAR; }
        if constexpr (!Epi::AFTER_DRAIN) { E(acc, cur, wr, wc, fr, fq); S.done(cur); }
        if (!has_next) break;
#pragma unroll
        for (int a = 0; a < 2; ++a)
#pragma unroll
            for (int b = 0; b < 2; ++b)
#pragma unroll
                for (int m = 0; m < 4; ++m)
#pragma unroll
                    for (int n = 0; n < 2; ++n) acc[a][b][m][n] = (f32x4){0.f, 0.f, 0.f, 0.f};
        cur = nxt; cA = nA; cB = nB; ++ui;
        if constexpr (ALIGN_EPI) { if (wr == 1) PG8_BAR; }
    }
    PG8_WAIT_V(0);
    if constexpr (!ALIGN_EPI) { if (wr == 0) PG8_BAR; }
    PG8_BAR;
    if constexpr (Epi::AFTER_DRAIN) { E.fused(acc, cur, wr, wc, fr, fq, lds, wid, lane); S.done(cur); }
#undef PG8_SA
#undef PG8_SB
#undef PG8_STAGE
#undef PG8_LDA
#undef PG8_LDB
#undef PG8_MMA
#undef PG8_WAIT_V
#undef PG8_WAIT_L
#undef PG8_BAR
#undef PG8_SCHED
}
}
namespace pg8 {
struct EpiStoreBf16 {
    static constexpr bool PERM = true, AFTER_DRAIN = false;
    bf16_t* O; int ldc; int pad;
    __device__ __forceinline__ void operator()(const f32x4 (&acc)[2][2][4][2], const Unit& u, int wr, int wc, int fr, int fq) const {
        const int row0 = u.pm * BM + wr * 64 + fr, col0 = u.pn * BM + wc * 32 + 8 * fq;
#pragma unroll
        for (int ai = 0; ai < 2; ++ai)
#pragma unroll
            for (int m = 0; m < 4; ++m) { bf16_t* rowp = O + (size_t)(row0 + ai * HALF + m * 16) * ldc + col0;
#pragma unroll
                for (int bj = 0; bj < 2; ++bj) { const f32x4 v0 = acc[ai][bj][m][0], v1 = acc[ai][bj][m][1];
                    u32x4 w; w.x = cvt_pk_bf16(v0[0], v0[1]); w.y = cvt_pk_bf16(v0[2], v0[3]); w.z = cvt_pk_bf16(v1[0], v1[1]); w.w = cvt_pk_bf16(v1[2], v1[3]);
                    *(u32x4*)(rowp + bj * HALF) = w; } }
    }
};
__device__ __forceinline__ float bflo(unsigned w) { return __uint_as_float(w << 16); }
__device__ __forceinline__ float bfhi(unsigned w) { return __uint_as_float(w & 0xffff0000u); }
__device__ __forceinline__ float sigm(float x) { return __builtin_amdgcn_rcpf(1.f + __expf(-x)); }
template <bool ADD> struct EpiGate {
    static constexpr bool PERM = true, AFTER_DRAIN = false;
    const bf16_t* gate; const bf16_t* prev; bf16_t* O; int ldg; int pad;
    __device__ __forceinline__ void operator()(const f32x4 (&acc)[2][2][4][2], const Unit& u, int wr, int wc, int fr, int fq) const {
        const int row0 = u.pm * BM + wr * 64 + fr, col0 = u.pn * BM + wc * 32 + 8 * fq;
#pragma unroll
        for (int ai = 0; ai < 2; ++ai)
#pragma unroll
            for (int m = 0; m < 4; ++m) { const size_t r = (size_t)(row0 + ai * HALF + m * 16);
#pragma unroll
                for (int bj = 0; bj < 2; ++bj) { const int c = col0 + bj * HALF;
                    const u32x4 gw = *(const u32x4*)(gate + r * ldg + c);
                    const f32x4 v0 = acc[ai][bj][m][0], v1 = acc[ai][bj][m][1];
                    float o[8];
                    o[0] = sigm(bflo(gw.x)) * v0[0]; o[1] = sigm(bfhi(gw.x)) * v0[1]; o[2] = sigm(bflo(gw.y)) * v0[2]; o[3] = sigm(bfhi(gw.y)) * v0[3];
                    o[4] = sigm(bflo(gw.z)) * v1[0]; o[5] = sigm(bfhi(gw.z)) * v1[1]; o[6] = sigm(bflo(gw.w)) * v1[2]; o[7] = sigm(bfhi(gw.w)) * v1[3];
                    if (ADD) { const u32x4 pw = *(const u32x4*)(prev + r * 1024 + c);
                        o[0] += bflo(pw.x); o[1] += bfhi(pw.x); o[2] += bflo(pw.y); o[3] += bfhi(pw.y); o[4] += bflo(pw.z); o[5] += bfhi(pw.z); o[6] += bflo(pw.w); o[7] += bfhi(pw.w); }
                    u32x4 w; w.x = cvt_pk_bf16(o[0], o[1]); w.y = cvt_pk_bf16(o[2], o[3]); w.z = cvt_pk_bf16(o[4], o[5]); w.w = cvt_pk_bf16(o[6], o[7]);
                    *(u32x4*)(O + r * 1024 + c) = w; } }
    }
};
struct EpiResid {
    static constexpr bool PERM = false, AFTER_DRAIN = false;
    const float* base; const float* gvec; float* out;
    __device__ __forceinline__ void operator()(const f32x4 (&acc)[2][2][4][2], const Unit& u, int wr, int wc, int fr, int fq) const {
        const int row0 = u.pm * BM + wr * 64 + fr, col0 = u.pn * BM + wc * 32 + 4 * fq;
        const float* gv = gvec + ((u.pm * BM) / 8192) * 6144;
#pragma unroll
        for (int bj = 0; bj < 2; ++bj)
#pragma unroll
            for (int n = 0; n < 2; ++n) { const int c = col0 + bj * HALF + n * 16; const f32x4 g = *(const f32x4*)(gv + c);
#pragma unroll
                for (int ai = 0; ai < 2; ++ai)
#pragma unroll
                    for (int m = 0; m < 4; ++m) { const size_t off = (size_t)(row0 + ai * HALF + m * 16) * 1024 + c;
                        const f32x4 b = *(const f32x4*)(base + off); *(f32x4*)(out + off) = b + g * acc[ai][bj][m][n]; } }
    }
};
struct EpiSharedRouter {
    static constexpr bool PERM = true, AFTER_DRAIN = false;
    bf16_t* sact; float* logits;
    __device__ __forceinline__ void operator()(const f32x4 (&acc)[2][2][4][2], const Unit& u, int wr, int wc, int fr, int fq) const {
        const int row0 = u.pm * BM + wr * 64 + fr;
        if (u.pn < 2) {
#pragma unroll
            for (int ai = 0; ai < 2; ++ai)
#pragma unroll
                for (int m = 0; m < 4; ++m) { const size_t r = (size_t)(row0 + ai * HALF + m * 16);
#pragma unroll
                    for (int bj = 0; bj < 2; ++bj) { const int c8 = (u.pn * BM + bj * HALF + wc * 32 + 8 * fq) >> 1;
                        const f32x4 g = acc[ai][bj][m][0], up = acc[ai][bj][m][1];
                        float a0 = g[0] * sigm(g[0]) * up[0], a1 = g[1] * sigm(g[1]) * up[1], a2 = g[2] * sigm(g[2]) * up[2], a3 = g[3] * sigm(g[3]) * up[3];
                        uint2 w; w.x = cvt_pk_bf16(a0, a1); w.y = cvt_pk_bf16(a2, a3);
                        *(uint2*)(sact + r * 256 + c8) = w; } }
        } else {
#pragma unroll
            for (int ai = 0; ai < 2; ++ai)
#pragma unroll
                for (int m = 0; m < 4; ++m) { const size_t r = (size_t)(row0 + ai * HALF + m * 16);
#pragma unroll
                    for (int bj = 0; bj < 2; ++bj) { const int c = bj * HALF + wc * 32 + 8 * fq;
                        *(f32x4*)(logits + r * 256 + c) = acc[ai][bj][m][0]; *(f32x4*)(logits + r * 256 + c + 4) = acc[ai][bj][m][1]; } }
        }
    }
};
struct EpiFinal {
    static constexpr bool PERM = false, AFTER_DRAIN = false;
    const float* x1; const float* gvec; const bf16_t* Y; float* out;
    __device__ __forceinline__ void operator()(const f32x4 (&acc)[2][2][4][2], const Unit& u, int wr, int wc, int fr, int fq) const {
        const int row0 = u.pm * BM + wr * 64 + fr, col0 = u.pn * BM + wc * 32 + 4 * fq;
        const float* gv = gvec + ((u.pm * BM) / 8192) * 6144;
#pragma unroll
        for (int ai = 0; ai < 2; ++ai)
#pragma unroll
            for (int m = 0; m < 4; ++m) { const size_t r = (size_t)(row0 + ai * HALF + m * 16);
#pragma unroll
                for (int bj = 0; bj < 2; ++bj)
#pragma unroll
                    for (int n = 0; n < 2; ++n) { const int c = col0 + bj * HALF + n * 16;
                        f32x4 s = acc[ai][bj][m][n];
#pragma unroll
                        for (int k = 0; k < 8; ++k) { const uint2 yw = *(const uint2*)(Y + (r * 8 + k) * 1024 + c);
                            s[0] += bflo(yw.x); s[1] += bfhi(yw.x); s[2] += bflo(yw.y); s[3] += bfhi(yw.y); }
                        const f32x4 g = *(const f32x4*)(gv + c); const f32x4 b = *(const f32x4*)(x1 + r * 1024 + c);
                        *(f32x4*)(out + r * 1024 + c) = b + g * s; } }
    }
};
}
#define XB_TMO      128
#define XB_XCNT(j)  (256  + 64 * (j))
#define XB_XSUB(j)  (1280 + 64 * (j))
#define XB_XGEN(j)  (2304 + 64 * (j))
#define XB_TOP      3328
#define XB_TOPGEN   3392
#define XCD_BAR_WORDS 3456
#define XB_SPIN_CAP (1u << 18)

__device__ __forceinline__ unsigned xb_ld(unsigned* p)              { return __hip_atomic_load(p, __ATOMIC_RELAXED, __HIP_MEMORY_SCOPE_AGENT); }
__device__ __forceinline__ unsigned xb_add(unsigned* p, unsigned v) { return __hip_atomic_fetch_add(p, v, __ATOMIC_RELAXED, __HIP_MEMORY_SCOPE_AGENT); }
__device__ __forceinline__ unsigned xb_xcc_id() { return (unsigned)__builtin_amdgcn_s_getreg((3 << 11) | 20) & 0xFu; }
#define XB_SPIN(cond, bar) do { unsigned _sp = 0; while (cond) { __builtin_amdgcn_s_sleep(1); \
    if ((++_sp & 255u) == 0u) { if (xb_ld(&(bar)[XB_TMO])) break; if (_sp > XB_SPIN_CAP) { atomicAdd(&(bar)[XB_TMO], 1u); break; } } } } while (0)

struct XcdBarrier {
    unsigned* bar; unsigned x;
    volatile LAS unsigned* st;
};

__device__ __forceinline__ XcdBarrier xcd_barrier_post(unsigned* bar, volatile LAS unsigned* st) {
    XcdBarrier b; b.bar = bar; b.x = xb_xcc_id(); b.st = st;
    if (threadIdx.x == 0) (void)xb_add(&bar[XB_XCNT(b.x)], 1u);
    return b;
}
__device__ __forceinline__ void xcd_barrier_complete(unsigned* bar, unsigned x, unsigned& nloc, unsigned& nx) {
    const unsigned G = gridDim.x * gridDim.y * gridDim.z;
    unsigned sum, cnt, mine, sp = 0u;
    for (;;) {
        sum = 0u; cnt = 0u; mine = 0u;
#pragma unroll
        for (unsigned j = 0; j < 16; ++j) { const unsigned c = xb_ld(&bar[XB_XCNT(j)]); sum += c; cnt += (c > 0u) ? 1u : 0u; mine = (j == x) ? c : mine; }
        if (sum == G) break;
        __builtin_amdgcn_s_sleep(1);
        if ((++sp & 255u) == 0u) { if (xb_ld(&bar[XB_TMO])) break; if (sp > XB_SPIN_CAP) { atomicAdd(&bar[XB_TMO], 1u); break; } }
    }
    nloc = mine > 0u ? mine : 1u; nx = cnt > 0u ? cnt : 1u;
}

__device__ __forceinline__ void xcd_barrier(const XcdBarrier& b) {
    asm volatile("s_waitcnt vmcnt(0)" ::: "memory");
    __syncthreads();
    if (threadIdx.x == 0) {
        unsigned* bar = b.bar;
        __builtin_amdgcn_s_waitcnt(0);
        unsigned nloc = b.st[0], nx = b.st[1];
        if (nloc == 0u) { xcd_barrier_complete(bar, b.x, nloc, nx); b.st[0] = nloc; b.st[1] = nx; }
        const unsigned old = xb_add(&bar[XB_XSUB(b.x)], 1u);
        const unsigned gen = old / nloc;
        if (old + 1u == (gen + 1u) * nloc) {
            __builtin_amdgcn_fence(__ATOMIC_RELEASE, "agent");
            asm volatile("s_waitcnt vmcnt(0)" ::: "memory");
            const unsigned og = xb_add(&bar[XB_TOP], 1u);
            const unsigned tg = og / nx;
            if (og + 1u == (tg + 1u) * nx) xb_add(&bar[XB_TOPGEN], 1u);
            else XB_SPIN(xb_ld(&bar[XB_TOPGEN]) == tg, bar);
            __builtin_amdgcn_fence(__ATOMIC_ACQUIRE, "agent");
            xb_add(&bar[XB_XGEN(b.x)], 1u);
            asm volatile("s_waitcnt vmcnt(0)" ::: "memory");
        } else {
            XB_SPIN(xb_ld(&bar[XB_XGEN(b.x)]) == gen, bar);
            __builtin_amdgcn_fence(__ATOMIC_ACQUIRE, "agent");
            asm volatile("s_waitcnt vmcnt(0)" ::: "memory");
        }
    }
    __syncthreads();
}
template <class Map>
__device__ __forceinline__ void transpose_item(const float* W, int ldw, int K, bf16_t* WT, int row_off, int nblk, LAS float* scr, int item, int lane, Map srccol) {
    const int kb = item / nblk, nb = item % nblk, k0 = 64 * kb, n0 = 32 * nb;
    const int sc = srccol(n0 + (lane & 31));
#pragma unroll 8
    for (int i = 0; i < 32; ++i) { const int kk = 2 * i + (lane >> 5); scr[kk * 33 + (lane & 31)] = W[(size_t)(k0 + kk) * ldw + sc]; }
    LDS_WAIT(); asm volatile("" ::: "memory");
    const int c = lane & 7;
#pragma unroll
    for (int j = 0; j < 4; ++j) { const int n = (lane >> 3) + 8 * j; const LAS float* s = scr + (8 * c) * 33 + n;
        v4u o; o.x = pk2(s[0 * 33], s[1 * 33]); o.y = pk2(s[2 * 33], s[3 * 33]); o.z = pk2(s[4 * 33], s[5 * 33]); o.w = pk2(s[6 * 33], s[7 * 33]);
        *(v4u*)(WT + (size_t)(row_off + n0 + n) * K + k0 + 8 * c) = o; }
    LDS_WAIT(); asm volatile("" ::: "memory");
}
__device__ __forceinline__ void p0_phase(Frame& F, const Args& A) {
    LAS float* scr = (LAS float*)(F.lds + F.wave * 16384);
    const int gw = F.vcu * NWAVES + F.wave, NGW = F.G * NWAVES, lane = F.lane;
    const float* c = A.in[1]; const float* w_ada = A.in[2]; const float* w_in = A.in[5];
    const float* w_o_gdn = A.in[10]; const float* w_o_diff = A.in[18]; const float* w_out = A.in[19]; const float* w_router = A.in[21];
    const float* ws_gu = A.in[25]; const float* ws_dn = A.in[26];
    constexpr int I_MOD = 96 * 4, I_WIN = 16 * 176, I_WOA = 8 * 32, I_WOB = 8 * 32, I_WOUT = 16 * 32, I_SGU = 16 * 16, I_RT = 16 * 8, I_SD = 4 * 32;
    constexpr int NITEMS = I_MOD + I_WIN + I_WOA + I_WOB + I_WOUT + I_SGU + I_RT + I_SD;
    for (int it = gw; it < NITEMS; it += NGW) {
        int r = it;
        if (r < I_MOD) {
            const int eb = r >> 2, dc = r & 3, e = eb * 64 + lane; float a0 = 0.f, a1 = 0.f;
#pragma unroll 8
            for (int d = dc * 256; d < dc * 256 + 256; ++d) { const float w = w_ada[(size_t)d * 6144 + e]; a0 += siluf(c[d]) * w; a1 += siluf(c[D + d]) * w; }
            float* modp = (float*)(F.ws + WS_MODP) + dc * 12288; modp[e] = a0; modp[6144 + e] = a1; continue; }
        r -= I_MOD;
        if (r < I_WIN) { transpose_item(w_in, INC, 1024, (bf16_t*)(F.ws + WS_WIN), 0, 176, scr, r, lane, [](int n) { return n < 2048 ? n : n + 8; }); continue; } r -= I_WIN;
        if (r < I_WOA) { transpose_item(w_o_gdn, 1024, 512, (bf16_t*)(F.ws + WS_WOA), 0, 32, scr, r, lane, [](int n) { return n; }); continue; } r -= I_WOA;
        if (r < I_WOB) { transpose_item(w_o_diff, 1024, 512, (bf16_t*)(F.ws + WS_WOB), 0, 32, scr, r, lane, [](int n) { return n; }); continue; } r -= I_WOB;
        if (r < I_WOUT) { transpose_item(w_out, 1024, 1024, (bf16_t*)(F.ws + WS_WOUT), 0, 32, scr, r, lane, [](int n) { return n; }); continue; } r -= I_WOUT;
        if (r < I_SGU) { transpose_item(ws_gu, 512, 1024, (bf16_t*)(F.ws + WS_W9), 0, 16, scr, r, lane, [](int n) { const int i8 = n >> 3, j = n & 7; return j < 4 ? 4 * i8 + j : 256 + 4 * i8 + (j - 4); }); continue; } r -= I_SGU;
        if (r < I_RT) { transpose_item(w_router, 256, 1024, (bf16_t*)(F.ws + WS_W9), 512, 8, scr, r, lane, [](int n) { return n; }); continue; } r -= I_RT;
        transpose_item(ws_dn, 1024, 256, (bf16_t*)(F.ws + WS_WSD), 0, 32, scr, r, lane, [](int n) { return n; });
    }
    if (gw == 0) {
        const float s1 = wave_sum(A.in[13][lane] * A.in[14][lane]), s2 = wave_sum(A.in[15][lane] * A.in[16][lane]);
        float qm = fabsf(A.in[11][lane]), km = fabsf(A.in[12][lane]);
#pragma unroll
        for (int o = 1; o < 64; o <<= 1) { qm = fmaxf(qm, __shfl_xor(qm, o)); km = fmaxf(km, __shfl_xor(km, o)); }
        if (lane == 0) { float* sc = (float*)(F.ws + WS_SCAL); sc[0] = expf(s1) - expf(s2) + LAM_INIT; sc[1] = 8.f * qm * km * 1.4426950408889634f; }
    }
}
__device__ __forceinline__ float mod_reduce(const float* modp, const float* b_ada, int idx) {
    return ((modp[idx] + modp[12288 + idx]) + (modp[2 * 12288 + idx] + modp[3 * 12288 + idx])) + b_ada[idx % 6144];
}
template <bool FROM_PARTIALS, bool WITH_BD>
__device__ __forceinline__ void norm_mod_phase(Frame& F, const Args& A, const float* src, const float* gain, int sh_off, int sc_off, bf16_t* dst) {
    LAS float* shs = (LAS float*)F.lds;
    LAS float* scs = shs + 2048;
    LAS float* wbd = scs + 2048;
    const float* modp = (const float*)(F.ws + WS_MODP); const float* b_ada = A.in[3]; float* mod = (float*)(F.ws + WS_MOD);
    for (int i = F.tid; i < 4096; i += NWAVES * 64) { const int b = i >> 11, r = i & 2047; const int idx = b * 6144 + (r < 1024 ? sh_off + r : sc_off + r - 1024);
        const float v = FROM_PARTIALS ? mod_reduce(modp, b_ada, idx) : mod[idx];
        if (r < 1024) shs[b * 1024 + r] = v; else scs[b * 1024 + r - 1024] = v; }
    if (WITH_BD) { const float* w_in = A.in[5]; for (int i = F.tid; i < 8192; i += NWAVES * 64) wbd[i] = w_in[(size_t)(i >> 3) * INC + 2048 + (i & 7)]; }
    if (FROM_PARTIALS) for (int idx = blockIdx.x * (NWAVES * 64) + F.tid; idx < 12288; idx += F.G * NWAVES * 64) mod[idx] = mod_reduce(modp, b_ada, idx);
    __syncthreads();
    const int gw = F.vcu * NWAVES + F.wave, NGW = F.G * NWAVES, lane = F.lane;
    for (int row = gw; row < T; row += NGW) {
        const int b = row / S; const float* xr = src + (size_t)row * D;
        f32x4 v[4]; float ss = 0.f;
#pragma unroll
        for (int j = 0; j < 4; ++j) { v[j] = *(const f32x4*)(xr + j * 256 + lane * 4); ss += (v[j][0] * v[j][0] + v[j][1] * v[j][1]) + (v[j][2] * v[j][2] + v[j][3] * v[j][3]); }
        const float rs = rsqrtf(wave_sum(ss) * (1.f / D) + EPS);
        float bacc[8];
#pragma unroll
        for (int q = 0; q < 8; ++q) bacc[q] = 0.f;
#pragma unroll
        for (int j = 0; j < 4; ++j) { const int col = j * 256 + lane * 4; const f32x4 gn = *(const f32x4*)(gain + col);
            const f32x4 sh = *(const LAS f32x4*)(shs + b * 1024 + col), sc = *(const LAS f32x4*)(scs + b * 1024 + col);
            f32x4 hv = (v[j] * rs * gn) * (sc + 1.f) + sh;
            uint2 w; w.x = pk2(hv[0], hv[1]); w.y = pk2(hv[2], hv[3]);
            *(uint2*)(dst + (size_t)row * D + col) = w;
            if (WITH_BD) {
#pragma unroll
                for (int i = 0; i < 4; ++i) { const f32x4 w0 = *(const LAS f32x4*)(wbd + (col + i) * 8), w1 = *(const LAS f32x4*)(wbd + (col + i) * 8 + 4);
                    bacc[0] += hv[i] * w0[0]; bacc[1] += hv[i] * w0[1]; bacc[2] += hv[i] * w0[2]; bacc[3] += hv[i] * w0[3];
                    bacc[4] += hv[i] * w1[0]; bacc[5] += hv[i] * w1[1]; bacc[6] += hv[i] * w1[2]; bacc[7] += hv[i] * w1[3]; } } }
        if (WITH_BD) {
#pragma unroll
            for (int q = 0; q < 8; ++q) bacc[q] = wave_sum(bacc[q]);
            if (lane == 0) { float* bd = (float*)(F.ws + WS_BD) + (size_t)row * 8; *(f32x4*)bd = (f32x4){bacc[0], bacc[1], bacc[2], bacc[3]}; *(f32x4*)(bd + 4) = (f32x4){bacc[4], bacc[5], bacc[6], bacc[7]}; } }
    }
}
__device__ __forceinline__ void route_phase(Frame& F, const Args& A) {
    const float* logits = (const float*)(F.ws + WS_LOGITS); const float* rbias = A.in[22];
    int* top_idx = (int*)(F.ws + WS_TOPI); float* top_w = (float*)(F.ws + WS_TOPW);
    const int gw = F.vcu * NWAVES + F.wave, NGW = F.G * NWAVES, lane = F.lane;
    const f32x4 rb = *(const f32x4*)(rbias + lane * 4);
    for (int t = gw; t < T; t += NGW) {
        float sc[4], ch[4];
        const f32x4 lg = *(const f32x4*)(logits + (size_t)t * 256 + lane * 4);
#pragma unroll
        for (int i = 0; i < 4; ++i) { sc[i] = 1.f / (1.f + __expf(-lg[i])); ch[i] = sc[i] + rb[i]; }
        float a1 = fmaxf(ch[0], ch[1]), a2 = fminf(ch[0], ch[1]);
        { const float b1 = fmaxf(ch[2], ch[3]), b2 = fminf(ch[2], ch[3]); const float m1 = fmaxf(a1, b1), m2 = fmaxf(fminf(a1, b1), fmaxf(a2, b2)); a1 = m1; a2 = m2; }
#pragma unroll
        for (int o = 1; o < 8; o <<= 1) { const float b1 = __shfl_xor(a1, o), b2 = __shfl_xor(a2, o); const float m1 = fmaxf(a1, b1), m2 = fmaxf(fminf(a1, b1), fmaxf(a2, b2)); a1 = m1; a2 = m2; }
        const float gs = a1 + a2; const int g = lane >> 3;
        int rank = 0;
#pragma unroll
        for (int gg = 0; gg < 8; ++gg) { const float o = __shfl(gs, gg * 8); rank += (o > gs || (o == gs && gg < g)) ? 1 : 0; }
        const bool sel = rank < 4;
        float mc[4];
#pragma unroll
        for (int i = 0; i < 4; ++i) mc[i] = sel ? ch[i] : -INFINITY;
        int my_idx = 0; float my_sc = 0.f, sum = 0.f;
#pragma unroll
        for (int r = 0; r < 8; ++r) {
            float bv = mc[0]; int bi = 0;
#pragma unroll
            for (int i = 1; i < 4; ++i) if (mc[i] > bv) { bv = mc[i]; bi = i; }
            int be = lane * 4 + bi;
#pragma unroll
            for (int o = 1; o < 64; o <<= 1) { const float ov = __shfl_xor(bv, o); const int oe = __shfl_xor(be, o); if (ov > bv || (ov == bv && oe < be)) { bv = ov; be = oe; } }
            float s = 0.f;
            if ((be >> 2) == lane) { const int b2 = be & 3;
                s = b2 == 0 ? sc[0] : b2 == 1 ? sc[1] : b2 == 2 ? sc[2] : sc[3];
                if (b2 == 0) mc[0] = -INFINITY; else if (b2 == 1) mc[1] = -INFINITY; else if (b2 == 2) mc[2] = -INFINITY; else mc[3] = -INFINITY; }
            s = __shfl(s, be >> 2);
            sum += s;
            if (lane == r) { my_idx = be; my_sc = s; }
        }
        if (lane < 8) { top_idx[t * 8 + lane] = my_idx; top_w[t * 8 + lane] = my_sc / sum * 2.5f; }
    }
}

typedef float f32x16 __attribute__((ext_vector_type(16)));
constexpr int XM = 512;
constexpr int XA_KG = (XM + 8) * 16;
constexpr int XA_BYTES = 4 * XA_KG;
constexpr int XW_BYTES = 4 * 128 * 16;
constexpr int X_BUF = XA_BYTES + XW_BYTES;
__device__ __forceinline__ int xw_lane(int n31) { const int i = n31 & 3, x = n31 >> 2; return (8 * i + (x ^ (i >> 1))) * 16; }

template <int KDIM, class ColMap>
__device__ __forceinline__ void xgemm_tile(Frame& F, f32x16 (&acc)[4][2], const unsigned char* src, const int* list, int r0, int total, int aid_shift, unsigned row_bytes, const float* W, int ldw, ColMap colmap) {
    const int tid = F.tid, lane = F.lane, wave = F.wave;
    LAS unsigned char* lds = F.lds;
    const int a_kg = tid & 3, a_r = tid >> 2;
    const int w_n4 = tid & 31, w_kp = tid >> 5;
    const float* wp = W + colmap(w_n4 * 4) + (size_t)(2 * w_kp) * ldw;
    unsigned rowoff[4];
#pragma unroll
    for (int i = 0; i < 4; ++i) { int r = r0 + a_r + 128 * i; r = r < total ? r : r0; rowoff[i] = (unsigned)(list[r] >> aid_shift) * row_bytes + a_kg * 16; }
#pragma unroll
    for (int nt = 0; nt < 4; ++nt)
#pragma unroll
        for (int tt = 0; tt < 2; ++tt)
#pragma unroll
            for (int q = 0; q < 16; ++q) acc[nt][tt][q] = 0.f;
    const int st_a = a_kg * XA_KG + (a_r + 2 * a_kg) * 16;
    const int st_w0 = XA_BYTES + (w_kp >> 2) * 2048 + (w_n4 >> 3) * 512 + ((w_n4 & 7)) * 16 + (w_kp & 3) * 4;
    const int st_w1 = XA_BYTES + (w_kp >> 2) * 2048 + (w_n4 >> 3) * 512 + ((w_n4 & 7) ^ 1) * 16 + (w_kp & 3) * 4 + 256;
    const int rd_a = (lane >> 5) * (XA_KG + 32) + (wave * 64 + (lane & 31)) * 16;
    const int rd_w = XA_BYTES + (lane >> 5) * 2048 + xw_lane(lane & 31);
    v4u ra[4]; f32x4 rw[2];
    auto gload = [&](int k0) {
#pragma unroll
        for (int i = 0; i < 4; ++i) ra[i] = *(const v4u*)(src + rowoff[i] + k0 * 2);
        rw[0] = *(const f32x4*)(wp + (size_t)k0 * ldw); rw[1] = *(const f32x4*)(wp + (size_t)(k0 + 1) * ldw);
    };
    auto lstore = [&](int buf) {
        LAS unsigned char* b = lds + buf * X_BUF;
#pragma unroll
        for (int i = 0; i < 4; ++i) *(LAS v4u*)(b + st_a + i * 2048) = ra[i];
        *(LAS unsigned*)(b + st_w0) = pk2(rw[0][0], rw[1][0]); *(LAS unsigned*)(b + st_w0 + 128) = pk2(rw[0][1], rw[1][1]);
        *(LAS unsigned*)(b + st_w1) = pk2(rw[0][2], rw[1][2]); *(LAS unsigned*)(b + st_w1 + 128) = pk2(rw[0][3], rw[1][3]);
    };
    constexpr int NS = KDIM / 32;
    gload(0); lstore(0); __syncthreads();
    for (int s = 0; s < NS; ++s) {
        if (s + 1 < NS) gload((s + 1) * 32);
        const LAS unsigned char* b = lds + (s & 1) * X_BUF;
#pragma unroll
        for (int ks = 0; ks < 2; ++ks) {
            bf16x8 tf[2], wf[4];
#pragma unroll
            for (int tt = 0; tt < 2; ++tt) tf[tt] = *(const LAS bf16x8*)(b + rd_a + ks * (2 * XA_KG + 64) + tt * 512);
#pragma unroll
            for (int nt = 0; nt < 4; ++nt) wf[nt] = *(const LAS bf16x8*)(b + rd_w + ks * 4096 + nt * 512);
#pragma unroll
            for (int nt = 0; nt < 4; ++nt)
#pragma unroll
                for (int tt = 0; tt < 2; ++tt) acc[nt][tt] = __builtin_amdgcn_mfma_f32_32x32x16_bf16(wf[nt], tf[tt], acc[nt][tt], 0, 0, 0);
        }
        if (s + 1 < NS) lstore((s + 1) & 1);
        __syncthreads();
    }
}

__device__ __forceinline__ void moe_phase(Frame& F, const Args& A) {
    const int tid = F.tid, lane = F.lane, wave = F.wave;
    const int* top_idx = (const int*)(F.ws + WS_TOPI); const float* top_w = (const float*)(F.ws + WS_TOPW);
    const unsigned char* hsrc = F.ws + WS_H; unsigned char* actb = F.ws + WS_ACTB; bf16_t* Y = (bf16_t*)(F.ws + WS_Y);
    LAS int* wcnt = (LAS int*)(F.lds + 2 * X_BUF);
    for (int e = blockIdx.x; e < NE; e += F.G) {
        int* list = (int*)(F.ws + WS_LIST) + (size_t)e * T;
        const int abase = wave * (NA / NWAVES);
        int c = 0;
        for (int it = 0; it < NA / NWAVES / 256; ++it) { const int4 v = *(const int4*)(top_idx + abase + it * 256 + lane * 4); c += (v.x == e) + (v.y == e) + (v.z == e) + (v.w == e); }
#pragma unroll
        for (int o = 1; o < 64; o <<= 1) c += __shfl_xor(c, o);
        __syncthreads();
        if (lane == 0) wcnt[wave] = c;
        __syncthreads();
        int pos = 0, total = 0;
#pragma unroll
        for (int w = 0; w < NWAVES; ++w) { const int cw = wcnt[w]; pos += (w < wave) ? cw : 0; total += cw; }
        const unsigned long long lt = (1ull << lane) - 1ull;
        for (int it = 0; it < NA / NWAVES / 256; ++it) {
            const int a0 = abase + it * 256 + lane * 4; const int4 v = *(const int4*)(top_idx + a0);
            const bool m0 = v.x == e, m1 = v.y == e, m2 = v.z == e, m3 = v.w == e;
            const unsigned long long b0 = __ballot(m0), b1 = __ballot(m1), b2 = __ballot(m2), b3 = __ballot(m3);
            int p = pos + __popcll(b0 & lt) + __popcll(b1 & lt) + __popcll(b2 & lt) + __popcll(b3 & lt);
            if (m0) list[p++] = a0; if (m1) list[p++] = a0 + 1; if (m2) list[p++] = a0 + 2; if (m3) list[p++] = a0 + 3;
            pos += __popcll(b0) + __popcll(b1) + __popcll(b2) + __popcll(b3);
        }
        __syncthreads();
        const float* W1 = A.in[23] + (size_t)e * 1024 * 512; const float* W2 = A.in[24] + (size_t)e * 256 * 1024;
        for (int r0 = 0; r0 < total; r0 += XM) {
            f32x16 acc[4][2];
            for (int j = 0; j < 4; ++j) {
                xgemm_tile<1024>(F, acc, hsrc, list, r0, total, 3, 2048u, W1, 512, [j](int n) { return n < 64 ? 64 * j + n : 256 + 64 * j + (n - 64); });
#pragma unroll
                for (int tt = 0; tt < 2; ++tt) { const int r = r0 + wave * 64 + tt * 32 + (lane & 31); if (r < total) {
                    bf16_t* dst = (bf16_t*)(actb + (size_t)list[r] * 512) + 64 * j + 4 * (lane >> 5);
#pragma unroll
                    for (int nt = 0; nt < 2; ++nt)
#pragma unroll
                        for (int g = 0; g < 4; ++g) { float a[4];
#pragma unroll
                            for (int q = 0; q < 4; ++q) { const float gt = acc[nt][tt][4 * g + q], up = acc[nt + 2][tt][4 * g + q]; a[q] = gt / (1.f + __expf(-gt)) * up; }
                            uint2 w; w.x = pk2(a[0], a[1]); w.y = pk2(a[2], a[3]); *(uint2*)(dst + 32 * nt + 8 * g) = w; }
                } }
            }
            __syncthreads();
            for (int j = 0; j < 8; ++j) {
                xgemm_tile<256>(F, acc, actb, list, r0, total, 0, 512u, W2, 1024, [j](int n) { return 128 * j + n; });
#pragma unroll
                for (int tt = 0; tt < 2; ++tt) { const int r = r0 + wave * 64 + tt * 32 + (lane & 31); if (r < total) {
                    const int aid = list[r]; const float rw2 = top_w[aid];
                    bf16_t* dst = Y + (size_t)aid * 1024 + 128 * j + 4 * (lane >> 5);
#pragma unroll
                    for (int nt = 0; nt < 4; ++nt)
#pragma unroll
                        for (int g = 0; g < 4; ++g) { uint2 w; w.x = pk2(acc[nt][tt][4 * g] * rw2, acc[nt][tt][4 * g + 1] * rw2); w.y = pk2(acc[nt][tt][4 * g + 2] * rw2, acc[nt][tt][4 * g + 3] * rw2);
                            *(uint2*)(dst + 32 * nt + 8 * g) = w; }
                } }
            }
            __syncthreads();
        }
    }
}
__device__ __forceinline__ void attn_prep_phase(Frame& F, const Args& A) {
    const bf16_t* P = (const bf16_t*)(F.ws + WS_P); bf16_t* QN = (bf16_t*)(F.ws + WS_QN); bf16_t* KN = (bf16_t*)(F.ws + WS_KN);
    const float* qg = A.in[11]; const float* kg = A.in[12];
    const int gw = F.vcu * NWAVES + F.wave, NGW = F.G * NWAVES, lane = F.lane;
    f32x4 gq0 = *(const f32x4*)(qg + (lane & 7) * 8), gq1 = *(const f32x4*)(qg + (lane & 7) * 8 + 4);
    f32x4 gk0 = *(const f32x4*)(kg + (lane & 7) * 8), gk1 = *(const f32x4*)(kg + (lane & 7) * 8 + 4);
    for (int t = gw; t < T; t += NGW) {
#pragma unroll
        for (int which = 0; which < 2; ++which) {
            const v4u w = *(const v4u*)(P + (size_t)t * LDP + (which ? C_KB : C_QB) + lane * 8);
            float v[8] = {pg8::bflo(w.x), pg8::bfhi(w.x), pg8::bflo(w.y), pg8::bfhi(w.y), pg8::bflo(w.z), pg8::bfhi(w.z), pg8::bflo(w.w), pg8::bfhi(w.w)};
            float ss = 0.f;
#pragma unroll
            for (int i = 0; i < 8; ++i) ss += v[i] * v[i];
            ss += __shfl_xor(ss, 1); ss += __shfl_xor(ss, 2); ss += __shfl_xor(ss, 4);
            const float r = rsqrtf(ss * (1.f / 64.f) + EPS) * (which ? 1.f : 0.125f * 1.4426950408889634f);
            const f32x4 g0 = which ? gk0 : gq0, g1 = which ? gk1 : gq1;
            v4u o; o.x = pk2(v[0] * r * g0[0], v[1] * r * g0[1]); o.y = pk2(v[2] * r * g0[2], v[3] * r * g0[3]); o.z = pk2(v[4] * r * g1[0], v[5] * r * g1[1]); o.w = pk2(v[6] * r * g1[2], v[7] * r * g1[3]);
            *(v4u*)((which ? KN : QN) + (size_t)t * 512 + lane * 8) = o;
        }
    }
}

typedef short s16x4 __attribute__((ext_vector_type(4)));
constexpr int AT_KPLANE = 1040;
constexpr int AT_KBYTES = 8 * AT_KPLANE;
constexpr int AT_VROW = 320;
constexpr int AT_VBYTES = 64 * AT_VROW;
constexpr int AT_BUF = AT_KBYTES + AT_VBYTES;
template <int OFF> __device__ __forceinline__ s16x4 tr_read(int vb) {
    s16x4 r; asm volatile("ds_read_b64_tr_b16 %0, %1 offset:%2" : "=&v"(r) : "v"(vb), "i"(OFF) : "memory"); return r;
}
template <int ND> __device__ __forceinline__ void pv_one(f32x16& od, int vb, const bf16x8 (&pf)[4]) {
#define VOFF(mt, s, half) (AT_KBYTES + (32 * (mt) + 16 * (s) + 8 * (half)) * AT_VROW + ND * 64)
    const s16x4 a0 = tr_read<VOFF(0, 0, 0)>(vb), b0 = tr_read<VOFF(0, 0, 1)>(vb), a1 = tr_read<VOFF(0, 1, 0)>(vb), b1 = tr_read<VOFF(0, 1, 1)>(vb);
    const s16x4 a2 = tr_read<VOFF(1, 0, 0)>(vb), b2 = tr_read<VOFF(1, 0, 1)>(vb), a3 = tr_read<VOFF(1, 1, 0)>(vb), b3 = tr_read<VOFF(1, 1, 1)>(vb);
#undef VOFF
    asm volatile("s_waitcnt lgkmcnt(0)" ::: "memory"); __builtin_amdgcn_sched_barrier(0);
#define PK(L, H) (bf16x8){L[0], L[1], L[2], L[3], H[0], H[1], H[2], H[3]}
    od = __builtin_amdgcn_mfma_f32_32x32x16_bf16(PK(a0, b0), pf[0], od, 0, 0, 0);
    od = __builtin_amdgcn_mfma_f32_32x32x16_bf16(PK(a1, b1), pf[1], od, 0, 0, 0);
    od = __builtin_amdgcn_mfma_f32_32x32x16_bf16(PK(a2, b2), pf[2], od, 0, 0, 0);
    od = __builtin_amdgcn_mfma_f32_32x32x16_bf16(PK(a3, b3), pf[3], od, 0, 0, 0);
#undef PK
}
__device__ __forceinline__ void attn_unit(Frame& F, int b, int h, int c, int qb) {
    const int tid = F.tid, lane = F.lane, wave = F.wave, r32 = lane & 31, hi = lane >> 5;
    LAS unsigned char* lds = F.lds;
    const bf16_t* QN = (const bf16_t*)(F.ws + WS_QN); const bf16_t* KN = (const bf16_t*)(F.ws + WS_KN); const bf16_t* P = (const bf16_t*)(F.ws + WS_P);
    const float sl2 = exp2f(-2.f * (float)(h + 1)) * 1.4426950408889634f;
    const float M2 = ((const float*)(F.ws + WS_SCAL))[1];
    const int tq = qb * 256 + wave * 32 + r32;
    const int ctw = 4 * qb + (wave >> 1), ntiles = 4 * qb + 4;
    bf16x8 qf[4];
    { const bf16_t* qp = QN + (size_t)(b * S + tq) * 512 + h * 128 + c * 64 + hi * 8;
#pragma unroll
      for (int ks = 0; ks < 4; ++ks) qf[ks] = *(const bf16x8*)(qp + 16 * ks); }
    float koffs[16];
#pragma unroll
    for (int r = 0; r < 16; ++r) koffs[r] = sl2 * (float)((r & 3) + 8 * (r >> 2) + 4 * hi);
    f32x16 oacc[4];
#pragma unroll
    for (int nd = 0; nd < 4; ++nd)
#pragma unroll
        for (int r = 0; r < 16; ++r) oacc[nd][r] = 0.f;
    float lsum = 0.f;
    const int s_key = tid >> 3, s_kg = tid & 7;
    const bf16_t* kg_src = KN + (size_t)(b * S + s_key) * 512 + h * 128 + c * 64 + s_kg * 8;
    const bf16_t* vg_src = P + (size_t)(b * S + s_key) * LDP + C_VB + h * 128 + s_kg * 8;
    const int st_k = s_kg * AT_KPLANE + s_key * 16, st_v = AT_KBYTES + s_key * AT_VROW + s_kg * 16;
    const int rd_k = hi * AT_KPLANE + r32 * 16;
    const int rd_v = (hi * 4 + ((lane & 15) >> 2)) * AT_VROW + ((lane >> 4) & 1) * 32 + (lane & 3) * 8;
    v4u rk, rv0, rv1;
    auto gload = [&](int tile) { rk = *(const v4u*)(kg_src + (size_t)tile * 64 * 512); const bf16_t* vp = vg_src + (size_t)tile * 64 * LDP; rv0 = *(const v4u*)vp; rv1 = *(const v4u*)(vp + 64); };
    auto lstore = [&](int buf) { LAS unsigned char* bb = lds + buf * AT_BUF; *(LAS v4u*)(bb + st_k) = rk; *(LAS v4u*)(bb + st_v) = rv0; *(LAS v4u*)(bb + st_v + 128) = rv1; };
    __syncthreads();
    gload(0); lstore(0); __syncthreads();
    for (int tile = 0; tile < ntiles; ++tile) {
        if (tile + 1 < ntiles) gload(tile + 1);
        if (tile <= ctw) {
            const LAS unsigned char* kb = lds + (tile & 1) * AT_BUF;
            f32x16 sacc[2];
            if (tile != ctw) {
                const float ct = sl2 * (float)(64 * tile - tq) - M2;
#pragma unroll
                for (int mt = 0; mt < 2; ++mt)
#pragma unroll
                    for (int r = 0; r < 16; ++r) sacc[mt][r] = koffs[r] + (ct + sl2 * 32.f * mt);
            } else {
                const float base = sl2 * (float)(64 * tile - tq);
#pragma unroll
                for (int mt = 0; mt < 2; ++mt)
#pragma unroll
                    for (int r = 0; r < 16; ++r) sacc[mt][r] = -fabsf(koffs[r] + (base + sl2 * 32.f * mt)) - M2;
            }
#pragma unroll
            for (int ks = 0; ks < 4; ++ks)
#pragma unroll
                for (int mt = 0; mt < 2; ++mt) { const bf16x8 kf = *(const LAS bf16x8*)(kb + rd_k + ks * 2 * AT_KPLANE + mt * 512);
                    sacc[mt] = __builtin_amdgcn_mfma_f32_32x32x16_bf16(kf, qf[ks], sacc[mt], 0, 0, 0); }
            bf16x8 pf[4];
#pragma unroll
            for (int mt = 0; mt < 2; ++mt) {
#pragma unroll
                for (int r = 0; r < 16; ++r) { const float p = __builtin_amdgcn_exp2f(sacc[mt][r]); lsum += p; sacc[mt][r] = p; }
#pragma unroll
                for (int s = 0; s < 2; ++s) { v4u w;
                    w.x = pg8::cvt_pk_bf16(sacc[mt][8 * s + 0], sacc[mt][8 * s + 1]); w.y = pg8::cvt_pk_bf16(sacc[mt][8 * s + 2], sacc[mt][8 * s + 3]);
                    w.z = pg8::cvt_pk_bf16(sacc[mt][8 * s + 4], sacc[mt][8 * s + 5]); w.w = pg8::cvt_pk_bf16(sacc[mt][8 * s + 6], sacc[mt][8 * s + 7]);
                    pf[mt * 2 + s] = __builtin_bit_cast(bf16x8, w); }
            }
            const int vb = (int)(uintptr_t)kb + rd_v;
            pv_one<0>(oacc[0], vb, pf); pv_one<1>(oacc[1], vb, pf); pv_one<2>(oacc[2], vb, pf); pv_one<3>(oacc[3], vb, pf);
        }
        if (tile + 1 < ntiles) lstore((tile + 1) & 1);
        __syncthreads();
    }
    lsum += __shfl_xor(lsum, 32);
    const float inv = 1.f / lsum;
    bf16_t* ob = (bf16_t*)(F.ws + WS_OB) + (size_t)c * T * 512 + (size_t)(b * S + tq) * 512 + h * 128 + 4 * hi;
#pragma unroll
    for (int nd = 0; nd < 4; ++nd)
#pragma unroll
        for (int g = 0; g < 4; ++g) { uint2 w; w.x = pk2(oacc[nd][4 * g] * inv, oacc[nd][4 * g + 1] * inv); w.y = pk2(oacc[nd][4 * g + 2] * inv, oacc[nd][4 * g + 3] * inv);
            *(uint2*)(ob + 32 * nd + 8 * g) = w; }
}
__device__ __forceinline__ void post_norm_phase(Frame& F, const Args& A) {
    const float* oa = (const float*)(F.ws + WS_OA); const bf16_t* ob = (const bf16_t*)(F.ws + WS_OB); const bf16_t* P = (const bf16_t*)(F.ws + WS_P);
    bf16_t* oan = (bf16_t*)(F.ws + WS_OAN); bf16_t* obn = (bf16_t*)(F.ws + WS_OBN);
    const float* gg = A.in[9]; const float* sg = A.in[17];
    const float lam = ((const float*)(F.ws + WS_SCAL))[0];
    const int gw = F.vcu * NWAVES + F.wave, NGW = F.G * NWAVES, lane = F.lane;
    const int gc = (lane & 15) * 8;
    const f32x4 g0 = *(const f32x4*)(gg + gc), g1 = *(const f32x4*)(gg + gc + 4), s0 = *(const f32x4*)(sg + gc), s1 = *(const f32x4*)(sg + gc + 4);
    for (int t = gw; t < T; t += NGW) {
        { const f32x4 a0 = *(const f32x4*)(oa + (size_t)t * 512 + lane * 8), a1 = *(const f32x4*)(oa + (size_t)t * 512 + lane * 8 + 4);
          float ss = (a0[0] * a0[0] + a0[1] * a0[1]) + (a0[2] * a0[2] + a0[3] * a0[3]) + (a1[0] * a1[0] + a1[1] * a1[1]) + (a1[2] * a1[2] + a1[3] * a1[3]);
          ss += __shfl_xor(ss, 1); ss += __shfl_xor(ss, 2); ss += __shfl_xor(ss, 4); ss += __shfl_xor(ss, 8);
          const float r = rsqrtf(ss * (1.f / 128.f) + EPS);
          const v4u zw = *(const v4u*)(P + (size_t)t * LDP + C_ZA + lane * 8);
          const float z[8] = {pg8::bflo(zw.x), pg8::bfhi(zw.x), pg8::bflo(zw.y), pg8::bfhi(zw.y), pg8::bflo(zw.z), pg8::bfhi(zw.z), pg8::bflo(zw.w), pg8::bfhi(zw.w)};
          float o[8];
#pragma unroll
          for (int i = 0; i < 4; ++i) { o[i] = a0[i] * r * g0[i] * siluf(z[i]); o[4 + i] = a1[i] * r * g1[i] * siluf(z[4 + i]); }
          v4u w; w.x = pk2(o[0], o[1]); w.y = pk2(o[2], o[3]); w.z = pk2(o[4], o[5]); w.w = pk2(o[6], o[7]);
          *(v4u*)(oan + (size_t)t * 512 + lane * 8) = w; }
        { const v4u w1 = *(const v4u*)(ob + (size_t)t * 512 + lane * 8), w2 = *(const v4u*)(ob + (size_t)T * 512 + (size_t)t * 512 + lane * 8);
          float d[8] = {pg8::bflo(w1.x) - lam * pg8::bflo(w2.x), pg8::bfhi(w1.x) - lam * pg8::bfhi(w2.x), pg8::bflo(w1.y) - lam * pg8::bflo(w2.y), pg8::bfhi(w1.y) - lam * pg8::bfhi(w2.y),
                        pg8::bflo(w1.z) - lam * pg8::bflo(w2.z), pg8::bfhi(w1.z) - lam * pg8::bfhi(w2.z), pg8::bflo(w1.w) - lam * pg8::bflo(w2.w), pg8::bfhi(w1.w) - lam * pg8::bfhi(w2.w)};
          float ss = 0.f;
#pragma unroll
          for (int i = 0; i < 8; ++i) ss += d[i] * d[i];
          ss += __shfl_xor(ss, 1); ss += __shfl_xor(ss, 2); ss += __shfl_xor(ss, 4); ss += __shfl_xor(ss, 8);
          const float r = rsqrtf(ss * (1.f / 128.f) + EPS) * (1.f - LAM_INIT);
          v4u w; w.x = pk2(d[0] * r * s0[0], d[1] * r * s0[1]); w.y = pk2(d[2] * r * s0[2], d[3] * r * s0[3]); w.z = pk2(d[4] * r * s1[0], d[5] * r * s1[1]); w.w = pk2(d[6] * r * s1[2], d[7] * r * s1[3]);
          *(v4u*)(obn + (size_t)t * 512 + lane * 8) = w; }
    }
}
constexpr int GD_KA = 0, GD_QA = 17408, GD_VN = 34816, GD_KB = 55296, GD_LM = 75776, GD_T1 = 93184, GD_T2 = 102400, GD_SC = 111616;
constexpr int GD_SA = 272, GD_SB = 320, GD_SL = 272, GD_ST = 144;
constexpr size_t GDN_WF = 0, GDN_QF = 16384, GDN_AF = 32768, GDN_KF = 40960, GDN_UF = 57344, GDN_EG = 90112, GDN_ITEM = 90368;
__device__ __forceinline__ int perm16_h(int n) { return (n >> 2) & 1; }
__device__ __forceinline__ int perm16_j(int n) { return (n & 3) + 4 * (n >> 3); }

__device__ __forceinline__ void gdn_prep_item(Frame& F, const Args& A, int item) {
    const int tid = F.tid, lane = F.lane, wave = F.wave, r32 = lane & 31, hi = lane >> 5;
    LAS unsigned char* lds = F.lds;
    const int b = item >> 9, h = (item >> 7) & 3, n = item & 127;
    const int t0 = b * S + n * 64;
    const bf16_t* P = (const bf16_t*)(F.ws + WS_P); const float* bd = (const float*)(F.ws + WS_BD);
    unsigned char* gi = F.ws + WS_GDN + (size_t)item * GDN_ITEM;
    LAS float* sc_g = (LAS float*)(lds + GD_SC);
    LAS float* sc_b = sc_g + 64;
    LAS float* sc_e = sc_g + 128;
    LAS float* sc_l = sc_g + 192;
#ifndef NO_S1
    if (tid < 128) *((LAS float*)(lds + GD_SC + 1024) + tid) = (tid == 63) ? 1.f : 0.f;
    {
        const float* cw = A.in[6];
        float w[3][4][2];
#pragma unroll
        for (int p = 0; p < 3; ++p)
#pragma unroll
            for (int j = 0; j < 4; ++j) { const float2 t = *(const float2*)(cw + j * 1536 + p * 512 + h * 128 + 2 * lane); w[p][j][0] = t.x; w[p][j][1] = t.y; }
        const int rl0 = n * 64 + wave * 8;
#pragma unroll
        for (int p = 0; p < 3; ++p) {
            float x[11][2];
#pragma unroll
            for (int i = 0; i < 11; ++i) { const int tl = rl0 - 3 + i; unsigned u = 0u;
                if (tl >= 0) u = *(const unsigned*)(P + (size_t)(b * S + tl) * LDP + p * 512 + h * 128 + 2 * lane);
                x[i][0] = pg8::bflo(u); x[i][1] = pg8::bfhi(u); }
#pragma unroll
            for (int r = 0; r < 8; ++r) {
                float a0 = 0.f, a1 = 0.f;
#pragma unroll
                for (int j = 0; j < 4; ++j) { a0 += x[r + j][0] * w[p][j][0]; a1 += x[r + j][1] * w[p][j][1]; }
                a0 = siluf(a0); a1 = siluf(a1);
                const int row = wave * 8 + r;
                if (p < 2) { const float ss = wave_sum(a0 * a0 + a1 * a1); const float rs = rsqrtf(ss + EPS) * (p == 0 ? 0.08838834764831845f : 1.f); a0 *= rs; a1 *= rs; }
                const unsigned pk = pk2(a0, a1);
                if (p == 0) *(LAS unsigned*)(lds + GD_QA + row * GD_SA + lane * 4) = pk;
                else if (p == 1) { *(LAS unsigned*)(lds + GD_KA + row * GD_SA + lane * 4) = pk; *(LAS unsigned*)(lds + GD_KB + row * GD_SB + lane * 4) = pk; }
                else *(LAS unsigned*)(lds + GD_VN + row * GD_SB + lane * 4) = pk;
            }
        }
        if (wave == 0) {
            const float bl = bd[(size_t)(t0 + lane) * 8 + h], dl = bd[(size_t)(t0 + lane) * 8 + 4 + h];
            const float beta = 1.f / (1.f + __expf(-bl));
            float g = -expf(A.in[7][h]) * softplusf(dl + A.in[8][h]);
#pragma unroll
            for (int o = 1; o < 64; o <<= 1) { const float up = __shfl_up(g, o); if (lane >= o) g += up; }
            const float glast = __shfl(g, 63);
            sc_g[lane] = g; sc_b[lane] = beta; sc_e[lane] = __expf(g); sc_l[lane] = __expf(glast - g);
            if (lane == 0) *(float*)(gi + GDN_EG) = __expf(glast);
        }
    }
#endif
    __syncthreads();
#ifndef NO_S2
    {
        const int which = wave >> 2, ti = (wave >> 1) & 1, tj = wave & 1;
        f32x16 acc;
#pragma unroll
        for (int r = 0; r < 16; ++r) acc[r] = 0.f;
        if (ti >= tj) {
            const LAS unsigned char* ap = lds + (which ? GD_QA : GD_KA) + (32 * ti + r32) * GD_SA + hi * 16;
            const LAS unsigned char* bp = lds + GD_KA + (32 * tj + r32) * GD_SA + hi * 16;
#pragma unroll
            for (int ks = 0; ks < 8; ++ks) acc = __builtin_amdgcn_mfma_f32_32x32x16_bf16(*(const LAS bf16x8*)(ap + ks * 32), *(const LAS bf16x8*)(bp + ks * 32), acc, 0, 0, 0);
        }
        const int j = 32 * tj + r32; const float Gj = sc_g[j];
        const int ibase = 32 * ti + 4 * hi, dij = ibase - j;
        const LAS float* gp = sc_g + ibase; const LAS float* bp2 = sc_b + ibase;
        if (which == 0) {
            LAS float* lm = (LAS float*)(lds + GD_LM + ibase * GD_SL + j * 4);
#pragma unroll
            for (int r = 0; r < 16; ++r) { const int off = (r & 3) + 8 * (r >> 2);
                const float v = (off + dij > 0) ? bp2[off] * acc[r] * __expf(fminf(gp[off] - Gj, 0.f)) : 0.f;
                lm[off * (GD_SL / 4)] = v; }
        } else {
            const int ks = j >> 4, nn = j & 15, hp = perm16_h(nn), jj = perm16_j(nn);
            bf16_t* af = (bf16_t*)(gi + GDN_AF) + ((ti * 4 + ks) * 64 + hp * 32 + 4 * hi) * 8 + jj;
#pragma unroll
            for (int r = 0; r < 16; ++r) { const int off = (r & 3) + 8 * (r >> 2);
                const float v = (off + dij >= 0) ? acc[r] * __expf(fminf(gp[off] - Gj, 0.f)) : 0.f;
                af[off * 8] = (bf16_t)f2bf(v); }
        }
    }
#endif
    __syncthreads();
#ifndef NO_S3
    if (wave == 0) {
        int ln = lane; asm volatile("" : "+v"(ln));
        LAS unsigned char* lmb = lds + GD_LM; asm volatile("" : "+v"(lmb));
        const LAS float* zz = (const LAS float*)(lds + GD_SC + 1024) + ln;
        float t[64];
#pragma unroll
        for (int i = 0; i < 64; ++i) {
            float s = zz[63 - i];
            const LAS float* Li = (const LAS float*)(lmb + i * GD_SL);
#pragma unroll
            for (int j4 = 0; j4 < (i + 3) / 4; ++j4) { const f32x4 l4 = *(const LAS f32x4*)(Li + 4 * j4);
#pragma unroll
                for (int q = 0; q < 4; ++q) if (4 * j4 + q < i) s -= l4[q] * t[4 * j4 + q]; }
            t[i] = s;
            __builtin_amdgcn_sched_barrier(0);
        }
        const float bc = sc_b[lane], bec = bc * sc_e[lane];
#pragma unroll
        for (int i = 0; i < 64; ++i) { *(LAS bf16_t*)(lds + GD_T1 + i * GD_ST + lane * 2) = (bf16_t)f2bf(t[i] * bc); *(LAS bf16_t*)(lds + GD_T2 + i * GD_ST + lane * 2) = (bf16_t)f2bf(t[i] * bec); }
    } else {
        for (int cidx = tid - 64; cidx < 2048; cidx += 448) {
            const bool isK = cidx >= 1024; const int cc = cidx & 1023; const int lp = cc & 63, hp = lp >> 5, rr = lp & 31;
            unsigned wds[4];
            if (!isK) { const int mt = cc >> 9, ks = (cc >> 6) & 7; const int i = 32 * mt + rr; const float e = sc_e[i];
#pragma unroll
                for (int q = 0; q < 4; ++q) { const int j0 = 2 * q, j1 = 2 * q + 1;
                    const int d0 = 16 * ks + 8 * (j0 >> 2) + 4 * hp + (j0 & 3), d1 = 16 * ks + 8 * (j1 >> 2) + 4 * hp + (j1 & 3);
                    wds[q] = pk2(bf2f(*(const LAS bf16_t*)(lds + GD_QA + i * GD_SA + d0 * 2)) * e, bf2f(*(const LAS bf16_t*)(lds + GD_QA + i * GD_SA + d1 * 2)) * e); }
                *(v4u*)(gi + GDN_QF + (size_t)cc * 16) = (v4u){wds[0], wds[1], wds[2], wds[3]};
            } else { const int dt = cc >> 8, ks = (cc >> 6) & 3; const int dk = 32 * dt + rr;
#pragma unroll
                for (int q = 0; q < 4; ++q) { const int j0 = 2 * q, j1 = 2 * q + 1;
                    const int k0 = 16 * ks + 8 * (j0 >> 2) + 4 * hp + (j0 & 3), k1 = 16 * ks + 8 * (j1 >> 2) + 4 * hp + (j1 & 3);
                    wds[q] = pk2(bf2f(*(const LAS bf16_t*)(lds + GD_KA + k0 * GD_SA + dk * 2)) * sc_l[k0], bf2f(*(const LAS bf16_t*)(lds + GD_KA + k1 * GD_SA + dk * 2)) * sc_l[k1]); }
                *(v4u*)(gi + GDN_KF + (size_t)cc * 16) = (v4u){wds[0], wds[1], wds[2], wds[3]};
            }
        }
    }
#endif
    __syncthreads();
#ifndef NO_S4
    {
        const int mt = wave >> 2, nt = wave & 3;
        const int trb = (hi * 8 + ((lane & 15) >> 2)) * GD_SB + (32 * nt + ((lane >> 4) & 1) * 16 + (lane & 3) * 4) * 2;
#pragma unroll
        for (int which = 0; which < 2; ++which) {
            f32x16 acc;
#pragma unroll
            for (int r = 0; r < 16; ++r) acc[r] = 0.f;
            const LAS unsigned char* tp = lds + (which ? GD_T2 : GD_T1) + (32 * mt + r32) * GD_ST + hi * 16;
            const int vb = (int)(uintptr_t)(lds + (which ? GD_KB : GD_VN)) + trb;
            s16x4 lo[4], hh[4];
            lo[0] = tr_read<0 * 16 * GD_SB>(vb); hh[0] = tr_read<0 * 16 * GD_SB + 4 * GD_SB>(vb); lo[1] = tr_read<1 * 16 * GD_SB>(vb); hh[1] = tr_read<1 * 16 * GD_SB + 4 * GD_SB>(vb);
            lo[2] = tr_read<2 * 16 * GD_SB>(vb); hh[2] = tr_read<2 * 16 * GD_SB + 4 * GD_SB>(vb); lo[3] = tr_read<3 * 16 * GD_SB>(vb); hh[3] = tr_read<3 * 16 * GD_SB + 4 * GD_SB>(vb);
            asm volatile("s_waitcnt lgkmcnt(0)" ::: "memory"); __builtin_amdgcn_sched_barrier(0);
#pragma unroll
            for (int ks = 0; ks < 4; ++ks) { const bf16x8 bfr = (bf16x8){lo[ks][0], lo[ks][1], lo[ks][2], lo[ks][3], hh[ks][0], hh[ks][1], hh[ks][2], hh[ks][3]};
                acc = __builtin_amdgcn_mfma_f32_32x32x16_bf16(*(const LAS bf16x8*)(tp + ks * 32), bfr, acc, 0, 0, 0); }
            if (which == 0) {
                float* uf = (float*)(gi + GDN_UF) + (size_t)nt * 2048 + (32 * mt + 4 * hi) * 32 + r32;
#pragma unroll
                for (int r = 0; r < 16; ++r) uf[((r & 3) + 8 * (r >> 2)) * 32] = acc[r];
            } else {
                const int dk = 32 * nt + r32, ks = dk >> 4, nn = dk & 15, hp = perm16_h(nn), jj = perm16_j(nn);
                bf16_t* wf = (bf16_t*)(gi + GDN_WF) + ((mt * 8 + ks) * 64 + hp * 32 + 4 * hi) * 8 + jj;
#pragma unroll
                for (int r = 0; r < 16; ++r) wf[((r & 3) + 8 * (r >> 2)) * 8] = (bf16_t)f2bf(acc[r]);
            }
        }
    }
#endif
    __syncthreads();
}
__device__ __forceinline__ void gdn_prep_phase(Frame& F, const Args& A) {
    for (int item = blockIdx.x; item < 1024; item += F.G) gdn_prep_item(F, A, item);
}

__device__ __forceinline__ bf16x8 pack8(const f32x16& a, int s) {
    v4u w; w.x = pg8::cvt_pk_bf16(a[8 * s + 0], a[8 * s + 1]); w.y = pg8::cvt_pk_bf16(a[8 * s + 2], a[8 * s + 3]); w.z = pg8::cvt_pk_bf16(a[8 * s + 4], a[8 * s + 5]); w.w = pg8::cvt_pk_bf16(a[8 * s + 6], a[8 * s + 7]);
    return __builtin_bit_cast(bf16x8, w);
}
constexpr int SC_STAGE = 65536;
__device__ __forceinline__ void gdn_scan_block(Frame& F, int task) {
    const int lane = F.lane, wave = F.wave, r32 = lane & 31, hi = lane >> 5;
    const int bh = task >> 2, sl = task & 3, b = bh >> 2, h = bh & 3;
    LAS unsigned char* lds = F.lds;
    float* oa = (float*)(F.ws + WS_OA);
    const unsigned char* g0 = F.ws + WS_GDN + (size_t)(bh * 128) * GDN_ITEM;
    auto issue = [&](int n) {
        const unsigned char* gi = g0 + (size_t)n * GDN_ITEM; LAS unsigned char* st = lds + (n & 1) * SC_STAGE;
        for (int p = wave - 1; p < 64; p += 7) {
            const unsigned char* src = (p < 56) ? gi + p * 1024 : gi + GDN_UF + (size_t)sl * 8192 + (p - 56) * 1024;
            __builtin_amdgcn_global_load_lds((const unsigned*)(src + lane * 16), (LAS unsigned*)(st + p * 1024), 16, 0, 0);
        }
    };
    f32x16 st4[4];
#pragma unroll
    for (int dt = 0; dt < 4; ++dt)
#pragma unroll
        for (int r = 0; r < 16; ++r) st4[dt][r] = 0.f;
    __syncthreads();
    if (wave != 0) issue(0);
    __syncthreads();
    for (int n = 0; n < 128; ++n) {
        if (wave != 0) { if (n + 1 < 128) issue(n + 1); }
        else {
            const LAS unsigned char* sg = lds + (n & 1) * SC_STAGE;
            const LAS bf16x8* wf = (const LAS bf16x8*)(sg + GDN_WF) + lane; const LAS bf16x8* qf = (const LAS bf16x8*)(sg + GDN_QF) + lane;
            const LAS bf16x8* af = (const LAS bf16x8*)(sg + GDN_AF) + lane; const LAS bf16x8* kf = (const LAS bf16x8*)(sg + GDN_KF) + lane;
            const LAS float* ufl = (const LAS float*)(sg + 57344) + 4 * hi * 32 + r32;
            const float egl = *(const float*)(g0 + (size_t)n * GDN_ITEM + GDN_EG);
            float* oap = oa + (size_t)(b * S + n * 64 + 4 * hi) * 512 + h * 128 + sl * 32 + r32;
            bf16x8 sb[8];
#pragma unroll
            for (int dt = 0; dt < 4; ++dt) { sb[2 * dt] = pack8(st4[dt], 0); sb[2 * dt + 1] = pack8(st4[dt], 1); }
            f32x16 vn[2], oc[2];
#pragma unroll
            for (int mt = 0; mt < 2; ++mt) {
                f32x16 ws_;
#pragma unroll
                for (int r = 0; r < 16; ++r) { ws_[r] = 0.f; oc[mt][r] = 0.f; }
#pragma unroll
                for (int ks = 0; ks < 8; ++ks) { ws_ = __builtin_amdgcn_mfma_f32_32x32x16_bf16(wf[(mt * 8 + ks) * 64], sb[ks], ws_, 0, 0, 0);
                                                 oc[mt] = __builtin_amdgcn_mfma_f32_32x32x16_bf16(qf[(mt * 8 + ks) * 64], sb[ks], oc[mt], 0, 0, 0); }
#pragma unroll
                for (int r = 0; r < 16; ++r) vn[mt][r] = ufl[(32 * mt + (r & 3) + 8 * (r >> 2)) * 32] - ws_[r];
            }
            bf16x8 vb[4];
#pragma unroll
            for (int mt = 0; mt < 2; ++mt) { vb[2 * mt] = pack8(vn[mt], 0); vb[2 * mt + 1] = pack8(vn[mt], 1); }
#pragma unroll
            for (int mt = 0; mt < 2; ++mt) {
#pragma unroll
                for (int ks = 0; ks < 4; ++ks) oc[mt] = __builtin_amdgcn_mfma_f32_32x32x16_bf16(af[(mt * 4 + ks) * 64], vb[ks], oc[mt], 0, 0, 0);
#pragma unroll
                for (int r = 0; r < 16; ++r) oap[(size_t)(32 * mt + (r & 3) + 8 * (r >> 2)) * 512] = oc[mt][r];
            }
#pragma unroll
            for (int dt = 0; dt < 4; ++dt) {
#pragma unroll
                for (int r = 0; r < 16; ++r) st4[dt][r] *= egl;
#pragma unroll
                for (int ks = 0; ks < 4; ++ks) st4[dt] = __builtin_amdgcn_mfma_f32_32x32x16_bf16(kf[(dt * 4 + ks) * 64], vb[ks], st4[dt], 0, 0, 0);
            }
        }
        __syncthreads();
    }
}
constexpr int CW_QUEUE = 64;
__device__ __forceinline__ void mixer_phase(Frame& F, const Args& A, int rep) {
    if (blockIdx.x < 32) gdn_scan_block(F, (int)blockIdx.x);
    unsigned* qctr = (unsigned*)(F.ws + WS_CTL) + CW_QUEUE + 64 * rep;
    volatile LAS int* slot = (volatile LAS int*)(F.lds + 131072 + 64);
    for (;;) {
        __syncthreads();
        if (F.tid == 0) slot[0] = (int)__hip_atomic_fetch_add(qctr, 1u, __ATOMIC_RELAXED, __HIP_MEMORY_SCOPE_AGENT);
        __syncthreads();
        const int i = slot[0];
        if (i >= 512) break;
        const int qb = 31 - (i >> 4), x = i & 15;
        attn_unit(F, x >> 3, (x >> 1) & 3, x & 1, qb);
    }
}
__global__ void __launch_bounds__(NWAVES * 64, 2) mega(Args args) {
    extern __shared__ __attribute__((aligned(16))) unsigned char lds_raw[];
    Frame F;
    F.lds = (LAS unsigned char*)lds_raw;
    F.MISC = (volatile LAS unsigned*)(F.lds + MISC_OFF);
    F.tid = threadIdx.x; F.lane = F.tid & 63; F.wave = __builtin_amdgcn_readfirstlane(F.tid >> 6);
    F.G = gridDim.x; { const int bx = blockIdx.x; F.vcu = (F.G % 8 == 0) ? (bx % 8) * (F.G / 8) + bx / 8 : bx; }
    F.out = args.out; F.ws = args.ws;
    for (int u = F.tid; u < (LDS_BYTES - 131072) / 4; u += NWAVES * 64) ((LAS unsigned*)(F.lds + 131072))[u] = 0u;
    __syncthreads();
    const int lo = args.ph_lo, hi = args.ph_hi;
    XcdBarrier bar; bar.bar = (unsigned*)(F.ws + WS_CTL) + CW_BAR; bar.x = 0; bar.st = nullptr;
    if (hi - lo > 1) bar = xcd_barrier_post((unsigned*)(F.ws + WS_CTL) + CW_BAR, F.MISC + 8);
#ifndef PHASE_MASK
#define PHASE_MASK 0xffff
#endif
#ifndef DUP_MASK
#define DUP_MASK 0
#endif
#define IN(k) (((PHASE_MASK >> (k)) & 1) && lo <= (k) && (k) < hi)
    if (IN(0)) { p0_phase(F, args); }
#if (DUP_MASK >> 0) & 1
    if (IN(0)) xcd_barrier(bar);
    if (IN(0)) { p0_phase(F, args); }
#endif
    if (IN(0) && IN(1)) xcd_barrier(bar);
    if (IN(1)) { norm_mod_phase<true, true>(F, args, args.in[0], args.in[4], 0, 1024, (bf16_t*)(F.ws + WS_H)); }
#if (DUP_MASK >> 1) & 1
    if (IN(1)) xcd_barrier(bar);
    if (IN(1)) { norm_mod_phase<true, true>(F, args, args.in[0], args.in[4], 0, 1024, (bf16_t*)(F.ws + WS_H)); }
#endif
    if (IN(1) && IN(2)) xcd_barrier(bar);
    if (IN(2)) {
        pg8::Gemm g{(const bf16_t*)(F.ws + WS_H), (const bf16_t*)(F.ws + WS_WIN), T, LDP, D}; pg8::StaticOrder So; So.init(T, LDP, F.G, (int)blockIdx.x);
        pg8::EpiStoreBf16 E{(bf16_t*)(F.ws + WS_P), LDP, 0};
        pg8::gemm_phase<pg8::EpiStoreBf16, pg8::StaticOrder, true, true>(F.lds, g, So, E);
    }
#if (DUP_MASK >> 2) & 1
    if (IN(2)) xcd_barrier(bar);
    if (IN(2)) {
        pg8::Gemm g{(const bf16_t*)(F.ws + WS_H), (const bf16_t*)(F.ws + WS_WIN), T, LDP, D}; pg8::StaticOrder So; So.init(T, LDP, F.G, (int)blockIdx.x);
        pg8::EpiStoreBf16 E{(bf16_t*)(F.ws + WS_P), LDP, 0};
        pg8::gemm_phase<pg8::EpiStoreBf16, pg8::StaticOrder, true, true>(F.lds, g, So, E);
    }
#endif
    if (IN(2) && IN(3)) xcd_barrier(bar);
    if (IN(3)) { attn_prep_phase(F, args); gdn_prep_phase(F, args); }
#if (DUP_MASK >> 3) & 1
    if (IN(3)) xcd_barrier(bar);
    if (IN(3)) { attn_prep_phase(F, args); gdn_prep_phase(F, args); }
#endif
    if (IN(3) && IN(4)) xcd_barrier(bar);
    if (IN(4)) { mixer_phase(F, args, 0); }
#if (DUP_MASK >> 4) & 1
    if (IN(4)) xcd_barrier(bar);
    if (IN(4)) { mixer_phase(F, args, 1); }
#endif
    if (IN(4) && IN(5)) xcd_barrier(bar);
    if (IN(5)) { post_norm_phase(F, args); }
#if (DUP_MASK >> 5) & 1
    if (IN(5)) xcd_barrier(bar);
    if (IN(5)) { post_norm_phase(F, args); }
#endif
    if (IN(5) && IN(6)) xcd_barrier(bar);
    if (IN(6)) {
        { pg8::Gemm g{(const bf16_t*)(F.ws + WS_OAN), (const bf16_t*)(F.ws + WS_WOA), T, 1024, 512}; pg8::StaticOrder So; So.init(T, 1024, F.G, (int)blockIdx.x);
          pg8::EpiGate<false> E{(const bf16_t*)(F.ws + WS_P) + C_GA, nullptr, (bf16_t*)(F.ws + WS_TMPB), LDP, 0};
          pg8::gemm_phase<pg8::EpiGate<false>, pg8::StaticOrder, true, true>(F.lds, g, So, E); }
        { pg8::Gemm g{(const bf16_t*)(F.ws + WS_OBN), (const bf16_t*)(F.ws + WS_WOB), T, 1024, 512}; pg8::StaticOrder So; So.init(T, 1024, F.G, (int)blockIdx.x);
          pg8::EpiGate<true> E{(const bf16_t*)(F.ws + WS_P) + C_GB, (const bf16_t*)(F.ws + WS_TMPB), (bf16_t*)(F.ws + WS_MERGED), LDP, 0};
          pg8::gemm_phase<pg8::EpiGate<true>, pg8::StaticOrder, true, true>(F.lds, g, So, E); }
    }
#if (DUP_MASK >> 6) & 1
    if (IN(6)) xcd_barrier(bar);
    if (IN(6)) {
        { pg8::Gemm g{(const bf16_t*)(F.ws + WS_OAN), (const bf16_t*)(F.ws + WS_WOA), T, 1024, 512}; pg8::StaticOrder So; So.init(T, 1024, F.G, (int)blockIdx.x);
          pg8::EpiGate<false> E{(const bf16_t*)(F.ws + WS_P) + C_GA, nullptr, (bf16_t*)(F.ws + WS_TMPB), LDP, 0};
          pg8::gemm_phase<pg8::EpiGate<false>, pg8::StaticOrder, true, true>(F.lds, g, So, E); }
        { pg8::Gemm g{(const bf16_t*)(F.ws + WS_OBN), (const bf16_t*)(F.ws + WS_WOB), T, 1024, 512}; pg8::StaticOrder So; So.init(T, 1024, F.G, (int)blockIdx.x);
          pg8::EpiGate<true> E{(const bf16_t*)(F.ws + WS_P) + C_GB, (const bf16_t*)(F.ws + WS_TMPB), (bf16_t*)(F.ws + WS_MERGED), LDP, 0};
          pg8::gemm_phase<pg8::EpiGate<true>, pg8::StaticOrder, true, true>(F.lds, g, So, E); }
    }
#endif
    if (IN(6) && IN(7)) xcd_barrier(bar);
    if (IN(7)) {
        pg8::Gemm g{(const bf16_t*)(F.ws + WS_MERGED), (const bf16_t*)(F.ws + WS_WOUT), T, 1024, 1024}; pg8::StaticOrder So; So.init(T, 1024, F.G, (int)blockIdx.x);
        pg8::EpiResid E{args.in[0], (const float*)(F.ws + WS_MOD) + 2048, (float*)(F.ws + WS_X1)};
        pg8::gemm_phase<pg8::EpiResid, pg8::StaticOrder, true, true>(F.lds, g, So, E);
    }
#if (DUP_MASK >> 7) & 1
    if (IN(7)) xcd_barrier(bar);
    if (IN(7)) {
        pg8::Gemm g{(const bf16_t*)(F.ws + WS_MERGED), (const bf16_t*)(F.ws + WS_WOUT), T, 1024, 1024}; pg8::StaticOrder So; So.init(T, 1024, F.G, (int)blockIdx.x);
        pg8::EpiResid E{args.in[0], (const float*)(F.ws + WS_MOD) + 2048, (float*)(F.ws + WS_X1)};
        pg8::gemm_phase<pg8::EpiResid, pg8::StaticOrder, true, true>(F.lds, g, So, E);
    }
#endif
    if (IN(7) && IN(8)) xcd_barrier(bar);
    if (IN(8)) { norm_mod_phase<false, false>(F, args, (const float*)(F.ws + WS_X1), args.in[20], 3072, 4096, (bf16_t*)(F.ws + WS_H)); }
#if (DUP_MASK >> 8) & 1
    if (IN(8)) xcd_barrier(bar);
    if (IN(8)) { norm_mod_phase<false, false>(F, args, (const float*)(F.ws + WS_X1), args.in[20], 3072, 4096, (bf16_t*)(F.ws + WS_H)); }
#endif
    if (IN(8) && IN(9)) xcd_barrier(bar);
    if (IN(9)) {
        pg8::Gemm g{(const bf16_t*)(F.ws + WS_H), (const bf16_t*)(F.ws + WS_W9), T, 768, 1024}; pg8::StaticOrder So; So.init(T, 768, F.G, (int)blockIdx.x);
        pg8::EpiSharedRouter E{(bf16_t*)(F.ws + WS_SACT), (float*)(F.ws + WS_LOGITS)};
        pg8::gemm_phase<pg8::EpiSharedRouter, pg8::StaticOrder, true, true>(F.lds, g, So, E);
    }
#if (DUP_MASK >> 9) & 1
    if (IN(9)) xcd_barrier(bar);
    if (IN(9)) {
        pg8::Gemm g{(const bf16_t*)(F.ws + WS_H), (const bf16_t*)(F.ws + WS_W9), T, 768, 1024}; pg8::StaticOrder So; So.init(T, 768, F.G, (int)blockIdx.x);
        pg8::EpiSharedRouter E{(bf16_t*)(F.ws + WS_SACT), (float*)(F.ws + WS_LOGITS)};
        pg8::gemm_phase<pg8::EpiSharedRouter, pg8::StaticOrder, true, true>(F.lds, g, So, E);
    }
#endif
    if (IN(9) && IN(10)) xcd_barrier(bar);
    if (IN(10)) { route_phase(F, args); }
#if (DUP_MASK >> 10) & 1
    if (IN(10)) xcd_barrier(bar);
    if (IN(10)) { route_phase(F, args); }
#endif
    if (IN(10) && IN(11)) xcd_barrier(bar);
    if (IN(11)) { moe_phase(F, args); }
#if (DUP_MASK >> 11) & 1
    if (IN(11)) xcd_barrier(bar);
    if (IN(11)) { moe_phase(F, args); }
#endif
    if (IN(11) && IN(12)) xcd_barrier(bar);
    if (IN(12)) {
        pg8::Gemm g{(const bf16_t*)(F.ws + WS_SACT), (const bf16_t*)(F.ws + WS_WSD), T, 1024, 256}; pg8::StaticOrder So; So.init(T, 1024, F.G, (int)blockIdx.x);
        pg8::EpiFinal E{(const float*)(F.ws + WS_X1), (const float*)(F.ws + WS_MOD) + 5120, (const bf16_t*)(F.ws + WS_Y), F.out};
        pg8::gemm_phase<pg8::EpiFinal, pg8::StaticOrder, true, true>(F.lds, g, So, E);
    }
#if (DUP_MASK >> 12) & 1
    if (IN(12)) xcd_barrier(bar);
    if (IN(12)) {
        pg8::Gemm g{(const bf16_t*)(F.ws + WS_SACT), (const bf16_t*)(F.ws + WS_WSD), T, 1024, 256}; pg8::StaticOrder So; So.init(T, 1024, F.G, (int)blockIdx.x);
        pg8::EpiFinal E{(const float*)(F.ws + WS_X1), (const float*)(F.ws + WS_MOD) + 5120, (const bf16_t*)(F.ws + WS_Y), F.out};
        pg8::gemm_phase<pg8::EpiFinal, pg8::StaticOrder, true, true>(F.lds, g, So, E);
    }
#endif
#undef IN
}
extern "C" void kernel_launch(void* const* d_in, const int* in_sizes, int n_in, void* d_out, int out_size, void* d_ws, size_t ws_size, hipStream_t stream) {
  static int grid = 0;
  if (grid == 0) {
    int dev = 0, cus = 0;
    if (n_in != 27 || out_size != T * D || ws_size < WS_END) { fprintf(stderr, "kernel_launch: unexpected problem (n_in %d, out %d, ws %zu < %zu)\n", n_in, out_size, ws_size, (size_t)WS_END); grid = -1; return; }
    if (hipGetDevice(&dev) != hipSuccess || hipDeviceGetAttribute(&cus, hipDeviceAttributeMultiprocessorCount, dev) != hipSuccess) { fprintf(stderr, "kernel_launch: device query failed\n"); grid = -1; return; }
    if (hipFuncSetAttribute((const void*)mega, hipFuncAttributeMaxDynamicSharedMemorySize, LDS_BYTES) != hipSuccess) { fprintf(stderr, "kernel_launch: hipFuncSetAttribute failed\n"); grid = -1; return; }
    int per_cu = 0;
    if (hipOccupancyMaxActiveBlocksPerMultiprocessor(&per_cu, (const void*)mega, NWAVES * 64, LDS_BYTES) != hipSuccess || per_cu < 1) fprintf(stderr, "kernel_launch: occupancy query says %d blocks per CU\n", per_cu);
    (void)hipGetLastError();
    grid = cus;
  }
  if (grid < 0) return;
  (void)hipMemsetAsync((unsigned char*)d_ws + WS_CTL, 0, CTL_ZERO_BYTES, stream);
  Args a{};
  for (int i = 0; i < 27; ++i) a.in[i] = (const float*)d_in[i];
  a.out = (float*)d_out; a.ws = (unsigned char*)d_ws;
#ifndef N_LAUNCH_PHASES
  a.ph_lo = 0; a.ph_hi = 13;
  hipLaunchKernelGGL(mega, dim3(grid), dim3(NWAVES * 64), LDS_BYTES, stream, a);
#else
  for (int ph = 0; ph < 13; ++ph) { a.ph_lo = ph; a.ph_hi = ph + 1; hipLaunchKernelGGL(mega, dim3(grid), dim3(NWAVES * 64), LDS_BYTES, stream, a); }
#endif
}
```

```cpp
#include <hip/hip_runtime.h>
#include <stdint.h>
#include <cstdio>

typedef unsigned short bf16_t;
constexpr int D = 1024, NB = 2, S = 8192, T = NB * S;
constexpr int INC = 5640;
constexpr int LDP = 5632;
constexpr int C_QA = 0, C_KA = 512, C_VA = 1024, C_ZA = 1536, C_QB = 2048, C_KB = 2560, C_VB = 3072, C_GA = 3584, C_GB = 4608;
constexpr int NE = 256, TOPK = 8, NA = T * TOPK;
constexpr float EPS = 1e-6f;
constexpr float LAM_INIT = 0.2f;
__device__ __forceinline__ float bf2f(bf16_t v) { return __uint_as_float(((unsigned)v) << 16); }
__device__ __forceinline__ float siluf(float x) { return x / (1.f + __expf(-x)); }
__device__ __forceinline__ float sigmf(float x) { return 1.f / (1.f + __expf(-x)); }
__device__ __forceinline__ float softplusf(float x) { return x > 20.f ? x : log1pf(__expf(x)); }
__device__ __forceinline__ float wave_sum(float v) {
#pragma unroll
  for (int o = 1; o < 64; o <<= 1) v += __shfl_xor(v, o);
  return v;
}
constexpr size_t MiB = 1u << 20;
constexpr size_t WS_CTL = 0, CTL_ZERO_BYTES = 1 * MiB;
constexpr size_t WS_MODP = 1 * MiB;
constexpr size_t WS_MOD = 1 * MiB + 256 * 1024;
constexpr size_t WS_SCAL = 1 * MiB + 320 * 1024;
constexpr size_t WS_WIN = 2 * MiB;
constexpr size_t WS_WOA = 13 * MiB, WS_WOB = 14 * MiB;
constexpr size_t WS_WOUT = 15 * MiB;
constexpr size_t WS_W9 = 17 * MiB;
constexpr size_t WS_WSD = 19 * MiB;
constexpr size_t WS_BD = 20 * MiB;
constexpr size_t WS_H = 32 * MiB;
constexpr size_t WS_P = 64 * MiB;
constexpr size_t WS_OAN = 240 * MiB, WS_OBN = 256 * MiB;
constexpr size_t WS_TMPB = 272 * MiB;
constexpr size_t WS_MERGED = 304 * MiB;
constexpr size_t WS_X1 = 336 * MiB;
constexpr size_t WS_LOGITS = 400 * MiB;
constexpr size_t WS_SACT = 416 * MiB;
constexpr size_t WS_TOPI = 424 * MiB, WS_TOPW = 425 * MiB;
constexpr size_t WS_Y = 432 * MiB;
constexpr size_t WS_ACTB = 704 * MiB;
constexpr size_t WS_LIST = 768 * MiB;
constexpr size_t WS_QN = 800 * MiB, WS_KN = 816 * MiB;
constexpr size_t WS_OB = 832 * MiB;
constexpr size_t WS_OA = 864 * MiB;
constexpr size_t WS_GDN = 896 * MiB;
constexpr size_t WS_XA = 992 * MiB;
constexpr size_t XA_BLOCK = (size_t)32 * 640 * 16;
constexpr size_t WS_END = WS_XA + 256 * XA_BLOCK;
constexpr int CW_BAR = 4096;

#define GAS __attribute__((address_space(1)))
#define LAS __attribute__((address_space(3)))
typedef unsigned v4u __attribute__((ext_vector_type(4)));
typedef float f32x4 __attribute__((ext_vector_type(4)));
typedef short bf16x8 __attribute__((ext_vector_type(8)));
typedef GAS unsigned gu32;
typedef GAS unsigned long long gu64;
#define RLX_AGENT __ATOMIC_RELAXED, __HIP_MEMORY_SCOPE_AGENT
#define LDS_WAIT() asm volatile("s_waitcnt lgkmcnt(0)" ::: "memory")
#define VM_WAIT() asm volatile("s_waitcnt vmcnt(0)" ::: "memory")
__device__ __forceinline__ unsigned f2bf(float f) { unsigned u = __builtin_bit_cast(unsigned, f); return (u + 0x7fffu + ((u >> 16) & 1u)) >> 16; }
__device__ __forceinline__ unsigned pk2(float lo, float hi) { return f2bf(lo) | (f2bf(hi) << 16); }

constexpr int NWAVES = 8;
constexpr int LDS_BYTES = 163840;
constexpr int CTRL_OFF = 159744;
constexpr int MISC_OFF = CTRL_OFF + 320;
constexpr int CW_ECNT = 256;

struct Frame {
    LAS unsigned char* lds;
    volatile LAS unsigned* MISC;
    int tid, lane, wave, vcu, G;
    float* out; unsigned char* ws;
    const __attribute__((address_space(4))) unsigned char* karg;
};
#define KIN(k) (*(const float* const __attribute__((address_space(4)))*)(F.karg + 8 * (k)))
struct Args { const float* in[27]; float* out; unsigned char* ws; int ph_lo, ph_hi; };
namespace pg8 {
#define PG8_LAS __attribute__((address_space(3)))
typedef unsigned short bf16_t;
typedef short bf16x8 __attribute__((ext_vector_type(8)));
typedef float f32x4 __attribute__((ext_vector_type(4)));
typedef unsigned u32x4 __attribute__((ext_vector_type(4)));
constexpr int BM = 256, BK = 64, HALF = 128, HTB = HALF * BK * 2  , STAGE_BYTES = 8 * HTB, NXCD = 8, WGM = 8;

__host__ __device__ __forceinline__ int lds_byte(int r, int c) { const int st = (r >> 4) * 2 + (c >> 5), rr = r & 15, cc = c & 31, ob = rr * 64 + cc * 2; return st * 1024 + (ob ^ (((ob >> 9) & 1) << 5)); }
__host__ __device__ __forceinline__ void stage_rc(int b, int& R, int& C) { const int st = b / 1024, sb = b % 1024, swz = sb ^ (((sb >> 9) & 1) << 5); R = (st >> 1) * 16 + swz / 64; C = (st & 1) * 32 + (swz % 64) / 2; }
__host__ __device__ __forceinline__ int perm32(int rho) { const int n = rho >> 4, i = rho & 15; return 8 * (i >> 2) + 4 * n + (i & 3); }

struct Unit { int pm, pn; };
struct Gemm { const bf16_t* A; const bf16_t* Bt; int M, N, K; };

struct StaticOrder {
    int nM, nN, nwg, G, c;
    __host__ __device__ void init(int M, int N, int G_, int c_) { nM = M / BM; nN = N / BM; nwg = nM * nN; G = G_; c = c_; }
    __host__ __device__ bool next(int i, Unit& u) const {
        const long L = (long)i * G + c; if (L >= nwg) return false;
        int wgid = (int)L; { const int q = nwg / NXCD, r = nwg % NXCD, xcd = wgid % NXCD, off = wgid / NXCD; wgid = (xcd < r ? xcd * (q + 1) : r * (q + 1) + (xcd - r) * q) + off; }
        const int nig = WGM * nN, gid = wgid / nig, fm = gid * WGM, gsz = (nM - fm) < WGM ? (nM - fm) : WGM;
        u.pm = fm + ((wgid % nig) % gsz); u.pn = (wgid % nig) / gsz; return true;
    }
    __device__ __forceinline__ void a_ready(const Unit&) const {}
    __device__ __forceinline__ void done(const Unit&) const {}
};

__device__ __forceinline__ unsigned cvt_pk_bf16(float lo, float hi) { unsigned r; asm volatile("v_cvt_pk_bf16_f32 %0, %1, %2" : "=v"(r) : "v"(lo), "v"(hi)); return r; }
typedef float f32x2 __attribute__((ext_vector_type(2)));
template <class Epi, class Sched, bool ALIGN_EPI = false, bool SP2 = false>
__device__ __forceinline__ void gemm_phase(PG8_LAS unsigned char* lds, const Gemm g, const Sched& S, const Epi& E) {
    const int tid = threadIdx.x, wid = __builtin_amdgcn_readfirstlane(tid >> 6), lane = tid & 63, wr = wid >> 2, wc = wid & 3, fr = lane & 15, fq = lane >> 4;
    const int K = g.K, nt = K / BK;
    unsigned voffA[2], voffB[2];
#pragma unroll
    for (int i = 0; i < 2; ++i) { int R, C; stage_rc(tid * 16 + i * 8192, R, C); const int Rb = Epi::PERM ? ((R & ~31) + perm32(R & 31)) : R;
        voffA[i] = (unsigned)(R * K + C) * 2u; voffB[i] = (unsigned)(Rb * K + C) * 2u; }
    const size_t kstep = (size_t)(BK * 2);
    const size_t hstep = (size_t)HALF * K * 2;
    const size_t tstep = 2 * hstep;
    const unsigned ldsw = (unsigned)wid * 1024u;
    const int aoff = lds_byte(wr * 64 + fr, fq * 8), boff = lds_byte(wc * 32 + fr, fq * 8);
#define PG8_SA(b, h) (((b) * 2 + (h)) * HTB)
#define PG8_SB(b, h) ((4 + (b) * 2 + (h)) * HTB)
#define PG8_STAGE(bufoff, gbase, voff) do { _Pragma("unroll") for (int _i = 0; _i < 2; ++_i) \
        __builtin_amdgcn_global_load_lds((const unsigned*)((const char*)(gbase) + (voff)[_i]), (PG8_LAS unsigned*)(lds + (bufoff) + ldsw + _i * 8192), 16, 0, 0); } while (0)
#define PG8_LDA(dst, b, h) do { _Pragma("unroll") for (int m = 0; m < 4; ++m) _Pragma("unroll") for (int k = 0; k < 2; ++k) dst[m][k] = *(const PG8_LAS bf16x8*)(lds + PG8_SA(b, h) + aoff + m * 2048 + k * 1024); } while (0)
#define PG8_LDB(dst, b, h) do { _Pragma("unroll") for (int n = 0; n < 2; ++n) _Pragma("unroll") for (int k = 0; k < 2; ++k) dst[n][k] = *(const PG8_LAS bf16x8*)(lds + PG8_SB(b, h) + boff + n * 2048 + k * 1024); } while (0)
#define PG8_MMA(ai, bj, At, Bt) do { __builtin_amdgcn_s_setprio(1); _Pragma("unroll") for (int m = 0; m < 4; ++m) _Pragma("unroll") for (int n = 0; n < 2; ++n) _Pragma("unroll") for (int k = 0; k < 2; ++k) \
        acc[ai][bj][m][n] = __builtin_amdgcn_mfma_f32_16x16x32_bf16(Bt[n][k], At[m][k], acc[ai][bj][m][n], 0, 0, 0); __builtin_amdgcn_s_setprio(0); } while (0)
#define PG8_WAIT_V(n) asm volatile("s_waitcnt vmcnt(" #n ")" ::: "memory")
#define PG8_WAIT_L(n) asm volatile("s_waitcnt lgkmcnt(" #n ")" ::: "memory")
#define PG8_BAR __builtin_amdgcn_s_barrier()
#define PG8_SCHED __builtin_amdgcn_sched_barrier(0)
    Unit cur, nxt; int ui = 0;
    if (!S.next(0, cur)) return;
    f32x4 acc[2][2][4][2];
#pragma unroll
    for (int a = 0; a < 2; ++a)
#pragma unroll
        for (int b = 0; b < 2; ++b)
#pragma unroll
            for (int m = 0; m < 4; ++m)
#pragma unroll
                for (int n = 0; n < 2; ++n) acc[a][b][m][n] = (f32x4){0.f, 0.f, 0.f, 0.f};
    bf16x8 At[4][2], B0[2][2], B1[2][2];
    const char* cA = (const char*)g.A + (size_t)cur.pm * tstep; const char* cB = (const char*)g.Bt + (size_t)cur.pn * tstep;
    S.a_ready(cur);
    if constexpr (SP2) {
        PG8_STAGE(PG8_SB(0, 0), cB, voffB); PG8_STAGE(PG8_SB(0, 1), cB + hstep, voffB); PG8_STAGE(PG8_SA(0, 0), cA, voffA); PG8_STAGE(PG8_SA(0, 1), cA + hstep, voffA);
        if (wr == 1) PG8_BAR;
        PG8_WAIT_V(2); PG8_BAR;
        PG8_STAGE(PG8_SB(1, 0), cB + kstep, voffB); PG8_STAGE(PG8_SA(1, 0), cA + kstep, voffA); PG8_STAGE(PG8_SB(1, 1), cB + hstep + kstep, voffB);
        PG8_WAIT_V(6); PG8_BAR;
    } else {
        PG8_STAGE(PG8_SB(0, 0), cB, voffB); PG8_STAGE(PG8_SA(0, 0), cA, voffA); PG8_STAGE(PG8_SB(0, 1), cB + hstep, voffB); PG8_STAGE(PG8_SA(0, 1), cA + hstep, voffA);
        if (wr == 1) PG8_BAR;
        PG8_WAIT_V(4); PG8_BAR;
        PG8_STAGE(PG8_SB(1, 0), cB + kstep, voffB); PG8_STAGE(PG8_SA(1, 0), cA + kstep, voffA); PG8_STAGE(PG8_SB(1, 1), cB + hstep + kstep, voffB);
        PG8_WAIT_V(6); PG8_BAR;
    }
    for (;;) {
        const bool has_next = S.next(ui + 1, nxt);
        const char* nA = has_next ? (const char*)g.A + (size_t)nxt.pm * tstep : cA; const char* nB = has_next ? (const char*)g.Bt + (size_t)nxt.pn * tstep : cB;
        for (int t = 0; t < nt; t += 2) {
            const bool last = (t == nt - 2);
            const char* a1 = cA + (size_t)(t + 1) * kstep;
            const char* a2 = last ? nA : cA + (size_t)(t + 2) * kstep; const char* b2 = last ? nB : cB + (size_t)(t + 2) * kstep;
            const char* a3 = a2 + kstep; const char* b3 = b2 + kstep;
            if (last && has_next) S.a_ready(nxt);
            if constexpr (SP2) {
            PG8_LDB(B0, 0, 0); PG8_LDB(B1, 0, 1); PG8_SCHED; PG8_LDA(At, 0, 0); PG8_STAGE(PG8_SA(1, 1), a1 + hstep, voffA);
            PG8_WAIT_V(8); PG8_WAIT_L(0); PG8_BAR; PG8_MMA(0, 0, At, B0); PG8_MMA(0, 1, At, B1); PG8_BAR; PG8_SCHED;
            PG8_LDA(At, 0, 1); PG8_STAGE(PG8_SB(0, 0), b2, voffB); PG8_STAGE(PG8_SB(0, 1), b2 + hstep, voffB); PG8_STAGE(PG8_SA(0, 0), a2, voffA);
            PG8_WAIT_V(8); PG8_WAIT_L(0); PG8_BAR; PG8_MMA(1, 0, At, B0); PG8_MMA(1, 1, At, B1); PG8_BAR; PG8_SCHED;
            PG8_LDB(B0, 1, 0); PG8_LDB(B1, 1, 1); PG8_SCHED; PG8_LDA(At, 1, 0); PG8_STAGE(PG8_SA(0, 1), a2 + hstep, voffA);
            PG8_WAIT_V(8); PG8_WAIT_L(0); PG8_BAR; PG8_MMA(0, 0, At, B0); PG8_MMA(0, 1, At, B1); PG8_BAR; PG8_SCHED;
            PG8_LDA(At, 1, 1); PG8_STAGE(PG8_SB(1, 0), b3, voffB); PG8_STAGE(PG8_SB(1, 1), b3 + hstep, voffB); PG8_STAGE(PG8_SA(1, 0), a3, voffA);
            PG8_WAIT_V(8); PG8_WAIT_L(0); PG8_BAR; PG8_MMA(1, 0, At, B0); PG8_MMA(1, 1, At, B1); PG8_BAR; PG8_SCHED;
            } else {
            PG8_LDB(B0, 0, 0); PG8_SCHED; PG8_LDA(At, 0, 0); PG8_STAGE(PG8_SA(1, 1), a1 + hstep, voffA);
            PG8_WAIT_L(8); PG8_BAR; PG8_WAIT_L(0); PG8_MMA(0, 0, At, B0); PG8_BAR; PG8_SCHED;
            PG8_LDB(B1, 0, 1); PG8_STAGE(PG8_SB(0, 0), b2, voffB);
            PG8_BAR; PG8_WAIT_L(0); PG8_MMA(0, 1, At, B1); PG8_BAR;
            PG8_LDA(At, 0, 1); PG8_STAGE(PG8_SA(0, 0), a2, voffA);
            PG8_BAR; PG8_WAIT_L(0); PG8_MMA(1, 0, At, B0); PG8_BAR; PG8_SCHED;
            PG8_STAGE(PG8_SB(0, 1), b2 + hstep, voffB);
            PG8_WAIT_V(6); PG8_BAR; PG8_MMA(1, 1, At, B1); PG8_BAR;
            PG8_LDB(B0, 1, 0); PG8_SCHED; PG8_LDA(At, 1, 0); PG8_STAGE(PG8_SA(0, 1), a2 + hstep, voffA);
            PG8_WAIT_L(8); PG8_BAR; PG8_WAIT_L(0); PG8_MMA(0, 0, At, B0); PG8_BAR; PG8_SCHED;
            PG8_LDB(B1, 1, 1); PG8_STAGE(PG8_SB(1, 0), b3, voffB);
            PG8_BAR; PG8_WAIT_L(0); PG8_MMA(0, 1, At, B1); PG8_BAR;
            PG8_LDA(At, 1, 1); PG8_STAGE(PG8_SA(1, 0), a3, voffA);
            PG8_BAR; PG8_WAIT_L(0); PG8_MMA(1, 0, At, B0); PG8_BAR; PG8_SCHED;
            PG8_STAGE(PG8_SB(1, 1), b3 + hstep, voffB);
            PG8_WAIT_V(6); PG8_BAR; PG8_MMA(1, 1, At, B1); PG8_BAR;
            }
        }
        if constexpr (ALIGN_EPI) { if (wr == 0) PG8_BAR; }
        if constexpr (!Epi::AFTER_DRAIN) { E(acc, cur, wr, wc, fr, fq); S.done(cur); }
        if (!has_next) break;
#pragma unroll
        for (int a = 0; a < 2; ++a)
#pragma unroll
            for (int b = 0; b < 2; ++b)
#pragma unroll
                for (int m = 0; m < 4; ++m)
#pragma unroll
                    for (int n = 0; n < 2; ++n) acc[a][b][m][n] = (f32x4){0.f, 0.f, 0.f, 0.f};
        cur = nxt; cA = nA; cB = nB; ++ui;
        if constexpr (ALIGN_EPI) { if (wr == 1) PG8_BAR; }
    }
    PG8_WAIT_V(0);
    if constexpr (!ALIGN_EPI) { if (wr == 0) PG8_BAR; }
    PG8_BAR;
    if constexpr (Epi::AFTER_DRAIN) { E.fused(acc, cur, wr, wc, fr, fq, lds, wid, lane); S.done(cur); }
#undef PG8_SA
#undef PG8_SB
#undef PG8_STAGE
#undef PG8_LDA
#undef PG8_LDB
#undef PG8_MMA
#undef PG8_WAIT_V
#undef PG8_WAIT_L
#undef PG8_BAR
#undef PG8_SCHED
}
}
namespace pg8 {
struct EpiStoreBf16 {
    static constexpr bool PERM = true, AFTER_DRAIN = false;
    bf16_t* O; int ldc; int pad;
    __device__ __forceinline__ void operator()(const f32x4 (&acc)[2][2][4][2], const Unit& u, int wr, int wc, int fr, int fq) const {
        const int row0 = u.pm * BM + wr * 64 + fr, col0 = u.pn * BM + wc * 32 + 8 * fq;
#pragma unroll
        for (int ai = 0; ai < 2; ++ai)
#pragma unroll
            for (int m = 0; m < 4; ++m) { bf16_t* rowp = O + (size_t)(row0 + ai * HALF + m * 16) * ldc + col0;
#pragma unroll
                for (int bj = 0; bj < 2; ++bj) { const f32x4 v0 = acc[ai][bj][m][0], v1 = acc[ai][bj][m][1];
                    u32x4 w; w.x = cvt_pk_bf16(v0[0], v0[1]); w.y = cvt_pk_bf16(v0[2], v0[3]); w.z = cvt_pk_bf16(v1[0], v1[1]); w.w = cvt_pk_bf16(v1[2], v1[3]);
                    *(u32x4*)(rowp + bj * HALF) = w; } }
    }
};
__device__ __forceinline__ float bflo(unsigned w) { return __uint_as_float(w << 16); }
__device__ __forceinline__ float bfhi(unsigned w) { return __uint_as_float(w & 0xffff0000u); }
__device__ __forceinline__ float sigm(float x) { return __builtin_amdgcn_rcpf(1.f + __expf(-x)); }
template <bool ADD> struct EpiGate {
    static constexpr bool PERM = true, AFTER_DRAIN = false;
    const bf16_t* gate; const bf16_t* prev; bf16_t* O; int ldg; int pad;
    __device__ __forceinline__ void operator()(const f32x4 (&acc)[2][2][4][2], const Unit& u, int wr, int wc, int fr, int fq) const {
        const int row0 = u.pm * BM + wr * 64 + fr, col0 = u.pn * BM + wc * 32 + 8 * fq;
#pragma unroll
        for (int ai = 0; ai < 2; ++ai)
#pragma unroll
            for (int m = 0; m < 4; ++m) { const size_t r = (size_t)(row0 + ai * HALF + m * 16);
#pragma unroll
                for (int bj = 0; bj < 2; ++bj) { const int c = col0 + bj * HALF;
                    const u32x4 gw = *(const u32x4*)(gate + r * ldg + c);
                    const f32x4 v0 = acc[ai][bj][m][0], v1 = acc[ai][bj][m][1];
                    float o[8];
                    o[0] = sigm(bflo(gw.x)) * v0[0]; o[1] = sigm(bfhi(gw.x)) * v0[1]; o[2] = sigm(bflo(gw.y)) * v0[2]; o[3] = sigm(bfhi(gw.y)) * v0[3];
                    o[4] = sigm(bflo(gw.z)) * v1[0]; o[5] = sigm(bfhi(gw.z)) * v1[1]; o[6] = sigm(bflo(gw.w)) * v1[2]; o[7] = sigm(bfhi(gw.w)) * v1[3];
                    if (ADD) { const u32x4 pw = *(const u32x4*)(prev + r * 1024 + c);
                        o[0] += bflo(pw.x); o[1] += bfhi(pw.x); o[2] += bflo(pw.y); o[3] += bfhi(pw.y); o[4] += bflo(pw.z); o[5] += bfhi(pw.z); o[6] += bflo(pw.w); o[7] += bfhi(pw.w); }
                    u32x4 w; w.x = cvt_pk_bf16(o[0], o[1]); w.y = cvt_pk_bf16(o[2], o[3]); w.z = cvt_pk_bf16(o[4], o[5]); w.w = cvt_pk_bf16(o[6], o[7]);
                    *(u32x4*)(O + r * 1024 + c) = w; } }
    }
};
struct EpiResid {
    static constexpr bool PERM = false, AFTER_DRAIN = false;
    const float* base; const float* gvec; float* out;
    __device__ __forceinline__ void operator()(const f32x4 (&acc)[2][2][4][2], const Unit& u, int wr, int wc, int fr, int fq) const {
        const int row0 = u.pm * BM + wr * 64 + fr, col0 = u.pn * BM + wc * 32 + 4 * fq;
        const float* gv = gvec + ((u.pm * BM) / 8192) * 6144;
#pragma unroll
        for (int bj = 0; bj < 2; ++bj)
#pragma unroll
            for (int n = 0; n < 2; ++n) { const int c = col0 + bj * HALF + n * 16; const f32x4 g = *(const f32x4*)(gv + c);
#pragma unroll
                for (int ai = 0; ai < 2; ++ai)
#pragma unroll
                    for (int m = 0; m < 4; ++m) { const size_t off = (size_t)(row0 + ai * HALF + m * 16) * 1024 + c;
                        const f32x4 b = *(const f32x4*)(base + off); *(f32x4*)(out + off) = b + g * acc[ai][bj][m][n]; } }
    }
};
struct EpiSharedRouter {
    static constexpr bool PERM = true, AFTER_DRAIN = false;
    bf16_t* sact; float* logits;
    __device__ __forceinline__ void operator()(const f32x4 (&acc)[2][2][4][2], const Unit& u, int wr, int wc, int fr, int fq) const {
        const int row0 = u.pm * BM + wr * 64 + fr;
        if (u.pn < 2) {
#pragma unroll
            for (int ai = 0; ai < 2; ++ai)
#pragma unroll
                for (int m = 0; m < 4; ++m) { const size_t r = (size_t)(row0 + ai * HALF + m * 16);
#pragma unroll
                    for (int bj = 0; bj < 2; ++bj) { const int c8 = (u.pn * BM + bj * HALF + wc * 32 + 8 * fq) >> 1;
                        const f32x4 g = acc[ai][bj][m][0], up = acc[ai][bj][m][1];
                        float a0 = g[0] * sigm(g[0]) * up[0], a1 = g[1] * sigm(g[1]) * up[1], a2 = g[2] * sigm(g[2]) * up[2], a3 = g[3] * sigm(g[3]) * up[3];
                        uint2 w; w.x = cvt_pk_bf16(a0, a1); w.y = cvt_pk_bf16(a2, a3);
                        *(uint2*)(sact + r * 256 + c8) = w; } }
        } else {
#pragma unroll
            for (int ai = 0; ai < 2; ++ai)
#pragma unroll
                for (int m = 0; m < 4; ++m) { const size_t r = (size_t)(row0 + ai * HALF + m * 16);
#pragma unroll
                    for (int bj = 0; bj < 2; ++bj) { const int c = bj * HALF + wc * 32 + 8 * fq;
                        *(f32x4*)(logits + r * 256 + c) = acc[ai][bj][m][0]; *(f32x4*)(logits + r * 256 + c + 4) = acc[ai][bj][m][1]; } }
        }
    }
};
struct EpiFinal {
    static constexpr bool PERM = false, AFTER_DRAIN = false;
    const float* x1; const float* gvec; const bf16_t* Y; float* out;
    __device__ __forceinline__ void operator()(const f32x4 (&acc)[2][2][4][2], const Unit& u, int wr, int wc, int fr, int fq) const {
        const int row0 = u.pm * BM + wr * 64 + fr, col0 = u.pn * BM + wc * 32 + 4 * fq;
        const float* gv = gvec + ((u.pm * BM) / 8192) * 6144;
#pragma unroll
        for (int ai = 0; ai < 2; ++ai)
#pragma unroll
            for (int m = 0; m < 4; ++m) { const size_t r = (size_t)(row0 + ai * HALF + m * 16);
#pragma unroll
                for (int bj = 0; bj < 2; ++bj)
#pragma unroll
                    for (int n = 0; n < 2; ++n) { const int c = col0 + bj * HALF + n * 16;
                        f32x4 s = acc[ai][bj][m][n];
#pragma unroll
                        for (int k = 0; k < 8; ++k) { const uint2 yw = *(const uint2*)(Y + (r * 8 + k) * 1024 + c);
                            s[0] += bflo(yw.x); s[1] += bfhi(yw.x); s[2] += bflo(yw.y); s[3] += bfhi(yw.y); }
                        const f32x4 g = *(const f32x4*)(gv + c); const f32x4 b = *(const f32x4*)(x1 + r * 1024 + c);
                        *(f32x4*)(out + r * 1024 + c) = b + g * s; } }
    }
};
}
#define XB_TMO      128
#define XB_XCNT(j)  (256  + 64 * (j))
#define XB_XSUB(j)  (1280 + 64 * (j))
#define XB_XGEN(j)  (2304 + 64 * (j))
#define XB_TOP      3328
#define XB_TOPGEN   3392
#define XCD_BAR_WORDS 3456
#define XB_SPIN_CAP (1u << 18)

__device__ __forceinline__ unsigned xb_ld(unsigned* p)              { return __hip_atomic_load(p, __ATOMIC_RELAXED, __HIP_MEMORY_SCOPE_AGENT); }
__device__ __forceinline__ unsigned xb_add(unsigned* p, unsigned v) { return __hip_atomic_fetch_add(p, v, __ATOMIC_RELAXED, __HIP_MEMORY_SCOPE_AGENT); }
__device__ __forceinline__ unsigned xb_xcc_id() { return (unsigned)__builtin_amdgcn_s_getreg((3 << 11) | 20) & 0xFu; }
#define XB_SPIN(cond, bar) do { unsigned _sp = 0; while (cond) { __builtin_amdgcn_s_sleep(1); \
    if ((++_sp & 255u) == 0u) { if (xb_ld(&(bar)[XB_TMO])) break; if (_sp > XB_SPIN_CAP) { atomicAdd(&(bar)[XB_TMO], 1u); break; } } } } while (0)

struct XcdBarrier {
    unsigned* bar; unsigned x;
    volatile LAS unsigned* st;
};

__device__ __forceinline__ XcdBarrier xcd_barrier_post(unsigned* bar, volatile LAS unsigned* st) {
    XcdBarrier b; b.bar = bar; b.x = xb_xcc_id(); b.st = st;
    if (threadIdx.x == 0) (void)xb_add(&bar[XB_XCNT(b.x)], 1u);
    return b;
}
__device__ __forceinline__ void xcd_barrier_complete(unsigned* bar, unsigned x, unsigned& nloc, unsigned& nx) {
    const unsigned G = gridDim.x * gridDim.y * gridDim.z;
    unsigned sum, cnt, mine, sp = 0u;
    for (;;) {
        sum = 0u; cnt = 0u; mine = 0u;
#pragma unroll
        for (unsigned j = 0; j < 16; ++j) { const unsigned c = xb_ld(&bar[XB_XCNT(j)]); sum += c; cnt += (c > 0u) ? 1u : 0u; mine = (j == x) ? c : mine; }
        if (sum == G) break;
        __builtin_amdgcn_s_sleep(1);
        if ((++sp & 255u) == 0u) { if (xb_ld(&bar[XB_TMO])) break; if (sp > XB_SPIN_CAP) { atomicAdd(&bar[XB_TMO], 1u); break; } }
    }
    nloc = mine > 0u ? mine : 1u; nx = cnt > 0u ? cnt : 1u;
}

__device__ __forceinline__ void xcd_barrier(const XcdBarrier& b) {
    asm volatile("s_waitcnt vmcnt(0)" ::: "memory");
    __syncthreads();
    if (threadIdx.x == 0) {
        unsigned* bar = b.bar;
        __builtin_amdgcn_s_waitcnt(0);
        unsigned nloc = b.st[0], nx = b.st[1];
        if (nloc == 0u) { xcd_barrier_complete(bar, b.x, nloc, nx); b.st[0] = nloc; b.st[1] = nx; }
        const unsigned old = xb_add(&bar[XB_XSUB(b.x)], 1u);
        const unsigned gen = old / nloc;
        if (old + 1u == (gen + 1u) * nloc) {
            __builtin_amdgcn_fence(__ATOMIC_RELEASE, "agent");
            asm volatile("s_waitcnt vmcnt(0)" ::: "memory");
            const unsigned og = xb_add(&bar[XB_TOP], 1u);
            const unsigned tg = og / nx;
            if (og + 1u == (tg + 1u) * nx) xb_add(&bar[XB_TOPGEN], 1u);
            else XB_SPIN(xb_ld(&bar[XB_TOPGEN]) == tg, bar);
            __builtin_amdgcn_fence(__ATOMIC_ACQUIRE, "agent");
            xb_add(&bar[XB_XGEN(b.x)], 1u);
            asm volatile("s_waitcnt vmcnt(0)" ::: "memory");
        } else {
            XB_SPIN(xb_ld(&bar[XB_XGEN(b.x)]) == gen, bar);
            __builtin_amdgcn_fence(__ATOMIC_ACQUIRE, "agent");
            asm volatile("s_waitcnt vmcnt(0)" ::: "memory");
        }
    }
    __syncthreads();
}
template <class Map>
__device__ __forceinline__ void transpose_item(const float* W, int ldw, int K, bf16_t* WT, int row_off, int nblk, LAS float* scr, int item, int lane, Map srccol) {
    const int kb = item / nblk, nb = item % nblk, k0 = 64 * kb, n0 = 32 * nb;
    const int sc = srccol(n0 + (lane & 31));
#pragma unroll 8
    for (int i = 0; i < 32; ++i) { const int kk = 2 * i + (lane >> 5); scr[kk * 33 + (lane & 31)] = W[(size_t)(k0 + kk) * ldw + sc]; }
    LDS_WAIT(); asm volatile("" ::: "memory");
    const int c = lane & 7;
#pragma unroll
    for (int j = 0; j < 4; ++j) { const int n = (lane >> 3) + 8 * j; const LAS float* s = scr + (8 * c) * 33 + n;
        v4u o; o.x = pk2(s[0 * 33], s[1 * 33]); o.y = pk2(s[2 * 33], s[3 * 33]); o.z = pk2(s[4 * 33], s[5 * 33]); o.w = pk2(s[6 * 33], s[7 * 33]);
        *(v4u*)(WT + (size_t)(row_off + n0 + n) * K + k0 + 8 * c) = o; }
    LDS_WAIT(); asm volatile("" ::: "memory");
}
__device__ __forceinline__ void p0_phase(Frame& F, const Args& A) {
    LAS float* scr = (LAS float*)(F.lds + F.wave * 16384);
    const int gw = F.vcu * NWAVES + F.wave, NGW = F.G * NWAVES, lane = F.lane;
    const float* c = A.in[1]; const float* w_ada = A.in[2]; const float* w_in = A.in[5];
    const float* w_o_gdn = A.in[10]; const float* w_o_diff = A.in[18]; const float* w_out = A.in[19]; const float* w_router = A.in[21];
    const float* ws_gu = A.in[25]; const float* ws_dn = A.in[26];
    constexpr int I_MOD = 96 * 4, I_WIN = 16 * 176, I_WOA = 8 * 32, I_WOB = 8 * 32, I_WOUT = 16 * 32, I_SGU = 16 * 16, I_RT = 16 * 8, I_SD = 4 * 32;
    constexpr int NITEMS = I_MOD + I_WIN + I_WOA + I_WOB + I_WOUT + I_SGU + I_RT + I_SD;
    for (int it = gw; it < NITEMS; it += NGW) {
        int r = it;
        if (r < I_MOD) {
            const int eb = r >> 2, dc = r & 3, e = eb * 64 + lane; float a0 = 0.f, a1 = 0.f;
#pragma unroll 8
            for (int d = dc * 256; d < dc * 256 + 256; ++d) { const float w = w_ada[(size_t)d * 6144 + e]; a0 += siluf(c[d]) * w; a1 += siluf(c[D + d]) * w; }
            float* modp = (float*)(F.ws + WS_MODP) + dc * 12288; modp[e] = a0; modp[6144 + e] = a1; continue; }
        r -= I_MOD;
        if (r < I_WIN) { transpose_item(w_in, INC, 1024, (bf16_t*)(F.ws + WS_WIN), 0, 176, scr, r, lane, [](int n) { return n < 2048 ? n : n + 8; }); continue; } r -= I_WIN;
        if (r < I_WOA) { transpose_item(w_o_gdn, 1024, 512, (bf16_t*)(F.ws + WS_WOA), 0, 32, scr, r, lane, [](int n) { return n; }); continue; } r -= I_WOA;
        if (r < I_WOB) { transpose_item(w_o_diff, 1024, 512, (bf16_t*)(F.ws + WS_WOB), 0, 32, scr, r, lane, [](int n) { return n; }); continue; } r -= I_WOB;
        if (r < I_WOUT) { transpose_item(w_out, 1024, 1024, (bf16_t*)(F.ws + WS_WOUT), 0, 32, scr, r, lane, [](int n) { return n; }); continue; } r -= I_WOUT;
        if (r < I_SGU) { transpose_item(ws_gu, 512, 1024, (bf16_t*)(F.ws + WS_W9), 0, 16, scr, r, lane, [](int n) { const int i8 = n >> 3, j = n & 7; return j < 4 ? 4 * i8 + j : 256 + 4 * i8 + (j - 4); }); continue; } r -= I_SGU;
        if (r < I_RT) { transpose_item(w_router, 256, 1024, (bf16_t*)(F.ws + WS_W9), 512, 8, scr, r, lane, [](int n) { return n; }); continue; } r -= I_RT;
        transpose_item(ws_dn, 1024, 256, (bf16_t*)(F.ws + WS_WSD), 0, 32, scr, r, lane, [](int n) { return n; });
    }
    if (gw == 0) {
        const float s1 = wave_sum(A.in[13][lane] * A.in[14][lane]), s2 = wave_sum(A.in[15][lane] * A.in[16][lane]);
        float qm = fabsf(A.in[11][lane]), km = fabsf(A.in[12][lane]);
#pragma unroll
        for (int o = 1; o < 64; o <<= 1) { qm = fmaxf(qm, __shfl_xor(qm, o)); km = fmaxf(km, __shfl_xor(km, o)); }
        if (lane == 0) { float* sc = (float*)(F.ws + WS_SCAL); sc[0] = expf(s1) - expf(s2) + LAM_INIT; sc[1] = 8.f * qm * km * 1.4426950408889634f; }
    }
}
__device__ __forceinline__ float mod_reduce(const float* modp, const float* b_ada, int idx) {
    return ((modp[idx] + modp[12288 + idx]) + (modp[2 * 12288 + idx] + modp[3 * 12288 + idx])) + b_ada[idx % 6144];
}
template <bool FROM_PARTIALS, bool WITH_BD>
__device__ __forceinline__ void norm_mod_phase(Frame& F, const Args& A, const float* src, const float* gain, int sh_off, int sc_off, bf16_t* dst) {
    LAS float* shs = (LAS float*)F.lds;
    LAS float* scs = shs + 2048;
    LAS float* wbd = scs + 2048;
    const float* modp = (const float*)(F.ws + WS_MODP); const float* b_ada = A.in[3]; float* mod = (float*)(F.ws + WS_MOD);
    for (int i = F.tid; i < 4096; i += NWAVES * 64) { const int b = i >> 11, r = i & 2047; const int idx = b * 6144 + (r < 1024 ? sh_off + r : sc_off + r - 1024);
        const float v = FROM_PARTIALS ? mod_reduce(modp, b_ada, idx) : mod[idx];
        if (r < 1024) shs[b * 1024 + r] = v; else scs[b * 1024 + r - 1024] = v; }
    if (WITH_BD) { const float* w_in = A.in[5]; for (int i = F.tid; i < 8192; i += NWAVES * 64) wbd[i] = w_in[(size_t)(i >> 3) * INC + 2048 + (i & 7)]; }
    if (FROM_PARTIALS) for (int idx = blockIdx.x * (NWAVES * 64) + F.tid; idx < 12288; idx += F.G * NWAVES * 64) mod[idx] = mod_reduce(modp, b_ada, idx);
    __syncthreads();
    const int gw = F.vcu * NWAVES + F.wave, NGW = F.G * NWAVES, lane = F.lane;
    for (int row = gw; row < T; row += NGW) {
        const int b = row / S; const float* xr = src + (size_t)row * D;
        f32x4 v[4]; float ss = 0.f;
#pragma unroll
        for (int j = 0; j < 4; ++j) { v[j] = *(const f32x4*)(xr + j * 256 + lane * 4); ss += (v[j][0] * v[j][0] + v[j][1] * v[j][1]) + (v[j][2] * v[j][2] + v[j][3] * v[j][3]); }
        const float rs = rsqrtf(wave_sum(ss) * (1.f / D) + EPS);
        float bacc[8];
#pragma unroll
        for (int q = 0; q < 8; ++q) bacc[q] = 0.f;
#pragma unroll
        for (int j = 0; j < 4; ++j) { const int col = j * 256 + lane * 4; const f32x4 gn = *(const f32x4*)(gain + col);
            const f32x4 sh = *(const LAS f32x4*)(shs + b * 1024 + col), sc = *(const LAS f32x4*)(scs + b * 1024 + col);
            f32x4 hv = (v[j] * rs * gn) * (sc + 1.f) + sh;
            uint2 w; w.x = pk2(hv[0], hv[1]); w.y = pk2(hv[2], hv[3]);
            *(uint2*)(dst + (size_t)row * D + col) = w;
            if (WITH_BD) {
#pragma unroll
                for (int i = 0; i < 4; ++i) { const f32x4 w0 = *(const LAS f32x4*)(wbd + (col + i) * 8), w1 = *(const LAS f32x4*)(wbd + (col + i) * 8 + 4);
                    bacc[0] += hv[i] * w0[0]; bacc[1] += hv[i] * w0[1]; bacc[2] += hv[i] * w0[2]; bacc[3] += hv[i] * w0[3];
                    bacc[4] += hv[i] * w1[0]; bacc[5] += hv[i] * w1[1]; bacc[6] += hv[i] * w1[2]; bacc[7] += hv[i] * w1[3]; } } }
        if (WITH_BD) {
#pragma unroll
            for (int q = 0; q < 8; ++q) bacc[q] = wave_sum(bacc[q]);
            if (lane == 0) { float* bd = (float*)(F.ws + WS_BD) + (size_t)row * 8; *(f32x4*)bd = (f32x4){bacc[0], bacc[1], bacc[2], bacc[3]}; *(f32x4*)(bd + 4) = (f32x4){bacc[4], bacc[5], bacc[6], bacc[7]}; } }
    }
}
__device__ __forceinline__ void route_phase(Frame& F, const Args& A) {
    const float* logits = (const float*)(F.ws + WS_LOGITS); const float* rbias = A.in[22];
    int* top_idx = (int*)(F.ws + WS_TOPI); float* top_w = (float*)(F.ws + WS_TOPW);
    unsigned* ecnt = (unsigned*)(F.ws + WS_CTL) + CW_ECNT; int* lists = (int*)(F.ws + WS_LIST);
    const int gw = F.vcu * NWAVES + F.wave, NGW = F.G * NWAVES, lane = F.lane;
    const f32x4 rb = *(const f32x4*)(rbias + lane * 4);
    for (int t = gw; t < T; t += NGW) {
        float sc[4], ch[4];
        const f32x4 lg = *(const f32x4*)(logits + (size_t)t * 256 + lane * 4);
#pragma unroll
        for (int i = 0; i < 4; ++i) { sc[i] = 1.f / (1.f + __expf(-lg[i])); ch[i] = sc[i] + rb[i]; }
        float a1 = fmaxf(ch[0], ch[1]), a2 = fminf(ch[0], ch[1]);
        { const float b1 = fmaxf(ch[2], ch[3]), b2 = fminf(ch[2], ch[3]); const float m1 = fmaxf(a1, b1), m2 = fmaxf(fminf(a1, b1), fmaxf(a2, b2)); a1 = m1; a2 = m2; }
#pragma unroll
        for (int o = 1; o < 8; o <<= 1) { const float b1 = __shfl_xor(a1, o), b2 = __shfl_xor(a2, o); const float m1 = fmaxf(a1, b1), m2 = fmaxf(fminf(a1, b1), fmaxf(a2, b2)); a1 = m1; a2 = m2; }
        const float gs = a1 + a2; const int g = lane >> 3;
        int rank = 0;
#pragma unroll
        for (int gg = 0; gg < 8; ++gg) { const float o = __shfl(gs, gg * 8); rank += (o > gs || (o == gs && gg < g)) ? 1 : 0; }
        const bool sel = rank < 4;
        float mc[4];
#pragma unroll
        for (int i = 0; i < 4; ++i) mc[i] = sel ? ch[i] : -INFINITY;
        int my_idx = 0; float my_sc = 0.f, sum = 0.f;
#pragma unroll
        for (int r = 0; r < 8; ++r) {
            float bv = mc[0]; int bi = 0;
#pragma unroll
            for (int i = 1; i < 4; ++i) if (mc[i] > bv) { bv = mc[i]; bi = i; }
            int be = lane * 4 + bi;
#pragma unroll
            for (int o = 1; o < 64; o <<= 1) { const float ov = __shfl_xor(bv, o); const int oe = __shfl_xor(be, o); if (ov > bv || (ov == bv && oe < be)) { bv = ov; be = oe; } }
            float s = 0.f;
            if ((be >> 2) == lane) { const int b2 = be & 3;
                s = b2 == 0 ? sc[0] : b2 == 1 ? sc[1] : b2 == 2 ? sc[2] : sc[3];
                if (b2 == 0) mc[0] = -INFINITY; else if (b2 == 1) mc[1] = -INFINITY; else if (b2 == 2) mc[2] = -INFINITY; else mc[3] = -INFINITY; }
            s = __shfl(s, be >> 2);
            sum += s;
            if (lane == r) { my_idx = be; my_sc = s; }
        }
        if (lane < 8) { top_idx[t * 8 + lane] = my_idx; top_w[t * 8 + lane] = my_sc / sum * 2.5f;
            const unsigned slot = __hip_atomic_fetch_add(ecnt + my_idx, 1u, __ATOMIC_RELAXED, __HIP_MEMORY_SCOPE_AGENT);
            lists[(size_t)my_idx * T + slot] = t * 8 + lane; }
    }
}

typedef float f32x16 __attribute__((ext_vector_type(16)));
typedef unsigned u32x2 __attribute__((ext_vector_type(2)));
constexpr int XT = 128;
constexpr int XA_OFF = 0, XA_STAGE = 8192;
constexpr int XWP_OFF = 16384, XWP_WAVE = 4096;
constexpr int XACT_OFF = 49152;
constexpr int XYS_OFF = 114688, XYS_WAVE = 4608, XYS_STRIDE = 144;
constexpr int XCNT_OFF = XYS_OFF + 8 * XYS_WAVE;
static_assert(XCNT_OFF + 1024 <= CTRL_OFF, "MoE LDS map");
constexpr int CW_MQ = 1024;

struct WRegs { f32x4 v[8]; };
template <bool GATEUP> __device__ __forceinline__ void xw_load(WRegs& R, const float* W, int ldw, int col0, int k0, int lane) {
    const int kgrp = lane >> 4;
    const int c = GATEUP ? (((lane >> 3) & 1) * 256 + col0 + (lane & 7) * 4) : (col0 + (lane & 15) * 4);
    const float* p = W + (size_t)(k0 + 8 * kgrp) * ldw + c;
#pragma unroll
    for (int i = 0; i < 8; ++i) R.v[i] = *(const f32x4*)(p + (size_t)i * ldw);
}
template <bool GATEUP> __device__ __forceinline__ void xw_store(const WRegs& R, LAS unsigned char* wp, int lane) {
    const int kgrp = lane >> 4;
    const int c = GATEUP ? (((lane >> 3) & 1) * 32 + (lane & 7) * 4) : ((lane & 15) * 4);
    LAS unsigned char* d = wp + (kgrp * 64 + c) * 16;
#pragma unroll
    for (int i = 0; i < 4; ++i) { v4u o; o.x = pk2(R.v[0][i], R.v[1][i]); o.y = pk2(R.v[2][i], R.v[3][i]); o.z = pk2(R.v[4][i], R.v[5][i]); o.w = pk2(R.v[6][i], R.v[7][i]);
        *(LAS v4u*)(d + i * 16) = o; }
}

__device__ __forceinline__ void moe_item(Frame& F, const Args& A, int e, int rt, int total) {
    const int lane = F.lane, wave = F.wave, r31 = lane & 31, hi = lane >> 5;
    LAS unsigned char* lds = F.lds;
    const int* list = (const int*)(F.ws + WS_LIST) + (size_t)e * T;
    const float* top_w = (const float*)(F.ws + WS_TOPW);
    const unsigned char* hsrc = F.ws + WS_H; bf16_t* Y = (bf16_t*)(F.ws + WS_Y);
    const float* W1 = A.in[23] + (size_t)e * 1024 * 512; const float* W2 = A.in[24] + (size_t)e * 256 * 1024;
    const int r0 = rt * XT;
    LAS unsigned char* wp = lds + XWP_OFF + wave * XWP_WAVE;
    unsigned grow;
    { const int rl = wave * 16 + (lane >> 2); int r = r0 + rl; r = r < total ? r : r0;
      grow = (unsigned)(list[r] >> 3) * 2048u + (unsigned)(((lane & 3) ^ ((rl >> 2) & 3)) * 16); }
    auto issue_a = [&](int k0, int stage) {
        const unsigned char* sp = hsrc + k0 * 2; asm volatile("" : "+s"(sp));
        __builtin_amdgcn_global_load_lds((const unsigned*)(sp + grow), (LAS unsigned*)(lds + XA_OFF + stage * XA_STAGE + wave * 1024), 16, 0, 0);
    };
    const int rd_t0 = r31 * 64 + ((hi ^ ((r31 >> 2) & 3)) * 16), rd_t1 = r31 * 64 + (((2 + hi) ^ ((r31 >> 2) & 3)) * 16);
    const int rd_w = (hi * 64 + r31) * 16;
    f32x16 acc[2][4];
    WRegs R;
#pragma unroll
    for (int nt = 0; nt < 2; ++nt)
#pragma unroll
        for (int tt = 0; tt < 4; ++tt)
#pragma unroll
            for (int q = 0; q < 16; ++q) acc[nt][tt][q] = 0.f;
    asm volatile("s_waitcnt vmcnt(0) lgkmcnt(0)" ::: "memory"); __builtin_amdgcn_s_barrier();
    issue_a(0, 0); xw_load<true>(R, W1, 512, 32 * wave, 0, lane);
    xw_store<true>(R, wp, lane);
    asm volatile("s_waitcnt vmcnt(0) lgkmcnt(0)" ::: "memory"); __builtin_amdgcn_s_barrier();
    for (int s = 0; s < 32; ++s) {
        if (s + 1 < 32) { issue_a((s + 1) * 32, (s + 1) & 1); xw_load<true>(R, W1, 512, 32 * wave, (s + 1) * 32, lane); }
        const LAS unsigned char* ab = lds + XA_OFF + (s & 1) * XA_STAGE;
#pragma unroll
        for (int ks = 0; ks < 2; ++ks) {
            bf16x8 tf[4], wf[2];
#pragma unroll
            for (int tt = 0; tt < 4; ++tt) tf[tt] = *(const LAS bf16x8*)(ab + (ks ? rd_t1 : rd_t0) + tt * 2048);
#pragma unroll
            for (int nt = 0; nt < 2; ++nt) wf[nt] = *(const LAS bf16x8*)(wp + rd_w + ks * 2048 + nt * 512);
#pragma unroll
            for (int nt = 0; nt < 2; ++nt)
#pragma unroll
                for (int tt = 0; tt < 4; ++tt) acc[nt][tt] = __builtin_amdgcn_mfma_f32_32x32x16_bf16(wf[nt], tf[tt], acc[nt][tt], 0, 0, 0);
        }
        if (s + 1 < 32) { asm volatile("s_waitcnt lgkmcnt(0)" ::: "memory"); xw_store<true>(R, wp, lane); }
        asm volatile("s_waitcnt vmcnt(0) lgkmcnt(0)" ::: "memory"); __builtin_amdgcn_s_barrier();
    }
#pragma unroll
    for (int tt = 0; tt < 4; ++tt) { const int r = r0 + 32 * tt + r31; const float rw = r < total ? top_w[list[r]] : 0.f;
#pragma unroll
        for (int g = 0; g < 4; ++g) { float a[4];
#pragma unroll
            for (int q = 0; q < 4; ++q) { const float gt = acc[0][tt][4 * g + q], up = acc[1][tt][4 * g + q]; a[q] = gt / (1.f + __expf(-gt)) * up * rw; }
            u32x2 w; w.x = pk2(a[0], a[1]); w.y = pk2(a[2], a[3]);
            *(LAS u32x2*)(lds + XACT_OFF + ((4 * wave + g) * 128 + 32 * tt + r31) * 16 + 8 * hi) = w; } }
#pragma unroll 1
    for (int h = 0; h < 2; ++h) {
        const int col0 = 512 * h + 64 * wave;
#pragma unroll
        for (int nt = 0; nt < 2; ++nt)
#pragma unroll
            for (int tt = 0; tt < 4; ++tt)
#pragma unroll
                for (int q = 0; q < 16; ++q) acc[nt][tt][q] = 0.f;
        xw_load<false>(R, W2, 1024, col0, 0, lane);
        asm volatile("s_waitcnt lgkmcnt(0)" ::: "memory");
        if (h == 0) __builtin_amdgcn_s_barrier();
        xw_store<false>(R, wp, lane);
        for (int s = 0; s < 8; ++s) {
            if (s + 1 < 8) xw_load<false>(R, W2, 1024, col0, (s + 1) * 32, lane);
            asm volatile("s_waitcnt lgkmcnt(0)" ::: "memory");
#pragma unroll
            for (int ks = 0; ks < 2; ++ks) {
                bf16x8 tf[4], wf[2];
#pragma unroll
                for (int tt = 0; tt < 4; ++tt) tf[tt] = *(const LAS bf16x8*)(lds + XACT_OFF + ((4 * s + 2 * ks + hi) * 128 + 32 * tt + r31) * 16);
#pragma unroll
                for (int nt = 0; nt < 2; ++nt) wf[nt] = *(const LAS bf16x8*)(wp + rd_w + ks * 2048 + nt * 512);
#pragma unroll
                for (int nt = 0; nt < 2; ++nt)
#pragma unroll
                    for (int tt = 0; tt < 4; ++tt) acc[nt][tt] = __builtin_amdgcn_mfma_f32_32x32x16_bf16(wf[nt], tf[tt], acc[nt][tt], 0, 0, 0);
            }
            if (s + 1 < 8) { asm volatile("s_waitcnt lgkmcnt(0)" ::: "memory"); xw_store<false>(R, wp, lane); }
        }
        LAS unsigned char* ys = lds + XYS_OFF + wave * XYS_WAVE;
#pragma unroll
        for (int tt = 0; tt < 4; ++tt) {
#pragma unroll
            for (int nt = 0; nt < 2; ++nt)
#pragma unroll
                for (int g = 0; g < 4; ++g) { u32x2 w; w.x = pk2(acc[nt][tt][4 * g], acc[nt][tt][4 * g + 1]); w.y = pk2(acc[nt][tt][4 * g + 2], acc[nt][tt][4 * g + 3]);
                    *(LAS u32x2*)(ys + r31 * XYS_STRIDE + (32 * nt + 8 * g + 4 * hi) * 2) = w; }
            asm volatile("s_waitcnt lgkmcnt(0)" ::: "memory");
#pragma unroll
            for (int p = 0; p < 4; ++p) { const int rl = 8 * p + (lane >> 3); const int r = r0 + 32 * tt + rl;
                const v4u v = *(const LAS v4u*)(ys + rl * XYS_STRIDE + (lane & 7) * 16);
                if (r < total) *(v4u*)(Y + (size_t)list[r] * 1024 + col0 + (lane & 7) * 8) = v; }
            asm volatile("s_waitcnt lgkmcnt(0)" ::: "memory");
        }
    }
}

__device__ __forceinline__ void moe_phase(Frame& F, const Args& A) {
    LAS int* cnts = (LAS int*)(F.lds + XCNT_OFF);
    const unsigned* ecnt = (const unsigned*)(F.ws + WS_CTL) + CW_ECNT;
    unsigned* mq = (unsigned*)(F.ws + WS_CTL) + CW_MQ;
    volatile LAS int* slot = (volatile LAS int*)(F.lds + CTRL_OFF + 64);
    if (F.tid < 256) cnts[F.tid] = (int)ecnt[F.tid];
    __syncthreads();
    const int x0 = (int)(blockIdx.x & 7);
    for (int xi = 0; xi < 8; ++xi) {
        const int x = (x0 + xi) & 7;
        int ntiles = 0;
        for (int i = 0; i < 32; ++i) ntiles += (cnts[x + 8 * i] + XT - 1) / XT;
        for (;;) {
            __syncthreads();
            if (F.tid == 0) slot[0] = (int)__hip_atomic_fetch_add(mq + 64 * x, 1u, __ATOMIC_RELAXED, __HIP_MEMORY_SCOPE_AGENT);
            __syncthreads();
            int k = slot[0];
            if (k >= ntiles) break;
            int e = x, tot = 0;
            for (int i = 0; i < 32; ++i) { const int c = cnts[x + 8 * i], t = (c + XT - 1) / XT; if (k < t) { e = x + 8 * i; tot = c; break; } k -= t; }
            moe_item(F, A, e, k, tot);
        }
    }
}
__device__ __forceinline__ void attn_prep_phase(Frame& F, const Args& A) {
    const bf16_t* P = (const bf16_t*)(F.ws + WS_P); bf16_t* QN = (bf16_t*)(F.ws + WS_QN); bf16_t* KN = (bf16_t*)(F.ws + WS_KN);
    const float* qg = A.in[11]; const float* kg = A.in[12];
    const int gw = F.vcu * NWAVES + F.wave, NGW = F.G * NWAVES, lane = F.lane;
    f32x4 gq0 = *(const f32x4*)(qg + (lane & 7) * 8), gq1 = *(const f32x4*)(qg + (lane & 7) * 8 + 4);
    f32x4 gk0 = *(const f32x4*)(kg + (lane & 7) * 8), gk1 = *(const f32x4*)(kg + (lane & 7) * 8 + 4);
    for (int t = gw; t < T; t += NGW) {
#pragma unroll
        for (int which = 0; which < 2; ++which) {
            const v4u w = *(const v4u*)(P + (size_t)t * LDP + (which ? C_KB : C_QB) + lane * 8);
            float v[8] = {pg8::bflo(w.x), pg8::bfhi(w.x), pg8::bflo(w.y), pg8::bfhi(w.y), pg8::bflo(w.z), pg8::bfhi(w.z), pg8::bflo(w.w), pg8::bfhi(w.w)};
            float ss = 0.f;
#pragma unroll
            for (int i = 0; i < 8; ++i) ss += v[i] * v[i];
            ss += __shfl_xor(ss, 1); ss += __shfl_xor(ss, 2); ss += __shfl_xor(ss, 4);
            const float r = rsqrtf(ss * (1.f / 64.f) + EPS) * (which ? 1.f : 0.125f * 1.4426950408889634f);
            const f32x4 g0 = which ? gk0 : gq0, g1 = which ? gk1 : gq1;
            v4u o; o.x = pk2(v[0] * r * g0[0], v[1] * r * g0[1]); o.y = pk2(v[2] * r * g0[2], v[3] * r * g0[3]); o.z = pk2(v[4] * r * g1[0], v[5] * r * g1[1]); o.w = pk2(v[6] * r * g1[2], v[7] * r * g1[3]);
            *(v4u*)((which ? KN : QN) + (size_t)t * 512 + lane * 8) = o;
        }
    }
}

typedef short s16x4 __attribute__((ext_vector_type(4)));
constexpr int AT_KPLANE = 1040;
constexpr int AT_KBYTES = 8 * AT_KPLANE;
constexpr int AT_VROW = 320;
constexpr int AT_VBYTES = 64 * AT_VROW;
constexpr int AT_BUF = AT_KBYTES + AT_VBYTES;
template <int OFF> __device__ __forceinline__ s16x4 tr_read(int vb) {
    s16x4 r; asm volatile("ds_read_b64_tr_b16 %0, %1 offset:%2" : "=&v"(r) : "v"(vb), "i"(OFF) : "memory"); return r;
}
template <int ND> __device__ __forceinline__ void pv_one(f32x16& od, int vb, const bf16x8 (&pf)[4]) {
#define VOFF(mt, s, half) (AT_KBYTES + (32 * (mt) + 16 * (s) + 8 * (half)) * AT_VROW + ND * 64)
    const s16x4 a0 = tr_read<VOFF(0, 0, 0)>(vb), b0 = tr_read<VOFF(0, 0, 1)>(vb), a1 = tr_read<VOFF(0, 1, 0)>(vb), b1 = tr_read<VOFF(0, 1, 1)>(vb);
    const s16x4 a2 = tr_read<VOFF(1, 0, 0)>(vb), b2 = tr_read<VOFF(1, 0, 1)>(vb), a3 = tr_read<VOFF(1, 1, 0)>(vb), b3 = tr_read<VOFF(1, 1, 1)>(vb);
#undef VOFF
    asm volatile("s_waitcnt lgkmcnt(0)" ::: "memory"); __builtin_amdgcn_sched_barrier(0);
#define PK(L, H) (bf16x8){L[0], L[1], L[2], L[3], H[0], H[1], H[2], H[3]}
    od = __builtin_amdgcn_mfma_f32_32x32x16_bf16(PK(a0, b0), pf[0], od, 0, 0, 0);
    od = __builtin_amdgcn_mfma_f32_32x32x16_bf16(PK(a1, b1), pf[1], od, 0, 0, 0);
    od = __builtin_amdgcn_mfma_f32_32x32x16_bf16(PK(a2, b2), pf[2], od, 0, 0, 0);
    od = __builtin_amdgcn_mfma_f32_32x32x16_bf16(PK(a3, b3), pf[3], od, 0, 0, 0);
#undef PK
}
__device__ __forceinline__ void attn_unit(Frame& F, int b, int h, int c, int qb) {
    const int tid = F.tid, lane = F.lane, wave = F.wave, r32 = lane & 31, hi = lane >> 5;
    LAS unsigned char* lds = F.lds;
    const bf16_t* QN = (const bf16_t*)(F.ws + WS_QN); const bf16_t* KN = (const bf16_t*)(F.ws + WS_KN); const bf16_t* P = (const bf16_t*)(F.ws + WS_P);
    const float sl2 = exp2f(-2.f * (float)(h + 1)) * 1.4426950408889634f;
    const float M2 = ((const float*)(F.ws + WS_SCAL))[1];
    const int tq = qb * 256 + wave * 32 + r32;
    const int ctw = 4 * qb + (wave >> 1), ntiles = 4 * qb + 4;
    bf16x8 qf[4];
    { const bf16_t* qp = QN + (size_t)(b * S + tq) * 512 + h * 128 + c * 64 + hi * 8;
#pragma unroll
      for (int ks = 0; ks < 4; ++ks) qf[ks] = *(const bf16x8*)(qp + 16 * ks); }
    float koffs[16];
#pragma unroll
    for (int r = 0; r < 16; ++r) koffs[r] = sl2 * (float)((r & 3) + 8 * (r >> 2) + 4 * hi);
    f32x16 oacc[4];
#pragma unroll
    for (int nd = 0; nd < 4; ++nd)
#pragma unroll
        for (int r = 0; r < 16; ++r) oacc[nd][r] = 0.f;
    float lsum = 0.f;
    const int s_key = tid >> 3, s_kg = tid & 7;
    const bf16_t* kg_src = KN + (size_t)(b * S + s_key) * 512 + h * 128 + c * 64 + s_kg * 8;
    const bf16_t* vg_src = P + (size_t)(b * S + s_key) * LDP + C_VB + h * 128 + s_kg * 8;
    const int st_k = s_kg * AT_KPLANE + s_key * 16, st_v = AT_KBYTES + s_key * AT_VROW + s_kg * 16;
    const int rd_k = hi * AT_KPLANE + r32 * 16;
    const int rd_v = (hi * 4 + ((lane & 15) >> 2)) * AT_VROW + ((lane >> 4) & 1) * 32 + (lane & 3) * 8;
    v4u rk, rv0, rv1;
    auto gload = [&](int tile) { rk = *(const v4u*)(kg_src + (size_t)tile * 64 * 512); const bf16_t* vp = vg_src + (size_t)tile * 64 * LDP; rv0 = *(const v4u*)vp; rv1 = *(const v4u*)(vp + 64); };
    auto lstore = [&](int buf) { LAS unsigned char* bb = lds + buf * AT_BUF; *(LAS v4u*)(bb + st_k) = rk; *(LAS v4u*)(bb + st_v) = rv0; *(LAS v4u*)(bb + st_v + 128) = rv1; };
    __syncthreads();
    gload(0); lstore(0); __syncthreads();
    for (int tile = 0; tile < ntiles; ++tile) {
        if (tile + 1 < ntiles) gload(tile + 1);
        if (tile <= ctw) {
            const LAS unsigned char* kb = lds + (tile & 1) * AT_BUF;
            f32x16 sacc[2];
            if (tile != ctw) {
                const float ct = sl2 * (float)(64 * tile - tq) - M2;
#pragma unroll
                for (int mt = 0; mt < 2; ++mt)
#pragma unroll
                    for (int r = 0; r < 16; ++r) sacc[mt][r] = koffs[r] + (ct + sl2 * 32.f * mt);
            } else {
                const float base = sl2 * (float)(64 * tile - tq);
#pragma unroll
                for (int mt = 0; mt < 2; ++mt)
#pragma unroll
                    for (int r = 0; r < 16; ++r) sacc[mt][r] = -fabsf(koffs[r] + (base + sl2 * 32.f * mt)) - M2;
            }
#pragma unroll
            for (int ks = 0; ks < 4; ++ks)
#pragma unroll
                for (int mt = 0; mt < 2; ++mt) { const bf16x8 kf = *(const LAS bf16x8*)(kb + rd_k + ks * 2 * AT_KPLANE + mt * 512);
                    sacc[mt] = __builtin_amdgcn_mfma_f32_32x32x16_bf16(kf, qf[ks], sacc[mt], 0, 0, 0); }
            bf16x8 pf[4];
#pragma unroll
            for (int mt = 0; mt < 2; ++mt) {
#pragma unroll
                for (int r = 0; r < 16; ++r) { const float p = __builtin_amdgcn_exp2f(sacc[mt][r]); lsum += p; sacc[mt][r] = p; }
#pragma unroll
                for (int s = 0; s < 2; ++s) { v4u w;
                    w.x = pg8::cvt_pk_bf16(sacc[mt][8 * s + 0], sacc[mt][8 * s + 1]); w.y = pg8::cvt_pk_bf16(sacc[mt][8 * s + 2], sacc[mt][8 * s + 3]);
                    w.z = pg8::cvt_pk_bf16(sacc[mt][8 * s + 4], sacc[mt][8 * s + 5]); w.w = pg8::cvt_pk_bf16(sacc[mt][8 * s + 6], sacc[mt][8 * s + 7]);
                    pf[mt * 2 + s] = __builtin_bit_cast(bf16x8, w); }
            }
            const int vb = (int)(uintptr_t)kb + rd_v;
            pv_one<0>(oacc[0], vb, pf); pv_one<1>(oacc[1], vb, pf); pv_one<2>(oacc[2], vb, pf); pv_one<3>(oacc[3], vb, pf);
        }
        if (tile + 1 < ntiles) lstore((tile + 1) & 1);
        __syncthreads();
    }
    lsum += __shfl_xor(lsum, 32);
    const float inv = 1.f / lsum;
    bf16_t* ob = (bf16_t*)(F.ws + WS_OB) + (size_t)c * T * 512 + (size_t)(b * S + tq) * 512 + h * 128 + 4 * hi;
#pragma unroll
    for (int nd = 0; nd < 4; ++nd)
#pragma unroll
        for (int g = 0; g < 4; ++g) { uint2 w; w.x = pk2(oacc[nd][4 * g] * inv, oacc[nd][4 * g + 1] * inv); w.y = pk2(oacc[nd][4 * g + 2] * inv, oacc[nd][4 * g + 3] * inv);
            *(uint2*)(ob + 32 * nd + 8 * g) = w; }
}
__device__ __forceinline__ void post_norm_phase(Frame& F, const Args& A) {
    const float* oa = (const float*)(F.ws + WS_OA); const bf16_t* ob = (const bf16_t*)(F.ws + WS_OB); const bf16_t* P = (const bf16_t*)(F.ws + WS_P);
    bf16_t* oan = (bf16_t*)(F.ws + WS_OAN); bf16_t* obn = (bf16_t*)(F.ws + WS_OBN);
    const float* gg = A.in[9]; const float* sg = A.in[17];
    const float lam = ((const float*)(F.ws + WS_SCAL))[0];
    const int gw = F.vcu * NWAVES + F.wave, NGW = F.G * NWAVES, lane = F.lane;
    const int gc = (lane & 15) * 8;
    const f32x4 g0 = *(const f32x4*)(gg + gc), g1 = *(const f32x4*)(gg + gc + 4), s0 = *(const f32x4*)(sg + gc), s1 = *(const f32x4*)(sg + gc + 4);
    for (int t = gw; t < T; t += NGW) {
        { const f32x4 a0 = *(const f32x4*)(oa + (size_t)t * 512 + lane * 8), a1 = *(const f32x4*)(oa + (size_t)t * 512 + lane * 8 + 4);
          float ss = (a0[0] * a0[0] + a0[1] * a0[1]) + (a0[2] * a0[2] + a0[3] * a0[3]) + (a1[0] * a1[0] + a1[1] * a1[1]) + (a1[2] * a1[2] + a1[3] * a1[3]);
          ss += __shfl_xor(ss, 1); ss += __shfl_xor(ss, 2); ss += __shfl_xor(ss, 4); ss += __shfl_xor(ss, 8);
          const float r = rsqrtf(ss * (1.f / 128.f) + EPS);
          const v4u zw = *(const v4u*)(P + (size_t)t * LDP + C_ZA + lane * 8);
          const float z[8] = {pg8::bflo(zw.x), pg8::bfhi(zw.x), pg8::bflo(zw.y), pg8::bfhi(zw.y), pg8::bflo(zw.z), pg8::bfhi(zw.z), pg8::bflo(zw.w), pg8::bfhi(zw.w)};
          float o[8];
#pragma unroll
          for (int i = 0; i < 4; ++i) { o[i] = a0[i] * r * g0[i] * siluf(z[i]); o[4 + i] = a1[i] * r * g1[i] * siluf(z[4 + i]); }
          v4u w; w.x = pk2(o[0], o[1]); w.y = pk2(o[2], o[3]); w.z = pk2(o[4], o[5]); w.w = pk2(o[6], o[7]);
          *(v4u*)(oan + (size_t)t * 512 + lane * 8) = w; }
        { const v4u w1 = *(const v4u*)(ob + (size_t)t * 512 + lane * 8), w2 = *(const v4u*)(ob + (size_t)T * 512 + (size_t)t * 512 + lane * 8);
          float d[8] = {pg8::bflo(w1.x) - lam * pg8::bflo(w2.x), pg8::bfhi(w1.x) - lam * pg8::bfhi(w2.x), pg8::bflo(w1.y) - lam * pg8::bflo(w2.y), pg8::bfhi(w1.y) - lam * pg8::bfhi(w2.y),
                        pg8::bflo(w1.z) - lam * pg8::bflo(w2.z), pg8::bfhi(w1.z) - lam * pg8::bfhi(w2.z), pg8::bflo(w1.w) - lam * pg8::bflo(w2.w), pg8::bfhi(w1.w) - lam * pg8::bfhi(w2.w)};
          float ss = 0.f;
#pragma unroll
          for (int i = 0; i < 8; ++i) ss += d[i] * d[i];
          ss += __shfl_xor(ss, 1); ss += __shfl_xor(ss, 2); ss += __shfl_xor(ss, 4); ss += __shfl_xor(ss, 8);
          const float r = rsqrtf(ss * (1.f / 128.f) + EPS) * (1.f - LAM_INIT);
          v4u w; w.x = pk2(d[0] * r * s0[0], d[1] * r * s0[1]); w.y = pk2(d[2] * r * s0[2], d[3] * r * s0[3]); w.z = pk2(d[4] * r * s1[0], d[5] * r * s1[1]); w.w = pk2(d[6] * r * s1[2], d[7] * r * s1[3]);
          *(v4u*)(obn + (size_t)t * 512 + lane * 8) = w; }
    }
}
constexpr int GD_KA = 0, GD_QA = 17408, GD_VN = 34816, GD_KB = 55296, GD_LM = 75776, GD_T1 = 93184, GD_T2 = 102400, GD_SC = 111616;
constexpr int GD_SA = 272, GD_SB = 320, GD_SL = 272, GD_ST = 144;
constexpr size_t GDN_WF = 0, GDN_QF = 16384, GDN_AF = 32768, GDN_KF = 40960, GDN_UF = 57344, GDN_EG = 90112, GDN_ITEM = 90368;
__device__ __forceinline__ int perm16_h(int n) { return (n >> 2) & 1; }
__device__ __forceinline__ int perm16_j(int n) { return (n & 3) + 4 * (n >> 3); }

__device__ __forceinline__ void gdn_prep_item(Frame& F, const Args& A, int item) {
    const int tid = F.tid, lane = F.lane, wave = F.wave, r32 = lane & 31, hi = lane >> 5;
    LAS unsigned char* lds = F.lds;
    const int b = item >> 9, h = (item >> 7) & 3, n = item & 127;
    const int t0 = b * S + n * 64;
    const bf16_t* P = (const bf16_t*)(F.ws + WS_P); const float* bd = (const float*)(F.ws + WS_BD);
    unsigned char* gi = F.ws + WS_GDN + (size_t)item * GDN_ITEM;
    LAS float* sc_g = (LAS float*)(lds + GD_SC);
    LAS float* sc_b = sc_g + 64;
    LAS float* sc_e = sc_g + 128;
    LAS float* sc_l = sc_g + 192;
#ifndef NO_S1
    if (tid < 128) *((LAS float*)(lds + GD_SC + 1024) + tid) = (tid == 63) ? 1.f : 0.f;
    {
        const float* cw = A.in[6];
        float w[3][4][2];
#pragma unroll
        for (int p = 0; p < 3; ++p)
#pragma unroll
            for (int j = 0; j < 4; ++j) { const float2 t = *(const float2*)(cw + j * 1536 + p * 512 + h * 128 + 2 * lane); w[p][j][0] = t.x; w[p][j][1] = t.y; }
        const int rl0 = n * 64 + wave * 8;
#pragma unroll
        for (int p = 0; p < 3; ++p) {
            float x[11][2];
#pragma unroll
            for (int i = 0; i < 11; ++i) { const int tl = rl0 - 3 + i; unsigned u = 0u;
                if (tl >= 0) u = *(const unsigned*)(P + (size_t)(b * S + tl) * LDP + p * 512 + h * 128 + 2 * lane);
                x[i][0] = pg8::bflo(u); x[i][1] = pg8::bfhi(u); }
#pragma unroll
            for (int r = 0; r < 8; ++r) {
                float a0 = 0.f, a1 = 0.f;
#pragma unroll
                for (int j = 0; j < 4; ++j) { a0 += x[r + j][0] * w[p][j][0]; a1 += x[r + j][1] * w[p][j][1]; }
                a0 = siluf(a0); a1 = siluf(a1);
                const int row = wave * 8 + r;
                if (p < 2) { const float ss = wave_sum(a0 * a0 + a1 * a1); const float rs = rsqrtf(ss + EPS) * (p == 0 ? 0.08838834764831845f : 1.f); a0 *= rs; a1 *= rs; }
                const unsigned pk = pk2(a0, a1);
                if (p == 0) *(LAS unsigned*)(lds + GD_QA + row * GD_SA + lane * 4) = pk;
                else if (p == 1) { *(LAS unsigned*)(lds + GD_KA + row * GD_SA + lane * 4) = pk; *(LAS unsigned*)(lds + GD_KB + row * GD_SB + lane * 4) = pk; }
                else *(LAS unsigned*)(lds + GD_VN + row * GD_SB + lane * 4) = pk;
            }
        }
        if (wave == 0) {
            const float bl = bd[(size_t)(t0 + lane) * 8 + h], dl = bd[(size_t)(t0 + lane) * 8 + 4 + h];
            const float beta = 1.f / (1.f + __expf(-bl));
            float g = -expf(A.in[7][h]) * softplusf(dl + A.in[8][h]);
#pragma unroll
            for (int o = 1; o < 64; o <<= 1) { const float up = __shfl_up(g, o); if (lane >= o) g += up; }
            const float glast = __shfl(g, 63);
            sc_g[lane] = g; sc_b[lane] = beta; sc_e[lane] = __expf(g); sc_l[lane] = __expf(glast - g);
            if (lane == 0) *(float*)(gi + GDN_EG) = __expf(glast);
        }
    }
#endif
    __syncthreads();
#ifndef NO_S2
    {
        const int which = wave >> 2, ti = (wave >> 1) & 1, tj = wave & 1;
        f32x16 acc;
#pragma unroll
        for (int r = 0; r < 16; ++r) acc[r] = 0.f;
        if (ti >= tj) {
            const LAS unsigned char* ap = lds + (which ? GD_QA : GD_KA) + (32 * ti + r32) * GD_SA + hi * 16;
            const LAS unsigned char* bp = lds + GD_KA + (32 * tj + r32) * GD_SA + hi * 16;
#pragma unroll
            for (int ks = 0; ks < 8; ++ks) acc = __builtin_amdgcn_mfma_f32_32x32x16_bf16(*(const LAS bf16x8*)(ap + ks * 32), *(const LAS bf16x8*)(bp + ks * 32), acc, 0, 0, 0);
        }
        const int j = 32 * tj + r32; const float Gj = sc_g[j];
        const int ibase = 32 * ti + 4 * hi, dij = ibase - j;
        const LAS float* gp = sc_g + ibase; const LAS float* bp2 = sc_b + ibase;
        if (which == 0) {
            LAS float* lm = (LAS float*)(lds + GD_LM + ibase * GD_SL + j * 4);
#pragma unroll
            for (int r = 0; r < 16; ++r) { const int off = (r & 3) + 8 * (r >> 2);
                const float v = (off + dij > 0) ? bp2[off] * acc[r] * __expf(fminf(gp[off] - Gj, 0.f)) : 0.f;
                lm[off * (GD_SL / 4)] = v; }
        } else {
            const int ks = j >> 4, nn = j & 15, hp = perm16_h(nn), jj = perm16_j(nn);
            bf16_t* af = (bf16_t*)(gi + GDN_AF) + ((ti * 4 + ks) * 64 + hp * 32 + 4 * hi) * 8 + jj;
#pragma unroll
            for (int r = 0; r < 16; ++r) { const int off = (r & 3) + 8 * (r >> 2);
                const float v = (off + dij >= 0) ? acc[r] * __expf(fminf(gp[off] - Gj, 0.f)) : 0.f;
                af[off * 8] = (bf16_t)f2bf(v); }
        }
    }
#endif
    __syncthreads();
#ifndef NO_S3
    if (wave == 0) {
        int ln = lane; asm volatile("" : "+v"(ln));
        LAS unsigned char* lmb = lds + GD_LM; asm volatile("" : "+v"(lmb));
        const LAS float* zz = (const LAS float*)(lds + GD_SC + 1024) + ln;
        float t[64];
#pragma unroll
        for (int i = 0; i < 64; ++i) {
            float s = zz[63 - i];
            const LAS float* Li = (const LAS float*)(lmb + i * GD_SL);
#pragma unroll
            for (int j4 = 0; j4 < (i + 3) / 4; ++j4) { const f32x4 l4 = *(const LAS f32x4*)(Li + 4 * j4);
#pragma unroll
                for (int q = 0; q < 4; ++q) if (4 * j4 + q < i) s -= l4[q] * t[4 * j4 + q]; }
            t[i] = s;
            __builtin_amdgcn_sched_barrier(0);
        }
        const float bc = sc_b[lane], bec = bc * sc_e[lane];
#pragma unroll
        for (int i = 0; i < 64; ++i) { *(LAS bf16_t*)(lds + GD_T1 + i * GD_ST + lane * 2) = (bf16_t)f2bf(t[i] * bc); *(LAS bf16_t*)(lds + GD_T2 + i * GD_ST + lane * 2) = (bf16_t)f2bf(t[i] * bec); }
    } else {
        for (int cidx = tid - 64; cidx < 2048; cidx += 448) {
            const bool isK = cidx >= 1024; const int cc = cidx & 1023; const int lp = cc & 63, hp = lp >> 5, rr = lp & 31;
            unsigned wds[4];
            if (!isK) { const int mt = cc >> 9, ks = (cc >> 6) & 7; const int i = 32 * mt + rr; const float e = sc_e[i];
#pragma unroll
                for (int q = 0; q < 4; ++q) { const int j0 = 2 * q, j1 = 2 * q + 1;
                    const int d0 = 16 * ks + 8 * (j0 >> 2) + 4 * hp + (j0 & 3), d1 = 16 * ks + 8 * (j1 >> 2) + 4 * hp + (j1 & 3);
                    wds[q] = pk2(bf2f(*(const LAS bf16_t*)(lds + GD_QA + i * GD_SA + d0 * 2)) * e, bf2f(*(const LAS bf16_t*)(lds + GD_QA + i * GD_SA + d1 * 2)) * e); }
                *(v4u*)(gi + GDN_QF + (size_t)cc * 16) = (v4u){wds[0], wds[1], wds[2], wds[3]};
            } else { const int dt = cc >> 8, ks = (cc >> 6) & 3; const int dk = 32 * dt + rr;
#pragma unroll
                for (int q = 0; q < 4; ++q) { const int j0 = 2 * q, j1 = 2 * q + 1;
                    const int k0 = 16 * ks + 8 * (j0 >> 2) + 4 * hp + (j0 & 3), k1 = 16 * ks + 8 * (j1 >> 2) + 4 * hp + (j1 & 3);
                    wds[q] = pk2(bf2f(*(const LAS bf16_t*)(lds + GD_KA + k0 * GD_SA + dk * 2)) * sc_l[k0], bf2f(*(const LAS bf16_t*)(lds + GD_KA + k1 * GD_SA + dk * 2)) * sc_l[k1]); }
                *(v4u*)(gi + GDN_KF + (size_t)cc * 16) = (v4u){wds[0], wds[1], wds[2], wds[3]};
            }
        }
    }
#endif
    __syncthreads();
#ifndef NO_S4
    {
        const int mt = wave >> 2, nt = wave & 3;
        const int trb = (hi * 8 + ((lane & 15) >> 2)) * GD_SB + (32 * nt + ((lane >> 4) & 1) * 16 + (lane & 3) * 4) * 2;
#pragma unroll
        for (int which = 0; which < 2; ++which) {
            f32x16 acc;
#pragma unroll
            for (int r = 0; r < 16; ++r) acc[r] = 0.f;
            const LAS unsigned char* tp = lds + (which ? GD_T2 : GD_T1) + (32 * mt + r32) * GD_ST + hi * 16;
            const int vb = (int)(uintptr_t)(lds + (which ? GD_KB : GD_VN)) + trb;
            s16x4 lo[4], hh[4];
            lo[0] = tr_read<0 * 16 * GD_SB>(vb); hh[0] = tr_read<0 * 16 * GD_SB + 4 * GD_SB>(vb); lo[1] = tr_read<1 * 16 * GD_SB>(vb); hh[1] = tr_read<1 * 16 * GD_SB + 4 * GD_SB>(vb);
            lo[2] = tr_read<2 * 16 * GD_SB>(vb); hh[2] = tr_read<2 * 16 * GD_SB + 4 * GD_SB>(vb); lo[3] = tr_read<3 * 16 * GD_SB>(vb); hh[3] = tr_read<3 * 16 * GD_SB + 4 * GD_SB>(vb);
            asm volatile("s_waitcnt lgkmcnt(0)" ::: "memory"); __builtin_amdgcn_sched_barrier(0);
#pragma unroll
            for (int ks = 0; ks < 4; ++ks) { const bf16x8 bfr = (bf16x8){lo[ks][0], lo[ks][1], lo[ks][2], lo[ks][3], hh[ks][0], hh[ks][1], hh[ks][2], hh[ks][3]};
                acc = __builtin_amdgcn_mfma_f32_32x32x16_bf16(*(const LAS bf16x8*)(tp + ks * 32), bfr, acc, 0, 0, 0); }
            if (which == 0) {
                float* uf = (float*)(gi + GDN_UF) + (size_t)nt * 2048 + (32 * mt + 4 * hi) * 32 + r32;
#pragma unroll
                for (int r = 0; r < 16; ++r) uf[((r & 3) + 8 * (r >> 2)) * 32] = acc[r];
            } else {
                const int dk = 32 * nt + r32, ks = dk >> 4, nn = dk & 15, hp = perm16_h(nn), jj = perm16_j(nn);
                bf16_t* wf = (bf16_t*)(gi + GDN_WF) + ((mt * 8 + ks) * 64 + hp * 32 + 4 * hi) * 8 + jj;
#pragma unroll
                for (int r = 0; r < 16; ++r) wf[((r & 3) + 8 * (r >> 2)) * 8] = (bf16_t)f2bf(acc[r]);
            }
        }
    }
#endif
    __syncthreads();
}
__device__ __forceinline__ void gdn_prep_phase(Frame& F, const Args& A) {
    for (int item = blockIdx.x; item < 1024; item += F.G) gdn_prep_item(F, A, item);
}

__device__ __forceinline__ bf16x8 pack8(const f32x16& a, int s) {
    v4u w; w.x = pg8::cvt_pk_bf16(a[8 * s + 0], a[8 * s + 1]); w.y = pg8::cvt_pk_bf16(a[8 * s + 2], a[8 * s + 3]); w.z = pg8::cvt_pk_bf16(a[8 * s + 4], a[8 * s + 5]); w.w = pg8::cvt_pk_bf16(a[8 * s + 6], a[8 * s + 7]);
    return __builtin_bit_cast(bf16x8, w);
}
constexpr int SC_STAGE = 65536;
__device__ __forceinline__ void gdn_scan_block(Frame& F, int task) {
    const int lane = F.lane, wave = F.wave, r32 = lane & 31, hi = lane >> 5;
    const int bh = task >> 2, sl = task & 3, b = bh >> 2, h = bh & 3;
    LAS unsigned char* lds = F.lds;
    float* oa = (float*)(F.ws + WS_OA);
    const unsigned char* g0 = F.ws + WS_GDN + (size_t)(bh * 128) * GDN_ITEM;
    auto issue = [&](int n) {
        const unsigned char* gi = g0 + (size_t)n * GDN_ITEM; LAS unsigned char* st = lds + (n & 1) * SC_STAGE;
        for (int p = wave - 1; p < 64; p += 7) {
            const unsigned char* src = (p < 56) ? gi + p * 1024 : gi + GDN_UF + (size_t)sl * 8192 + (p - 56) * 1024;
            __builtin_amdgcn_global_load_lds((const unsigned*)(src + lane * 16), (LAS unsigned*)(st + p * 1024), 16, 0, 0);
        }
    };
    f32x16 st4[4];
#pragma unroll
    for (int dt = 0; dt < 4; ++dt)
#pragma unroll
        for (int r = 0; r < 16; ++r) st4[dt][r] = 0.f;
    __syncthreads();
    if (wave != 0) issue(0);
    __syncthreads();
    for (int n = 0; n < 128; ++n) {
        if (wave != 0) { if (n + 1 < 128) issue(n + 1); }
        else {
            const LAS unsigned char* sg = lds + (n & 1) * SC_STAGE;
            const LAS bf16x8* wf = (const LAS bf16x8*)(sg + GDN_WF) + lane; const LAS bf16x8* qf = (const LAS bf16x8*)(sg + GDN_QF) + lane;
            const LAS bf16x8* af = (const LAS bf16x8*)(sg + GDN_AF) + lane; const LAS bf16x8* kf = (const LAS bf16x8*)(sg + GDN_KF) + lane;
            const LAS float* ufl = (const LAS float*)(sg + 57344) + 4 * hi * 32 + r32;
            const float egl = *(const float*)(g0 + (size_t)n * GDN_ITEM + GDN_EG);
            float* oap = oa + (size_t)(b * S + n * 64 + 4 * hi) * 512 + h * 128 + sl * 32 + r32;
            bf16x8 sb[8];
#pragma unroll
            for (int dt = 0; dt < 4; ++dt) { sb[2 * dt] = pack8(st4[dt], 0); sb[2 * dt + 1] = pack8(st4[dt], 1); }
            f32x16 vn[2], oc[2];
#pragma unroll
            for (int mt = 0; mt < 2; ++mt) {
                f32x16 ws_;
#pragma unroll
                for (int r = 0; r < 16; ++r) { ws_[r] = 0.f; oc[mt][r] = 0.f; }
#pragma unroll
                for (int ks = 0; ks < 8; ++ks) { ws_ = __builtin_amdgcn_mfma_f32_32x32x16_bf16(wf[(mt * 8 + ks) * 64], sb[ks], ws_, 0, 0, 0);
                                                 oc[mt] = __builtin_amdgcn_mfma_f32_32x32x16_bf16(qf[(mt * 8 + ks) * 64], sb[ks], oc[mt], 0, 0, 0); }
#pragma unroll
                for (int r = 0; r < 16; ++r) vn[mt][r] = ufl[(32 * mt + (r & 3) + 8 * (r >> 2)) * 32] - ws_[r];
            }
            bf16x8 vb[4];
#pragma unroll
            for (int mt = 0; mt < 2; ++mt) { vb[2 * mt] = pack8(vn[mt], 0); vb[2 * mt + 1] = pack8(vn[mt], 1); }
#pragma unroll
            for (int mt = 0; mt < 2; ++mt) {
#pragma unroll
                for (int ks = 0; ks < 4; ++ks) oc[mt] = __builtin_amdgcn_mfma_f32_32x32x16_bf16(af[(mt * 4 + ks) * 64], vb[ks], oc[mt], 0, 0, 0);
#pragma unroll
                for (int r = 0; r < 16; ++r) oap[(size_t)(32 * mt + (r & 3) + 8 * (r >> 2)) * 512] = oc[mt][r];
            }
#pragma unroll
            for (int dt = 0; dt < 4; ++dt) {
#pragma unroll
                for (int r = 0; r < 16; ++r) st4[dt][r] *= egl;
#pragma unroll
                for (int ks = 0; ks < 4; ++ks) st4[dt] = __builtin_amdgcn_mfma_f32_32x32x16_bf16(kf[(dt * 4 + ks) * 64], vb[ks], st4[dt], 0, 0, 0);
            }
        }
        __syncthreads();
    }
}
constexpr int CW_QUEUE = 64;
__device__ __forceinline__ void mixer_phase(Frame& F, const Args& A, int rep) {
    if (blockIdx.x < 32) gdn_scan_block(F, (int)blockIdx.x);
    unsigned* qctr = (unsigned*)(F.ws + WS_CTL) + CW_QUEUE + 64 * rep;
    volatile LAS int* slot = (volatile LAS int*)(F.lds + CTRL_OFF + 64);
    for (;;) {
        __syncthreads();
        if (F.tid == 0) slot[0] = (int)__hip_atomic_fetch_add(qctr, 1u, __ATOMIC_RELAXED, __HIP_MEMORY_SCOPE_AGENT);
        __syncthreads();
        const int i = slot[0];
        if (i >= 512) break;
        const int qb = 31 - (i >> 4), x = i & 15;
        attn_unit(F, x >> 3, (x >> 1) & 3, x & 1, qb);
    }
}
__global__ void __launch_bounds__(NWAVES * 64, 2) mega(Args args) {
    extern __shared__ __attribute__((aligned(16))) unsigned char lds_raw[];
    Frame F;
    F.lds = (LAS unsigned char*)lds_raw;
    F.MISC = (volatile LAS unsigned*)(F.lds + MISC_OFF);
    F.tid = threadIdx.x; F.lane = F.tid & 63; F.wave = __builtin_amdgcn_readfirstlane(F.tid >> 6);
    F.G = gridDim.x; { const int bx = blockIdx.x; F.vcu = (F.G % 8 == 0) ? (bx % 8) * (F.G / 8) + bx / 8 : bx; }
    F.out = args.out; F.ws = args.ws;
    for (int u = F.tid; u < (LDS_BYTES - CTRL_OFF) / 4; u += NWAVES * 64) ((LAS unsigned*)(F.lds + CTRL_OFF))[u] = 0u;
    __syncthreads();
    const int lo = args.ph_lo, hi = args.ph_hi;
    XcdBarrier bar; bar.bar = (unsigned*)(F.ws + WS_CTL) + CW_BAR; bar.x = 0; bar.st = nullptr;
    if (hi - lo > 1) bar = xcd_barrier_post((unsigned*)(F.ws + WS_CTL) + CW_BAR, F.MISC + 8);
#ifndef PHASE_MASK
#define PHASE_MASK 0xffff
#endif
#ifndef DUP_MASK
#define DUP_MASK 0
#endif
#define IN(k) (((PHASE_MASK >> (k)) & 1) && lo <= (k) && (k) < hi)
    if (IN(0)) { p0_phase(F, args); }
#if (DUP_MASK >> 0) & 1
    if (IN(0)) xcd_barrier(bar);
    if (IN(0)) { p0_phase(F, args); }
#endif
    if (IN(0) && IN(1)) xcd_barrier(bar);
    if (IN(1)) { norm_mod_phase<true, true>(F, args, args.in[0], args.in[4], 0, 1024, (bf16_t*)(F.ws + WS_H)); }
#if (DUP_MASK >> 1) & 1
    if (IN(1)) xcd_barrier(bar);
    if (IN(1)) { norm_mod_phase<true, true>(F, args, args.in[0], args.in[4], 0, 1024, (bf16_t*)(F.ws + WS_H)); }
#endif
    if (IN(1) && IN(2)) xcd_barrier(bar);
    if (IN(2)) {
        pg8::Gemm g{(const bf16_t*)(F.ws + WS_H), (const bf16_t*)(F.ws + WS_WIN), T, LDP, D}; pg8::StaticOrder So; So.init(T, LDP, F.G, (int)blockIdx.x);
        pg8::EpiStoreBf16 E{(bf16_t*)(F.ws + WS_P), LDP, 0};
        pg8::gemm_phase<pg8::EpiStoreBf16, pg8::StaticOrder, true, true>(F.lds, g, So, E);
    }
#if (DUP_MASK >> 2) & 1
    if (IN(2)) xcd_barrier(bar);
    if (IN(2)) {
        pg8::Gemm g{(const bf16_t*)(F.ws + WS_H), (const bf16_t*)(F.ws + WS_WIN), T, LDP, D}; pg8::StaticOrder So; So.init(T, LDP, F.G, (int)blockIdx.x);
        pg8::EpiStoreBf16 E{(bf16_t*)(F.ws + WS_P), LDP, 0};
        pg8::gemm_phase<pg8::EpiStoreBf16, pg8::StaticOrder, true, true>(F.lds, g, So, E);
    }
#endif
    if (IN(2) && IN(3)) xcd_barrier(bar);
    if (IN(3)) { attn_prep_phase(F, args); gdn_prep_phase(F, args); }
#if (DUP_MASK >> 3) & 1
    if (IN(3)) xcd_barrier(bar);
    if (IN(3)) { attn_prep_phase(F, args); gdn_prep_phase(F, args); }
#endif
    if (IN(3) && IN(4)) xcd_barrier(bar);
    if (IN(4)) { mixer_phase(F, args, 0); }
#if (DUP_MASK >> 4) & 1
    if (IN(4)) xcd_barrier(bar);
    if (IN(4)) { mixer_phase(F, args, 1); }
#endif
    if (IN(4) && IN(5)) xcd_barrier(bar);
    if (IN(5)) { post_norm_phase(F, args); }
#if (DUP_MASK >> 5) & 1
    if (IN(5)) xcd_barrier(bar);
    if (IN(5)) { post_norm_phase(F, args); }
#endif
    if (IN(5) && IN(6)) xcd_barrier(bar);
    if (IN(6)) {
        { pg8::Gemm g{(const bf16_t*)(F.ws + WS_OAN), (const bf16_t*)(F.ws + WS_WOA), T, 1024, 512}; pg8::StaticOrder So; So.init(T, 1024, F.G, (int)blockIdx.x);
          pg8::EpiGate<false> E{(const bf16_t*)(F.ws + WS_P) + C_GA, nullptr, (bf16_t*)(F.ws + WS_TMPB), LDP, 0};
          pg8::gemm_phase<pg8::EpiGate<false>, pg8::StaticOrder, true, true>(F.lds, g, So, E); }
        { pg8::Gemm g{(const bf16_t*)(F.ws + WS_OBN), (const bf16_t*)(F.ws + WS_WOB), T, 1024, 512}; pg8::StaticOrder So; So.init(T, 1024, F.G, (int)blockIdx.x);
          pg8::EpiGate<true> E{(const bf16_t*)(F.ws + WS_P) + C_GB, (const bf16_t*)(F.ws + WS_TMPB), (bf16_t*)(F.ws + WS_MERGED), LDP, 0};
          pg8::gemm_phase<pg8::EpiGate<true>, pg8::StaticOrder, true, true>(F.lds, g, So, E); }
    }
#if (DUP_MASK >> 6) & 1
    if (IN(6)) xcd_barrier(bar);
    if (IN(6)) {
        { pg8::Gemm g{(const bf16_t*)(F.ws + WS_OAN), (const bf16_t*)(F.ws + WS_WOA), T, 1024, 512}; pg8::StaticOrder So; So.init(T, 1024, F.G, (int)blockIdx.x);
          pg8::EpiGate<false> E{(const bf16_t*)(F.ws + WS_P) + C_GA, nullptr, (bf16_t*)(F.ws + WS_TMPB), LDP, 0};
          pg8::gemm_phase<pg8::EpiGate<false>, pg8::StaticOrder, true, true>(F.lds, g, So, E); }
        { pg8::Gemm g{(const bf16_t*)(F.ws + WS_OBN), (const bf16_t*)(F.ws + WS_WOB), T, 1024, 512}; pg8::StaticOrder So; So.init(T, 1024, F.G, (int)blockIdx.x);
          pg8::EpiGate<true> E{(const bf16_t*)(F.ws + WS_P) + C_GB, (const bf16_t*)(F.ws + WS_TMPB), (bf16_t*)(F.ws + WS_MERGED), LDP, 0};
          pg8::gemm_phase<pg8::EpiGate<true>, pg8::StaticOrder, true, true>(F.lds, g, So, E); }
    }
#endif
    if (IN(6) && IN(7)) xcd_barrier(bar);
    if (IN(7)) {
        pg8::Gemm g{(const bf16_t*)(F.ws + WS_MERGED), (const bf16_t*)(F.ws + WS_WOUT), T, 1024, 1024}; pg8::StaticOrder So; So.init(T, 1024, F.G, (int)blockIdx.x);
        pg8::EpiResid E{args.in[0], (const float*)(F.ws + WS_MOD) + 2048, (float*)(F.ws + WS_X1)};
        pg8::gemm_phase<pg8::EpiResid, pg8::StaticOrder, true, true>(F.lds, g, So, E);
    }
#if (DUP_MASK >> 7) & 1
    if (IN(7)) xcd_barrier(bar);
    if (IN(7)) {
        pg8::Gemm g{(const bf16_t*)(F.ws + WS_MERGED), (const bf16_t*)(F.ws + WS_WOUT), T, 1024, 1024}; pg8::StaticOrder So; So.init(T, 1024, F.G, (int)blockIdx.x);
        pg8::EpiResid E{args.in[0], (const float*)(F.ws + WS_MOD) + 2048, (float*)(F.ws + WS_X1)};
        pg8::gemm_phase<pg8::EpiResid, pg8::StaticOrder, true, true>(F.lds, g, So, E);
    }
#endif
    if (IN(7) && IN(8)) xcd_barrier(bar);
    if (IN(8)) { norm_mod_phase<false, false>(F, args, (const float*)(F.ws + WS_X1), args.in[20], 3072, 4096, (bf16_t*)(F.ws + WS_H)); }
#if (DUP_MASK >> 8) & 1
    if (IN(8)) xcd_barrier(bar);
    if (IN(8)) { norm_mod_phase<false, false>(F, args, (const float*)(F.ws + WS_X1), args.in[20], 3072, 4096, (bf16_t*)(F.ws + WS_H)); }
#endif
    if (IN(8) && IN(9)) xcd_barrier(bar);
    if (IN(9)) {
        pg8::Gemm g{(const bf16_t*)(F.ws + WS_H), (const bf16_t*)(F.ws + WS_W9), T, 768, 1024}; pg8::StaticOrder So; So.init(T, 768, F.G, (int)blockIdx.x);
        pg8::EpiSharedRouter E{(bf16_t*)(F.ws + WS_SACT), (float*)(F.ws + WS_LOGITS)};
        pg8::gemm_phase<pg8::EpiSharedRouter, pg8::StaticOrder, true, true>(F.lds, g, So, E);
    }
#if (DUP_MASK >> 9) & 1
    if (IN(9)) xcd_barrier(bar);
    if (IN(9)) {
        pg8::Gemm g{(const bf16_t*)(F.ws + WS_H), (const bf16_t*)(F.ws + WS_W9), T, 768, 1024}; pg8::StaticOrder So; So.init(T, 768, F.G, (int)blockIdx.x);
        pg8::EpiSharedRouter E{(bf16_t*)(F.ws + WS_SACT), (float*)(F.ws + WS_LOGITS)};
        pg8::gemm_phase<pg8::EpiSharedRouter, pg8::StaticOrder, true, true>(F.lds, g, So, E);
    }
#endif
    if (IN(9) && IN(10)) xcd_barrier(bar);
    if (IN(10)) { route_phase(F, args); }
#if (DUP_MASK >> 10) & 1
    if (IN(10)) xcd_barrier(bar);
    if (IN(10)) { route_phase(F, args); }
#endif
    if (IN(10) && IN(11)) xcd_barrier(bar);
    if (IN(11)) { moe_phase(F, args); }
#if (DUP_MASK >> 11) & 1
    if (IN(11)) xcd_barrier(bar);
    if (IN(11)) { moe_phase(F, args); }
#endif
    if (IN(11) && IN(12)) xcd_barrier(bar);
    if (IN(12)) {
        pg8::Gemm g{(const bf16_t*)(F.ws + WS_SACT), (const bf16_t*)(F.ws + WS_WSD), T, 1024, 256}; pg8::StaticOrder So; So.init(T, 1024, F.G, (int)blockIdx.x);
        pg8::EpiFinal E{(const float*)(F.ws + WS_X1), (const float*)(F.ws + WS_MOD) + 5120, (const bf16_t*)(F.ws + WS_Y), F.out};
        pg8::gemm_phase<pg8::EpiFinal, pg8::StaticOrder, true, true>(F.lds, g, So, E);
    }
#if (DUP_MASK >> 12) & 1
    if (IN(12)) xcd_barrier(bar);
    if (IN(12)) {
        pg8::Gemm g{(const bf16_t*)(F.ws + WS_SACT), (const bf16_t*)(F.ws + WS_WSD), T, 1024, 256}; pg8::StaticOrder So; So.init(T, 1024, F.G, (int)blockIdx.x);
        pg8::EpiFinal E{(const float*)(F.ws + WS_X1), (const float*)(F.ws + WS_MOD) + 5120, (const bf16_t*)(F.ws + WS_Y), F.out};
        pg8::gemm_phase<pg8::EpiFinal, pg8::StaticOrder, true, true>(F.lds, g, So, E);
    }
#endif
#undef IN
}
extern "C" void kernel_launch(void* const* d_in, const int* in_sizes, int n_in, void* d_out, int out_size, void* d_ws, size_t ws_size, hipStream_t stream) {
  static int grid = 0;
  if (grid == 0) {
    int dev = 0, cus = 0;
    if (n_in != 27 || out_size != T * D || ws_size < WS_END) { fprintf(stderr, "kernel_launch: unexpected problem (n_in %d, out %d, ws %zu < %zu)\n", n_in, out_size, ws_size, (size_t)WS_END); grid = -1; return; }
    if (hipGetDevice(&dev) != hipSuccess || hipDeviceGetAttribute(&cus, hipDeviceAttributeMultiprocessorCount, dev) != hipSuccess) { fprintf(stderr, "kernel_launch: device query failed\n"); grid = -1; return; }
    if (hipFuncSetAttribute((const void*)mega, hipFuncAttributeMaxDynamicSharedMemorySize, LDS_BYTES) != hipSuccess) { fprintf(stderr, "kernel_launch: hipFuncSetAttribute failed\n"); grid = -1; return; }
    int per_cu = 0;
    if (hipOccupancyMaxActiveBlocksPerMultiprocessor(&per_cu, (const void*)mega, NWAVES * 64, LDS_BYTES) != hipSuccess || per_cu < 1) fprintf(stderr, "kernel_launch: occupancy query says %d blocks per CU\n", per_cu);
    (void)hipGetLastError();
    grid = cus;
  }
  if (grid < 0) return;
  (void)hipMemsetAsync((unsigned char*)d_ws + WS_CTL, 0, CTL_ZERO_BYTES, stream);
  Args a{};
  for (int i = 0; i < 27; ++i) a.in[i] = (const float*)d_in[i];
  a.out = (float*)d_out; a.ws = (unsigned char*)d_ws;
#ifndef N_LAUNCH_PHASES
  a.ph_lo = 0; a.ph_hi = 13;
  hipLaunchKernelGGL(mega, dim3(grid), dim3(NWAVES * 64), LDS_BYTES, stream, a);
#else
  for (int ph = 0; ph < 13; ++ph) { a.ph_lo = ph; a.ph_hi = ph + 1; hipLaunchKernelGGL(mega, dim3(grid), dim3(NWAVES * 64), LDS_BYTES, stream, a); }
#endif
}
```

```cpp
#include <hip/hip_runtime.h>
#include <stdint.h>
#include <cstdio>

typedef unsigned short bf16_t;
constexpr int D = 1024, NB = 2, S = 8192, T = NB * S;
constexpr int INC = 5640;
constexpr int LDP = 5632;
constexpr int C_QA = 0, C_KA = 512, C_VA = 1024, C_ZA = 1536, C_QB = 2048, C_KB = 2560, C_VB = 3072, C_GA = 3584, C_GB = 4608;
constexpr int NE = 256, TOPK = 8, NA = T * TOPK;
constexpr float EPS = 1e-6f;
constexpr float LAM_INIT = 0.2f;
__device__ __forceinline__ float bf2f(bf16_t v) { return __uint_as_float(((unsigned)v) << 16); }
__device__ __forceinline__ float siluf(float x) { return x / (1.f + __expf(-x)); }
__device__ __forceinline__ float sigmf(float x) { return 1.f / (1.f + __expf(-x)); }
__device__ __forceinline__ float softplusf(float x) { return x > 20.f ? x : log1pf(__expf(x)); }
__device__ __forceinline__ float wave_sum(float v) {
#pragma unroll
  for (int o = 1; o < 64; o <<= 1) v += __shfl_xor(v, o);
  return v;
}
constexpr size_t MiB = 1u << 20;
constexpr size_t WS_CTL = 0, CTL_ZERO_BYTES = 1 * MiB;
constexpr size_t WS_MODP = 1 * MiB;
constexpr size_t WS_MOD = 1 * MiB + 256 * 1024;
constexpr size_t WS_SCAL = 1 * MiB + 320 * 1024;
constexpr size_t WS_WIN = 2 * MiB;
constexpr size_t WS_WOA = 13 * MiB, WS_WOB = 14 * MiB;
constexpr size_t WS_WOUT = 15 * MiB;
constexpr size_t WS_W9 = 17 * MiB;
constexpr size_t WS_WSD = 19 * MiB;
constexpr size_t WS_BD = 20 * MiB;
constexpr size_t WS_H = 32 * MiB;
constexpr size_t WS_P = 64 * MiB;
constexpr size_t WS_OAN = 240 * MiB, WS_OBN = 256 * MiB;
constexpr size_t WS_TMPB = 272 * MiB;
constexpr size_t WS_MERGED = 304 * MiB;
constexpr size_t WS_X1 = 336 * MiB;
constexpr size_t WS_LOGITS = 400 * MiB;
constexpr size_t WS_SACT = 416 * MiB;
constexpr size_t WS_TOPI = 424 * MiB, WS_TOPW = 425 * MiB;
constexpr size_t WS_Y = 432 * MiB;
constexpr size_t WS_ACTB = 704 * MiB;
constexpr size_t WS_LIST = 768 * MiB;
constexpr size_t WS_QN = 800 * MiB, WS_KN = 816 * MiB;
constexpr size_t WS_OB = 832 * MiB;
constexpr size_t WS_OA = 864 * MiB;
constexpr size_t WS_GDN = 896 * MiB;
constexpr size_t WS_XA = 992 * MiB;
constexpr size_t XA_BLOCK = (size_t)32 * 640 * 16;
constexpr size_t WS_END = WS_XA + 256 * XA_BLOCK;
constexpr int CW_BAR = 4096;

#define GAS __attribute__((address_space(1)))
#define LAS __attribute__((address_space(3)))
typedef unsigned v4u __attribute__((ext_vector_type(4)));
typedef float f32x4 __attribute__((ext_vector_type(4)));
typedef unsigned u32x2 __attribute__((ext_vector_type(2)));
typedef short bf16x8 __attribute__((ext_vector_type(8)));
typedef GAS unsigned gu32;
typedef GAS unsigned long long gu64;
#define RLX_AGENT __ATOMIC_RELAXED, __HIP_MEMORY_SCOPE_AGENT
#define LDS_WAIT() asm volatile("s_waitcnt lgkmcnt(0)" ::: "memory")
#define VM_WAIT() asm volatile("s_waitcnt vmcnt(0)" ::: "memory")
__device__ __forceinline__ unsigned f2bf(float f) { unsigned u = __builtin_bit_cast(unsigned, f); return (u + 0x7fffu + ((u >> 16) & 1u)) >> 16; }
__device__ __forceinline__ unsigned pk2(float lo, float hi) { return f2bf(lo) | (f2bf(hi) << 16); }

constexpr int NWAVES = 8;
constexpr int LDS_BYTES = 163840;
constexpr int CTRL_OFF = 159744;
constexpr int MISC_OFF = CTRL_OFF + 320;
constexpr int CW_ECNT = 256;

struct Frame {
    LAS unsigned char* lds;
    volatile LAS unsigned* MISC;
    int tid, lane, wave, vcu, G;
    float* out; unsigned char* ws;
    const __attribute__((address_space(4))) unsigned char* karg;
};
#define KIN(k) (*(const float* const __attribute__((address_space(4)))*)(F.karg + 8 * (k)))
struct Args { const float* in[27]; float* out; unsigned char* ws; int ph_lo, ph_hi; };
namespace pg8 {
#define PG8_LAS __attribute__((address_space(3)))
typedef unsigned short bf16_t;
typedef short bf16x8 __attribute__((ext_vector_type(8)));
typedef float f32x4 __attribute__((ext_vector_type(4)));
typedef unsigned u32x4 __attribute__((ext_vector_type(4)));
constexpr int BM = 256, BK = 64, HALF = 128, HTB = HALF * BK * 2  , STAGE_BYTES = 8 * HTB, NXCD = 8, WGM = 8;

__host__ __device__ __forceinline__ int lds_byte(int r, int c) { const int st = (r >> 4) * 2 + (c >> 5), rr = r & 15, cc = c & 31, ob = rr * 64 + cc * 2; return st * 1024 + (ob ^ (((ob >> 9) & 1) << 5)); }
__host__ __device__ __forceinline__ void stage_rc(int b, int& R, int& C) { const int st = b / 1024, sb = b % 1024, swz = sb ^ (((sb >> 9) & 1) << 5); R = (st >> 1) * 16 + swz / 64; C = (st & 1) * 32 + (swz % 64) / 2; }
__host__ __device__ __forceinline__ int perm32(int rho) { const int n = rho >> 4, i = rho & 15; return 8 * (i >> 2) + 4 * n + (i & 3); }

struct Unit { int pm, pn; };
struct Gemm { const bf16_t* A; const bf16_t* Bt; int M, N, K; };

struct StaticOrder {
    int nM, nN, nwg, G, c;
    __host__ __device__ void init(int M, int N, int G_, int c_) { nM = M / BM; nN = N / BM; nwg = nM * nN; G = G_; c = c_; }
    __host__ __device__ bool next(int i, Unit& u) const {
        const long L = (long)i * G + c; if (L >= nwg) return false;
        int wgid = (int)L; { const int q = nwg / NXCD, r = nwg % NXCD, xcd = wgid % NXCD, off = wgid / NXCD; wgid = (xcd < r ? xcd * (q + 1) : r * (q + 1) + (xcd - r) * q) + off; }
        const int nig = WGM * nN, gid = wgid / nig, fm = gid * WGM, gsz = (nM - fm) < WGM ? (nM - fm) : WGM;
        u.pm = fm + ((wgid % nig) % gsz); u.pn = (wgid % nig) / gsz; return true;
    }
    __device__ __forceinline__ void a_ready(const Unit&) const {}
    __device__ __forceinline__ void done(const Unit&) const {}
};

__device__ __forceinline__ unsigned cvt_pk_bf16(float lo, float hi) { unsigned r; asm volatile("v_cvt_pk_bf16_f32 %0, %1, %2" : "=v"(r) : "v"(lo), "v"(hi)); return r; }
typedef float f32x2 __attribute__((ext_vector_type(2)));
template <class Epi, class Sched, bool ALIGN_EPI = false, bool SP2 = false>
__device__ __forceinline__ void gemm_phase(PG8_LAS unsigned char* lds, const Gemm g, const Sched& S, const Epi& E) {
    const int tid = threadIdx.x, wid = __builtin_amdgcn_readfirstlane(tid >> 6), lane = tid & 63, wr = wid >> 2, wc = wid & 3, fr = lane & 15, fq = lane >> 4;
    const int K = g.K, nt = K / BK;
    unsigned voffA[2], voffB[2];
#pragma unroll
    for (int i = 0; i < 2; ++i) { int R, C; stage_rc(tid * 16 + i * 8192, R, C); const int Rb = Epi::PERM ? ((R & ~31) + perm32(R & 31)) : R;
        voffA[i] = (unsigned)(R * K + C) * 2u; voffB[i] = (unsigned)(Rb * K + C) * 2u; }
    const size_t kstep = (size_t)(BK * 2);
    const size_t hstep = (size_t)HALF * K * 2;
    const size_t tstep = 2 * hstep;
    const unsigned ldsw = (unsigned)wid * 1024u;
    const int aoff = lds_byte(wr * 64 + fr, fq * 8), boff = lds_byte(wc * 32 + fr, fq * 8);
#define PG8_SA(b, h) (((b) * 2 + (h)) * HTB)
#define PG8_SB(b, h) ((4 + (b) * 2 + (h)) * HTB)
#define PG8_STAGE(bufoff, gbase, voff) do { _Pragma("unroll") for (int _i = 0; _i < 2; ++_i) \
        __builtin_amdgcn_global_load_lds((const unsigned*)((const char*)(gbase) + (voff)[_i]), (PG8_LAS unsigned*)(lds + (bufoff) + ldsw + _i * 8192), 16, 0, 0); } while (0)
#define PG8_LDA(dst, b, h) do { _Pragma("unroll") for (int m = 0; m < 4; ++m) _Pragma("unroll") for (int k = 0; k < 2; ++k) dst[m][k] = *(const PG8_LAS bf16x8*)(lds + PG8_SA(b, h) + aoff + m * 2048 + k * 1024); } while (0)
#define PG8_LDB(dst, b, h) do { _Pragma("unroll") for (int n = 0; n < 2; ++n) _Pragma("unroll") for (int k = 0; k < 2; ++k) dst[n][k] = *(const PG8_LAS bf16x8*)(lds + PG8_SB(b, h) + boff + n * 2048 + k * 1024); } while (0)
#define PG8_MMA(ai, bj, At, Bt) do { __builtin_amdgcn_s_setprio(1); _Pragma("unroll") for (int m = 0; m < 4; ++m) _Pragma("unroll") for (int n = 0; n < 2; ++n) _Pragma("unroll") for (int k = 0; k < 2; ++k) \
        acc[ai][bj][m][n] = __builtin_amdgcn_mfma_f32_16x16x32_bf16(Bt[n][k], At[m][k], acc[ai][bj][m][n], 0, 0, 0); __builtin_amdgcn_s_setprio(0); } while (0)
#define PG8_WAIT_V(n) asm volatile("s_waitcnt vmcnt(" #n ")" ::: "memory")
#define PG8_WAIT_L(n) asm volatile("s_waitcnt lgkmcnt(" #n ")" ::: "memory")
#define PG8_BAR __builtin_amdgcn_s_barrier()
#define PG8_SCHED __builtin_amdgcn_sched_barrier(0)
    Unit cur, nxt; int ui = 0;
    if (!S.next(0, cur)) return;
    f32x4 acc[2][2][4][2];
#pragma unroll
    for (int a = 0; a < 2; ++a)
#pragma unroll
        for (int b = 0; b < 2; ++b)
#pragma unroll
            for (int m = 0; m < 4; ++m)
#pragma unroll
                for (int n = 0; n < 2; ++n) acc[a][b][m][n] = (f32x4){0.f, 0.f, 0.f, 0.f};
    bf16x8 At[4][2], B0[2][2], B1[2][2];
    const char* cA = (const char*)g.A + (size_t)cur.pm * tstep; const char* cB = (const char*)g.Bt + (size_t)cur.pn * tstep;
    S.a_ready(cur);
    if constexpr (SP2) {
        PG8_STAGE(PG8_SB(0, 0), cB, voffB); PG8_STAGE(PG8_SB(0, 1), cB + hstep, voffB); PG8_STAGE(PG8_SA(0, 0), cA, voffA); PG8_STAGE(PG8_SA(0, 1), cA + hstep, voffA);
        if (wr == 1) PG8_BAR;
        PG8_WAIT_V(2); PG8_BAR;
        PG8_STAGE(PG8_SB(1, 0), cB + kstep, voffB); PG8_STAGE(PG8_SA(1, 0), cA + kstep, voffA); PG8_STAGE(PG8_SB(1, 1), cB + hstep + kstep, voffB);
        PG8_WAIT_V(6); PG8_BAR;
    } else {
        PG8_STAGE(PG8_SB(0, 0), cB, voffB); PG8_STAGE(PG8_SA(0, 0), cA, voffA); PG8_STAGE(PG8_SB(0, 1), cB + hstep, voffB); PG8_STAGE(PG8_SA(0, 1), cA + hstep, voffA);
        if (wr == 1) PG8_BAR;
        PG8_WAIT_V(4); PG8_BAR;
        PG8_STAGE(PG8_SB(1, 0), cB + kstep, voffB); PG8_STAGE(PG8_SA(1, 0), cA + kstep, voffA); PG8_STAGE(PG8_SB(1, 1), cB + hstep + kstep, voffB);
        PG8_WAIT_V(6); PG8_BAR;
    }
    for (;;) {
        const bool has_next = S.next(ui + 1, nxt);
        const char* nA = has_next ? (const char*)g.A + (size_t)nxt.pm * tstep : cA; const char* nB = has_next ? (const char*)g.Bt + (size_t)nxt.pn * tstep : cB;
        for (int t = 0; t < nt; t += 2) {
            const bool last = (t == nt - 2);
            const char* a1 = cA + (size_t)(t + 1) * kstep;
            const char* a2 = last ? nA : cA + (size_t)(t + 2) * kstep; const char* b2 = last ? nB : cB + (size_t)(t + 2) * kstep;
            const char* a3 = a2 + kstep; const char* b3 = b2 + kstep;
            if (last && has_next) S.a_ready(nxt);
            if constexpr (SP2) {
            PG8_LDB(B0, 0, 0); PG8_LDB(B1, 0, 1); PG8_SCHED; PG8_LDA(At, 0, 0); PG8_STAGE(PG8_SA(1, 1), a1 + hstep, voffA);
            PG8_WAIT_V(8); PG8_WAIT_L(0); PG8_BAR; PG8_MMA(0, 0, At, B0); PG8_MMA(0, 1, At, B1); PG8_BAR; PG8_SCHED;
            PG8_LDA(At, 0, 1); PG8_STAGE(PG8_SB(0, 0), b2, voffB); PG8_STAGE(PG8_SB(0, 1), b2 + hstep, voffB); PG8_STAGE(PG8_SA(0, 0), a2, voffA);
            PG8_WAIT_V(8); PG8_WAIT_L(0); PG8_BAR; PG8_MMA(1, 0, At, B0); PG8_MMA(1, 1, At, B1); PG8_BAR; PG8_SCHED;
            PG8_LDB(B0, 1, 0); PG8_LDB(B1, 1, 1); PG8_SCHED; PG8_LDA(At, 1, 0); PG8_STAGE(PG8_SA(0, 1), a2 + hstep, voffA);
            PG8_WAIT_V(8); PG8_WAIT_L(0); PG8_BAR; PG8_MMA(0, 0, At, B0); PG8_MMA(0, 1, At, B1); PG8_BAR; PG8_SCHED;
            PG8_LDA(At, 1, 1); PG8_STAGE(PG8_SB(1, 0), b3, voffB); PG8_STAGE(PG8_SB(1, 1), b3 + hstep, voffB); PG8_STAGE(PG8_SA(1, 0), a3, voffA);
            PG8_WAIT_V(8); PG8_WAIT_L(0); PG8_BAR; PG8_MMA(1, 0, At, B0); PG8_MMA(1, 1, At, B1); PG8_BAR; PG8_SCHED;
            } else {
            PG8_LDB(B0, 0, 0); PG8_SCHED; PG8_LDA(At, 0, 0); PG8_STAGE(PG8_SA(1, 1), a1 + hstep, voffA);
            PG8_WAIT_L(8); PG8_BAR; PG8_WAIT_L(0); PG8_MMA(0, 0, At, B0); PG8_BAR; PG8_SCHED;
            PG8_LDB(B1, 0, 1); PG8_STAGE(PG8_SB(0, 0), b2, voffB);
            PG8_BAR; PG8_WAIT_L(0); PG8_MMA(0, 1, At, B1); PG8_BAR;
            PG8_LDA(At, 0, 1); PG8_STAGE(PG8_SA(0, 0), a2, voffA);
            PG8_BAR; PG8_WAIT_L(0); PG8_MMA(1, 0, At, B0); PG8_BAR; PG8_SCHED;
            PG8_STAGE(PG8_SB(0, 1), b2 + hstep, voffB);
            PG8_WAIT_V(6); PG8_BAR; PG8_MMA(1, 1, At, B1); PG8_BAR;
            PG8_LDB(B0, 1, 0); PG8_SCHED; PG8_LDA(At, 1, 0); PG8_STAGE(PG8_SA(0, 1), a2 + hstep, voffA);
            PG8_WAIT_L(8); PG8_BAR; PG8_WAIT_L(0); PG8_MMA(0, 0, At, B0); PG8_BAR; PG8_SCHED;
            PG8_LDB(B1, 1, 1); PG8_STAGE(PG8_SB(1, 0), b3, voffB);
            PG8_BAR; PG8_WAIT_L(0); PG8_MMA(0, 1, At, B1); PG8_BAR;
            PG8_LDA(At, 1, 1); PG8_STAGE(PG8_SA(1, 0), a3, voffA);
            PG8_BAR; PG8_WAIT_L(0); PG8_MMA(1, 0, At, B0); PG8_BAR; PG8_SCHED;
            PG8_STAGE(PG8_SB(1, 1), b3 + hstep, voffB);
            PG8_WAIT_V(6); PG8_BAR; PG8_MMA(1, 1, At, B1); PG8_BAR;
            }
        }
        if constexpr (ALIGN_EPI) { if (wr == 0) PG8_BAR; }
        if constexpr (!Epi::AFTER_DRAIN) { E(acc, cur, wr, wc, fr, fq); S.done(cur); }
        if (!has_next) break;
#pragma unroll
        for (int a = 0; a < 2; ++a)
#pragma unroll
            for (int b = 0; b < 2; ++b)
#pragma unroll
                for (int m = 0; m < 4; ++m)
#pragma unroll
                    for (int n = 0; n < 2; ++n) acc[a][b][m][n] = (f32x4){0.f, 0.f, 0.f, 0.f};
        cur = nxt; cA = nA; cB = nB; ++ui;
        if constexpr (ALIGN_EPI) { if (wr == 1) PG8_BAR; }
    }
    PG8_WAIT_V(0);
    if constexpr (!ALIGN_EPI) { if (wr == 0) PG8_BAR; }
    PG8_BAR;
    if constexpr (Epi::AFTER_DRAIN) { E.fused(acc, cur, wr, wc, fr, fq, lds, wid, lane); S.done(cur); }
#undef PG8_SA
#undef PG8_SB
#undef PG8_STAGE
#undef PG8_LDA
#undef PG8_LDB
#undef PG8_MMA
#undef PG8_WAIT_V
#undef PG8_WAIT_L
#undef PG8_BAR
#undef PG8_SCHED
}
}
namespace pg8 {
struct EpiStoreBf16 {
    static constexpr bool PERM = true, AFTER_DRAIN = false;
    bf16_t* O; int ldc; int pad;
    __device__ __forceinline__ void operator()(const f32x4 (&acc)[2][2][4][2], const Unit& u, int wr, int wc, int fr, int fq) const {
        const int row0 = u.pm * BM + wr * 64 + fr, col0 = u.pn * BM + wc * 32 + 8 * fq;
#pragma unroll
        for (int ai = 0; ai < 2; ++ai)
#pragma unroll
            for (int m = 0; m < 4; ++m) { bf16_t* rowp = O + (size_t)(row0 + ai * HALF + m * 16) * ldc + col0;
#pragma unroll
                for (int bj = 0; bj < 2; ++bj) { const f32x4 v0 = acc[ai][bj][m][0], v1 = acc[ai][bj][m][1];
                    u32x4 w; w.x = cvt_pk_bf16(v0[0], v0[1]); w.y = cvt_pk_bf16(v0[2], v0[3]); w.z = cvt_pk_bf16(v1[0], v1[1]); w.w = cvt_pk_bf16(v1[2], v1[3]);
                    *(u32x4*)(rowp + bj * HALF) = w; } }
    }
};
__device__ __forceinline__ float bflo(unsigned w) { return __uint_as_float(w << 16); }
__device__ __forceinline__ float bfhi(unsigned w) { return __uint_as_float(w & 0xffff0000u); }
__device__ __forceinline__ float sigm(float x) { return __builtin_amdgcn_rcpf(1.f + __expf(-x)); }
template <bool ADD> struct EpiGate {
    static constexpr bool PERM = true, AFTER_DRAIN = false;
    const bf16_t* gate; const bf16_t* prev; bf16_t* O; int ldg; int pad;
    __device__ __forceinline__ void operator()(const f32x4 (&acc)[2][2][4][2], const Unit& u, int wr, int wc, int fr, int fq) const {
        const int row0 = u.pm * BM + wr * 64 + fr, col0 = u.pn * BM + wc * 32 + 8 * fq;
#pragma unroll
        for (int ai = 0; ai < 2; ++ai)
#pragma unroll
            for (int m = 0; m < 4; ++m) { const size_t r = (size_t)(row0 + ai * HALF + m * 16);
#pragma unroll
                for (int bj = 0; bj < 2; ++bj) { const int c = col0 + bj * HALF;
                    const u32x4 gw = *(const u32x4*)(gate + r * ldg + c);
                    const f32x4 v0 = acc[ai][bj][m][0], v1 = acc[ai][bj][m][1];
                    float o[8];
                    o[0] = sigm(bflo(gw.x)) * v0[0]; o[1] = sigm(bfhi(gw.x)) * v0[1]; o[2] = sigm(bflo(gw.y)) * v0[2]; o[3] = sigm(bfhi(gw.y)) * v0[3];
                    o[4] = sigm(bflo(gw.z)) * v1[0]; o[5] = sigm(bfhi(gw.z)) * v1[1]; o[6] = sigm(bflo(gw.w)) * v1[2]; o[7] = sigm(bfhi(gw.w)) * v1[3];
                    if (ADD) { const u32x4 pw = *(const u32x4*)(prev + r * 1024 + c);
                        o[0] += bflo(pw.x); o[1] += bfhi(pw.x); o[2] += bflo(pw.y); o[3] += bfhi(pw.y); o[4] += bflo(pw.z); o[5] += bfhi(pw.z); o[6] += bflo(pw.w); o[7] += bfhi(pw.w); }
                    u32x4 w; w.x = cvt_pk_bf16(o[0], o[1]); w.y = cvt_pk_bf16(o[2], o[3]); w.z = cvt_pk_bf16(o[4], o[5]); w.w = cvt_pk_bf16(o[6], o[7]);
                    *(u32x4*)(O + r * 1024 + c) = w; } }
    }
};
struct EpiResid {
    static constexpr bool PERM = false, AFTER_DRAIN = false;
    const float* base; const float* gvec; float* out;
    __device__ __forceinline__ void operator()(const f32x4 (&acc)[2][2][4][2], const Unit& u, int wr, int wc, int fr, int fq) const {
        const int row0 = u.pm * BM + wr * 64 + fr, col0 = u.pn * BM + wc * 32 + 4 * fq;
        const float* gv = gvec + ((u.pm * BM) / 8192) * 6144;
#pragma unroll
        for (int bj = 0; bj < 2; ++bj)
#pragma unroll
            for (int n = 0; n < 2; ++n) { const int c = col0 + bj * HALF + n * 16; const f32x4 g = *(const f32x4*)(gv + c);
#pragma unroll
                for (int ai = 0; ai < 2; ++ai)
#pragma unroll
                    for (int m = 0; m < 4; ++m) { const size_t off = (size_t)(row0 + ai * HALF + m * 16) * 1024 + c;
                        const f32x4 b = *(const f32x4*)(base + off); *(f32x4*)(out + off) = b + g * acc[ai][bj][m][n]; } }
    }
};
struct EpiSharedRouter {
    static constexpr bool PERM = true, AFTER_DRAIN = false;
    bf16_t* sact; float* logits;
    __device__ __forceinline__ void operator()(const f32x4 (&acc)[2][2][4][2], const Unit& u, int wr, int wc, int fr, int fq) const {
        const int row0 = u.pm * BM + wr * 64 + fr;
        if (u.pn < 2) {
#pragma unroll
            for (int ai = 0; ai < 2; ++ai)
#pragma unroll
                for (int m = 0; m < 4; ++m) { const size_t r = (size_t)(row0 + ai * HALF + m * 16);
#pragma unroll
                    for (int bj = 0; bj < 2; ++bj) { const int c8 = (u.pn * BM + bj * HALF + wc * 32 + 8 * fq) >> 1;
                        const f32x4 g = acc[ai][bj][m][0], up = acc[ai][bj][m][1];
                        float a0 = g[0] * sigm(g[0]) * up[0], a1 = g[1] * sigm(g[1]) * up[1], a2 = g[2] * sigm(g[2]) * up[2], a3 = g[3] * sigm(g[3]) * up[3];
                        uint2 w; w.x = cvt_pk_bf16(a0, a1); w.y = cvt_pk_bf16(a2, a3);
                        *(uint2*)(sact + r * 256 + c8) = w; } }
        } else {
#pragma unroll
            for (int ai = 0; ai < 2; ++ai)
#pragma unroll
                for (int m = 0; m < 4; ++m) { const size_t r = (size_t)(row0 + ai * HALF + m * 16);
#pragma unroll
                    for (int bj = 0; bj < 2; ++bj) { const int c = bj * HALF + wc * 32 + 8 * fq;
                        *(f32x4*)(logits + r * 256 + c) = acc[ai][bj][m][0]; *(f32x4*)(logits + r * 256 + c + 4) = acc[ai][bj][m][1]; } }
        }
    }
};
struct EpiFinal {
    static constexpr bool PERM = true, AFTER_DRAIN = false;
    const float* x1; const float* gvec; const bf16_t* Y; float* out;
    __device__ __forceinline__ void operator()(const f32x4 (&acc)[2][2][4][2], const Unit& u, int wr, int wc, int fr, int fq) const {
        const int row0 = u.pm * BM + wr * 64 + fr, col0 = u.pn * BM + wc * 32 + 8 * fq;
        const float* gv = gvec + ((u.pm * BM) / 8192) * 6144;
#pragma unroll
        for (int ai = 0; ai < 2; ++ai)
#pragma unroll
            for (int m = 0; m < 4; ++m) { const size_t r = (size_t)(row0 + ai * HALF + m * 16);
#pragma unroll
                for (int bj = 0; bj < 2; ++bj) { const int c = col0 + bj * HALF;
                    f32x4 s0 = acc[ai][bj][m][0], s1 = acc[ai][bj][m][1];
#pragma unroll
                    for (int k = 0; k < 8; ++k) { const u32x4 yw = *(const u32x4*)(Y + (r * 8 + k) * 1024 + c);
                        s0[0] += bflo(yw.x); s0[1] += bfhi(yw.x); s0[2] += bflo(yw.y); s0[3] += bfhi(yw.y);
                        s1[0] += bflo(yw.z); s1[1] += bfhi(yw.z); s1[2] += bflo(yw.w); s1[3] += bfhi(yw.w); }
                    const f32x4 g0 = *(const f32x4*)(gv + c), g1 = *(const f32x4*)(gv + c + 4);
                    const f32x4 b0 = *(const f32x4*)(x1 + r * 1024 + c), b1 = *(const f32x4*)(x1 + r * 1024 + c + 4);
                    *(f32x4*)(out + r * 1024 + c) = b0 + g0 * s0; *(f32x4*)(out + r * 1024 + c + 4) = b1 + g1 * s1; } }
    }
};
}
#define XB_TMO      128
#define XB_XCNT(j)  (256  + 64 * (j))
#define XB_XSUB(j)  (1280 + 64 * (j))
#define XB_XGEN(j)  (2304 + 64 * (j))
#define XB_TOP      3328
#define XB_TOPGEN   3392
#define XCD_BAR_WORDS 3456
#define XB_SPIN_CAP (1u << 18)

__device__ __forceinline__ unsigned xb_ld(unsigned* p)              { return __hip_atomic_load(p, __ATOMIC_RELAXED, __HIP_MEMORY_SCOPE_AGENT); }
__device__ __forceinline__ unsigned xb_add(unsigned* p, unsigned v) { return __hip_atomic_fetch_add(p, v, __ATOMIC_RELAXED, __HIP_MEMORY_SCOPE_AGENT); }
__device__ __forceinline__ unsigned xb_xcc_id() { return (unsigned)__builtin_amdgcn_s_getreg((3 << 11) | 20) & 0xFu; }
#define XB_SPIN(cond, bar) do { unsigned _sp = 0; while (cond) { __builtin_amdgcn_s_sleep(1); \
    if ((++_sp & 255u) == 0u) { if (xb_ld(&(bar)[XB_TMO])) break; if (_sp > XB_SPIN_CAP) { atomicAdd(&(bar)[XB_TMO], 1u); break; } } } } while (0)

struct XcdBarrier {
    unsigned* bar; unsigned x;
    volatile LAS unsigned* st;
};

__device__ __forceinline__ XcdBarrier xcd_barrier_post(unsigned* bar, volatile LAS unsigned* st) {
    XcdBarrier b; b.bar = bar; b.x = xb_xcc_id(); b.st = st;
    if (threadIdx.x == 0) (void)xb_add(&bar[XB_XCNT(b.x)], 1u);
    return b;
}
__device__ __forceinline__ void xcd_barrier_complete(unsigned* bar, unsigned x, unsigned& nloc, unsigned& nx) {
    const unsigned G = gridDim.x * gridDim.y * gridDim.z;
    unsigned sum, cnt, mine, sp = 0u;
    for (;;) {
        sum = 0u; cnt = 0u; mine = 0u;
#pragma unroll
        for (unsigned j = 0; j < 16; ++j) { const unsigned c = xb_ld(&bar[XB_XCNT(j)]); sum += c; cnt += (c > 0u) ? 1u : 0u; mine = (j == x) ? c : mine; }
        if (sum == G) break;
        __builtin_amdgcn_s_sleep(1);
        if ((++sp & 255u) == 0u) { if (xb_ld(&bar[XB_TMO])) break; if (sp > XB_SPIN_CAP) { atomicAdd(&bar[XB_TMO], 1u); break; } }
    }
    nloc = mine > 0u ? mine : 1u; nx = cnt > 0u ? cnt : 1u;
}

__device__ __forceinline__ void xcd_barrier(const XcdBarrier& b) {
    asm volatile("s_waitcnt vmcnt(0)" ::: "memory");
    __syncthreads();
    if (threadIdx.x == 0) {
        unsigned* bar = b.bar;
        __builtin_amdgcn_s_waitcnt(0);
        unsigned nloc = b.st[0], nx = b.st[1];
        if (nloc == 0u) { xcd_barrier_complete(bar, b.x, nloc, nx); b.st[0] = nloc; b.st[1] = nx; }
        const unsigned old = xb_add(&bar[XB_XSUB(b.x)], 1u);
        const unsigned gen = old / nloc;
        if (old + 1u == (gen + 1u) * nloc) {
            __builtin_amdgcn_fence(__ATOMIC_RELEASE, "agent");
            asm volatile("s_waitcnt vmcnt(0)" ::: "memory");
            const unsigned og = xb_add(&bar[XB_TOP], 1u);
            const unsigned tg = og / nx;
            if (og + 1u == (tg + 1u) * nx) xb_add(&bar[XB_TOPGEN], 1u);
            else XB_SPIN(xb_ld(&bar[XB_TOPGEN]) == tg, bar);
            __builtin_amdgcn_fence(__ATOMIC_ACQUIRE, "agent");
            xb_add(&bar[XB_XGEN(b.x)], 1u);
            asm volatile("s_waitcnt vmcnt(0)" ::: "memory");
        } else {
            XB_SPIN(xb_ld(&bar[XB_XGEN(b.x)]) == gen, bar);
            __builtin_amdgcn_fence(__ATOMIC_ACQUIRE, "agent");
            asm volatile("s_waitcnt vmcnt(0)" ::: "memory");
        }
    }
    __syncthreads();
}
template <class Map>
__device__ __forceinline__ void transpose_item(const float* W, int ldw, int K, bf16_t* WT, int row_off, int nblk, LAS float* scr, int item, int lane, Map srccol) {
    const int kb = item / nblk, nb = item % nblk, k0 = 64 * kb, n0 = 32 * nb;
    const int sc = srccol(n0 + (lane & 31));
#pragma unroll 8
    for (int i = 0; i < 32; ++i) { const int kk = 2 * i + (lane >> 5); scr[kk * 33 + (lane & 31)] = W[(size_t)(k0 + kk) * ldw + sc]; }
    LDS_WAIT(); asm volatile("" ::: "memory");
    const int c = lane & 7;
#pragma unroll
    for (int j = 0; j < 4; ++j) { const int n = (lane >> 3) + 8 * j; const LAS float* s = scr + (8 * c) * 33 + n;
        v4u o; o.x = pk2(s[0 * 33], s[1 * 33]); o.y = pk2(s[2 * 33], s[3 * 33]); o.z = pk2(s[4 * 33], s[5 * 33]); o.w = pk2(s[6 * 33], s[7 * 33]);
        *(v4u*)(WT + (size_t)(row_off + n0 + n) * K + k0 + 8 * c) = o; }
    LDS_WAIT(); asm volatile("" ::: "memory");
}
__device__ __forceinline__ void p0_phase(Frame& F, const Args& A) {
    LAS float* scr = (LAS float*)(F.lds + F.wave * 16384);
    const int gw = F.vcu * NWAVES + F.wave, NGW = F.G * NWAVES, lane = F.lane;
    const float* c = A.in[1]; const float* w_ada = A.in[2]; const float* w_in = A.in[5];
    constexpr int I_MOD = 96 * 4, I_WIN = 16 * 176;
    constexpr int NITEMS = I_MOD + I_WIN;
    for (int it = gw; it < NITEMS; it += NGW) {
        int r = it;
        if (r < I_MOD) {
            const int eb = r >> 2, dc = r & 3, e = eb * 64 + lane; float a0 = 0.f, a1 = 0.f;
#pragma unroll 8
            for (int d = dc * 256; d < dc * 256 + 256; ++d) { const float w = w_ada[(size_t)d * 6144 + e]; a0 += siluf(c[d]) * w; a1 += siluf(c[D + d]) * w; }
            float* modp = (float*)(F.ws + WS_MODP) + dc * 12288; modp[e] = a0; modp[6144 + e] = a1; continue; }
        r -= I_MOD;
        transpose_item(w_in, INC, 1024, (bf16_t*)(F.ws + WS_WIN), 0, 176, scr, r, lane, [](int n) { return n < 2048 ? n : n + 8; });
    }
    if (gw == 0) {
        const float s1 = wave_sum(A.in[13][lane] * A.in[14][lane]), s2 = wave_sum(A.in[15][lane] * A.in[16][lane]);
        float qm = fabsf(A.in[11][lane]), km = fabsf(A.in[12][lane]);
#pragma unroll
        for (int o = 1; o < 64; o <<= 1) { qm = fmaxf(qm, __shfl_xor(qm, o)); km = fmaxf(km, __shfl_xor(km, o)); }
        if (lane == 0) { float* sc = (float*)(F.ws + WS_SCAL); sc[0] = expf(s1) - expf(s2) + LAM_INIT; sc[1] = 8.f * qm * km * 1.4426950408889634f; }
    }
}
__device__ __forceinline__ void late_weight_copies(Frame& F, const Args& A, int w0, int nw) {
    LAS float* scr = (LAS float*)(F.lds + F.wave * 16384);
    const int lane = F.lane;
    const float* w_o_gdn = A.in[10]; const float* w_o_diff = A.in[18]; const float* w_out = A.in[19]; const float* w_router = A.in[21];
    const float* ws_gu = A.in[25]; const float* ws_dn = A.in[26];
    constexpr int I_WOA = 8 * 32, I_WOB = 8 * 32, I_WOUT = 16 * 32, I_SGU = 16 * 16, I_RT = 16 * 8, I_SD = 4 * 32;
    constexpr int NITEMS = I_WOA + I_WOB + I_WOUT + I_SGU + I_RT + I_SD;
    for (int it = w0; it < NITEMS; it += nw) {
        int r = it;
        if (r < I_WOA) { transpose_item(w_o_gdn, 1024, 512, (bf16_t*)(F.ws + WS_WOA), 0, 32, scr, r, lane, [](int n) { return n; }); continue; } r -= I_WOA;
        if (r < I_WOB) { transpose_item(w_o_diff, 1024, 512, (bf16_t*)(F.ws + WS_WOB), 0, 32, scr, r, lane, [](int n) { return n; }); continue; } r -= I_WOB;
        if (r < I_WOUT) { transpose_item(w_out, 1024, 1024, (bf16_t*)(F.ws + WS_WOUT), 0, 32, scr, r, lane, [](int n) { return n; }); continue; } r -= I_WOUT;
        if (r < I_SGU) { transpose_item(ws_gu, 512, 1024, (bf16_t*)(F.ws + WS_W9), 0, 16, scr, r, lane, [](int n) { const int i8 = n >> 3, j = n & 7; return j < 4 ? 4 * i8 + j : 256 + 4 * i8 + (j - 4); }); continue; } r -= I_SGU;
        if (r < I_RT) { transpose_item(w_router, 256, 1024, (bf16_t*)(F.ws + WS_W9), 512, 8, scr, r, lane, [](int n) { return n; }); continue; } r -= I_RT;
        transpose_item(ws_dn, 1024, 256, (bf16_t*)(F.ws + WS_WSD), 0, 32, scr, r, lane, [](int n) { return n; });
    }
}
__device__ __forceinline__ float mod_reduce(const float* modp, const float* b_ada, int idx) {
    return ((modp[idx] + modp[12288 + idx]) + (modp[2 * 12288 + idx] + modp[3 * 12288 + idx])) + b_ada[idx % 6144];
}
template <bool FROM_PARTIALS, bool WITH_BD>
__device__ __forceinline__ void norm_mod_phase(Frame& F, const Args& A, const float* src, const float* gain, int sh_off, int sc_off, bf16_t* dst) {
    LAS float* shs = (LAS float*)F.lds;
    LAS float* scs = shs + 2048;
    LAS float* wbd = scs + 2048;
    const float* modp = (const float*)(F.ws + WS_MODP); const float* b_ada = A.in[3]; float* mod = (float*)(F.ws + WS_MOD);
    for (int i = F.tid; i < 4096; i += NWAVES * 64) { const int b = i >> 11, r = i & 2047; const int idx = b * 6144 + (r < 1024 ? sh_off + r : sc_off + r - 1024);
        const float v = FROM_PARTIALS ? mod_reduce(modp, b_ada, idx) : mod[idx];
        if (r < 1024) shs[b * 1024 + r] = v; else scs[b * 1024 + r - 1024] = v; }
    if (WITH_BD) { const float* w_in = A.in[5]; for (int i = F.tid; i < 8192; i += NWAVES * 64) wbd[i] = w_in[(size_t)(i >> 3) * INC + 2048 + (i & 7)]; }
    if (FROM_PARTIALS) for (int idx = blockIdx.x * (NWAVES * 64) + F.tid; idx < 12288; idx += F.G * NWAVES * 64) mod[idx] = mod_reduce(modp, b_ada, idx);
    __syncthreads();
    const int gw = F.vcu * NWAVES + F.wave, NGW = F.G * NWAVES, lane = F.lane;
    for (int row = gw; row < T; row += NGW) {
        const int b = row / S; const float* xr = src + (size_t)row * D;
        f32x4 v[4]; float ss = 0.f;
#pragma unroll
        for (int j = 0; j < 4; ++j) { v[j] = *(const f32x4*)(xr + j * 256 + lane * 4); ss += (v[j][0] * v[j][0] + v[j][1] * v[j][1]) + (v[j][2] * v[j][2] + v[j][3] * v[j][3]); }
        const float rs = rsqrtf(wave_sum(ss) * (1.f / D) + EPS);
        float bacc[8];
#pragma unroll
        for (int q = 0; q < 8; ++q) bacc[q] = 0.f;
#pragma unroll
        for (int j = 0; j < 4; ++j) { const int col = j * 256 + lane * 4; const f32x4 gn = *(const f32x4*)(gain + col);
            const f32x4 sh = *(const LAS f32x4*)(shs + b * 1024 + col), sc = *(const LAS f32x4*)(scs + b * 1024 + col);
            f32x4 hv = (v[j] * rs * gn) * (sc + 1.f) + sh;
            uint2 w; w.x = pk2(hv[0], hv[1]); w.y = pk2(hv[2], hv[3]);
            *(uint2*)(dst + (size_t)row * D + col) = w;
            if (WITH_BD) {
#pragma unroll
                for (int i = 0; i < 4; ++i) { const f32x4 w0 = *(const LAS f32x4*)(wbd + (col + i) * 8), w1 = *(const LAS f32x4*)(wbd + (col + i) * 8 + 4);
                    bacc[0] += hv[i] * w0[0]; bacc[1] += hv[i] * w0[1]; bacc[2] += hv[i] * w0[2]; bacc[3] += hv[i] * w0[3];
                    bacc[4] += hv[i] * w1[0]; bacc[5] += hv[i] * w1[1]; bacc[6] += hv[i] * w1[2]; bacc[7] += hv[i] * w1[3]; } } }
        if (WITH_BD) {
#pragma unroll
            for (int q = 0; q < 8; ++q) bacc[q] = wave_sum(bacc[q]);
            if (lane == 0) { float* bd = (float*)(F.ws + WS_BD) + (size_t)row * 8; *(f32x4*)bd = (f32x4){bacc[0], bacc[1], bacc[2], bacc[3]}; *(f32x4*)(bd + 4) = (f32x4){bacc[4], bacc[5], bacc[6], bacc[7]}; } }
    }
}
__device__ __forceinline__ void route_phase(Frame& F, const Args& A) {
    const float* logits = (const float*)(F.ws + WS_LOGITS); const float* rbias = A.in[22];
    int* top_idx = (int*)(F.ws + WS_TOPI); float* top_w = (float*)(F.ws + WS_TOPW);
    unsigned* ecnt = (unsigned*)(F.ws + WS_CTL) + CW_ECNT; int* lists = (int*)(F.ws + WS_LIST);
    const int gw = F.vcu * NWAVES + F.wave, NGW = F.G * NWAVES, lane = F.lane;
    const f32x4 rb = *(const f32x4*)(rbias + lane * 4);
    for (int t = gw; t < T; t += NGW) {
        float sc[4], ch[4];
        const f32x4 lg = *(const f32x4*)(logits + (size_t)t * 256 + lane * 4);
#pragma unroll
        for (int i = 0; i < 4; ++i) { sc[i] = 1.f / (1.f + __expf(-lg[i])); ch[i] = sc[i] + rb[i]; }
        float a1 = fmaxf(ch[0], ch[1]), a2 = fminf(ch[0], ch[1]);
        { const float b1 = fmaxf(ch[2], ch[3]), b2 = fminf(ch[2], ch[3]); const float m1 = fmaxf(a1, b1), m2 = fmaxf(fminf(a1, b1), fmaxf(a2, b2)); a1 = m1; a2 = m2; }
#pragma unroll
        for (int o = 1; o < 8; o <<= 1) { const float b1 = __shfl_xor(a1, o), b2 = __shfl_xor(a2, o); const float m1 = fmaxf(a1, b1), m2 = fmaxf(fminf(a1, b1), fmaxf(a2, b2)); a1 = m1; a2 = m2; }
        const float gs = a1 + a2; const int g = lane >> 3;
        int rank = 0;
#pragma unroll
        for (int gg = 0; gg < 8; ++gg) { const float o = __shfl(gs, gg * 8); rank += (o > gs || (o == gs && gg < g)) ? 1 : 0; }
        const bool sel = rank < 4;
        float mc[4];
#pragma unroll
        for (int i = 0; i < 4; ++i) mc[i] = sel ? ch[i] : -INFINITY;
        int my_idx = 0; float my_sc = 0.f, sum = 0.f;
#pragma unroll
        for (int r = 0; r < 8; ++r) {
            float bv = mc[0]; int bi = 0;
#pragma unroll
            for (int i = 1; i < 4; ++i) if (mc[i] > bv) { bv = mc[i]; bi = i; }
            int be = lane * 4 + bi;
#pragma unroll
            for (int o = 1; o < 64; o <<= 1) { const float ov = __shfl_xor(bv, o); const int oe = __shfl_xor(be, o); if (ov > bv || (ov == bv && oe < be)) { bv = ov; be = oe; } }
            float s = 0.f;
            if ((be >> 2) == lane) { const int b2 = be & 3;
                s = b2 == 0 ? sc[0] : b2 == 1 ? sc[1] : b2 == 2 ? sc[2] : sc[3];
                if (b2 == 0) mc[0] = -INFINITY; else if (b2 == 1) mc[1] = -INFINITY; else if (b2 == 2) mc[2] = -INFINITY; else mc[3] = -INFINITY; }
            s = __shfl(s, be >> 2);
            sum += s;
            if (lane == r) { my_idx = be; my_sc = s; }
        }
        if (lane < 8) { top_idx[t * 8 + lane] = my_idx; top_w[t * 8 + lane] = my_sc / sum * 2.5f;
            const unsigned slot = __hip_atomic_fetch_add(ecnt + my_idx, 1u, __ATOMIC_RELAXED, __HIP_MEMORY_SCOPE_AGENT);
            lists[(size_t)my_idx * T + slot] = t * 8 + lane; }
    }
}

typedef float f32x16 __attribute__((ext_vector_type(16)));
constexpr int XT = 256;
constexpr int XA_OFF = 0, XA_STAGE = 16384;
constexpr int XWP_OFF = 32768, XWP_WAVE = 2048;
constexpr int XYS_OFF = 49152, XYS_WAVE = 2560, XYS_STRIDE = 80;
constexpr int XCNT_OFF = XYS_OFF + 8 * XYS_WAVE;
static_assert(XCNT_OFF + 1024 <= CTRL_OFF, "MoE LDS map");
constexpr int CW_MQ = 1024;

struct WRegs { f32x4 v[4]; };
__device__ __forceinline__ void xw_load(WRegs& R, const float* wb, unsigned wo, int ldw, int k0) {
    const float* p = wb + (size_t)k0 * ldw + wo;
#pragma unroll
    for (int i = 0; i < 4; ++i) R.v[i] = *(const f32x4*)(p + (size_t)i * ldw);
}
__device__ __forceinline__ void xw_store(const WRegs& R, LAS unsigned char* wd) {
#pragma unroll
    for (int j = 0; j < 4; ++j) { u32x2 o; o.x = pg8::cvt_pk_bf16(R.v[0][j], R.v[1][j]); o.y = pg8::cvt_pk_bf16(R.v[2][j], R.v[3][j]); *(LAS u32x2*)(wd + j * 16) = o; }
}
template <int NS, int NP, class WOff, class Epi>
__device__ __forceinline__ void xpasses(Frame& F, f32x16 (&acc)[8], const unsigned char* ab0, unsigned o0, unsigned o1, const float* wb, int ldw, WOff wo, Epi epi,
                                        LAS unsigned char* wp, LAS unsigned char* wd, LAS unsigned char* ast, int rd_t0, int rd_t1, int rd_w) {
    LAS unsigned char* lds = F.lds;
    WRegs R[2]; v4u ra[2][2];
#pragma unroll
    for (int tt = 0; tt < 8; ++tt)
#pragma unroll
        for (int q = 0; q < 16; ++q) acc[tt][q] = 0.f;
    asm volatile("s_waitcnt vmcnt(0) lgkmcnt(0)" ::: "memory"); __builtin_amdgcn_s_barrier();
    { const unsigned w0 = wo(0);
      const v4u p0 = *(const v4u*)(ab0 + o0), p1 = *(const v4u*)(ab0 + o1);
      xw_load(R[0], wb, w0, ldw, 0); xw_load(R[1], wb, w0, ldw, 32);
      ra[1][0] = *(const v4u*)(ab0 + 64 + o0); ra[1][1] = *(const v4u*)(ab0 + 64 + o1);
      *(LAS v4u*)ast = p0; *(LAS v4u*)(ast + 1024) = p1; xw_store(R[0], wd); }
    asm volatile("s_waitcnt lgkmcnt(0)" ::: "memory"); __builtin_amdgcn_s_barrier();
#pragma unroll 1
    for (int p = 0; p < NP; ++p) {
        const unsigned wcur = wo(p), wnxt = wo(p + 1 < NP ? p + 1 : p);
#pragma unroll 1
        for (int s2 = 0; s2 < NS; s2 += 2) {
#pragma unroll
            for (int j = 0; j < 2; ++j) { const int s = s2 + j;
                {
                  const bool wrap = s + 2 >= NS; const bool last = p + 1 >= NP;
                  const int sl = wrap ? (last ? NS - 1 : s + 2 - NS) : s + 2;
                  xw_load(R[j], wb, wrap ? wnxt : wcur, ldw, sl * 32); const unsigned char* ap = ab0 + sl * 64; ra[j][0] = *(const v4u*)(ap + o0); ra[j][1] = *(const v4u*)(ap + o1); }
                const LAS unsigned char* ab = lds + XA_OFF + j * XA_STAGE;
#pragma unroll
                for (int ks = 0; ks < 2; ++ks) { const bf16x8 wf = *(const LAS bf16x8*)(wp + rd_w + ks * 1024);
                    bf16x8 tf[8];
#pragma unroll
                    for (int tt = 0; tt < 8; ++tt) tf[tt] = *(const LAS bf16x8*)(ab + (ks ? rd_t1 : rd_t0) + tt * 2048);
#pragma unroll
                    for (int tt = 0; tt < 8; ++tt) acc[tt] = __builtin_amdgcn_mfma_f32_32x32x16_bf16(wf, tf[tt], acc[tt], 0, 0, 0); }
                { asm volatile("s_waitcnt lgkmcnt(0)" ::: "memory"); xw_store(R[j ^ 1], wd);
                  LAS unsigned char* d = ast + (j ^ 1) * XA_STAGE; *(LAS v4u*)d = ra[j ^ 1][0]; *(LAS v4u*)(d + 1024) = ra[j ^ 1][1]; }
                asm volatile("s_waitcnt lgkmcnt(0)" ::: "memory"); __builtin_amdgcn_s_barrier();
            }
        }
        epi(p);
#pragma unroll
        for (int tt = 0; tt < 8; ++tt)
#pragma unroll
            for (int q = 0; q < 16; ++q) acc[tt][q] = 0.f;
    }
}

__device__ __forceinline__ void moe_item(Frame& F, const Args& A, int e, int rt, int total) {
    const int lane = F.lane, wave = F.wave, r31 = lane & 31, hi = lane >> 5;
    LAS unsigned char* lds = F.lds;
    const int* list = (const int*)(F.ws + WS_LIST) + (size_t)e * T;
    const float* top_w = (const float*)(F.ws + WS_TOPW);
    const unsigned char* hsrc = F.ws + WS_H; bf16_t* Y = (bf16_t*)(F.ws + WS_Y);
    unsigned char* xb = F.ws + WS_XA + (size_t)blockIdx.x * XA_BLOCK;
    const float* W1 = A.in[23] + (size_t)e * 1024 * 512; const float* W2 = A.in[24] + (size_t)e * 256 * 1024;
    const int r0 = rt * XT;
    LAS unsigned char* wp = lds + XWP_OFF + wave * XWP_WAVE;
    const int kgrp = lane >> 3;
    LAS unsigned char* wd = wp + ((kgrp >> 1) * 32 + 4 * (lane & 7)) * 16 + (kgrp & 1) * 8;
    const int rl0 = wave * 32 + (lane >> 2), rl1 = rl0 + 16;
    const unsigned sw0 = (unsigned)(((lane & 3) ^ ((rl0 >> 2) & 3)) * 16), sw1 = (unsigned)(((lane & 3) ^ ((rl1 >> 2) & 3)) * 16);
    unsigned g0, g1;
    { int ra_ = r0 + rl0; ra_ = ra_ < total ? ra_ : r0; int rb_ = r0 + rl1; rb_ = rb_ < total ? rb_ : r0;
      g0 = (unsigned)(list[ra_] >> 3) * 2048u + sw0; g1 = (unsigned)(list[rb_] >> 3) * 2048u + sw1; }
    LAS unsigned char* ast = lds + XA_OFF + wave * 2048 + lane * 16;
    const int rd_t0 = r31 * 64 + ((hi ^ ((r31 >> 2) & 3)) * 16), rd_t1 = r31 * 64 + (((2 + hi) ^ ((r31 >> 2) & 3)) * 16);
    const int rd_w = (hi * 32 + r31) * 16;
    f32x16 acc[8];
    xpasses<32, 2>(F, acc, hsrc, g0, g1, W1, 512,
        [&](int p) { return (unsigned)(((lane & 4) ? 256 + 128 * p + 16 * wave : 128 * p + 16 * wave) + 4 * (lane & 3) + (4 * kgrp) * 512); },
        [&](int p) {
            int ln = lane; asm volatile("" : "+v"(ln)); const int e31 = ln & 31, ehi = ln >> 5;
#pragma unroll
            for (int tt = 0; tt < 8; ++tt) { const int rl = 32 * tt + e31; const int r = r0 + rl; const float rw = r < total ? top_w[list[r]] : 0.f;
#pragma unroll
                for (int g = 0; g < 2; ++g) { float a[4];
#pragma unroll
                    for (int q = 0; q < 4; ++q) { const float gt = acc[tt][4 * g + q], up = acc[tt][8 + 4 * g + q]; a[q] = gt / (1.f + __expf(-gt)) * up * rw; }
                    u32x2 w; w.x = pg8::cvt_pk_bf16(a[0], a[1]); w.y = pg8::cvt_pk_bf16(a[2], a[3]);
                    *(u32x2*)(xb + (unsigned)(rl * 512 + (128 * p + 16 * wave + 8 * g + 4 * ehi) * 2)) = w; } } },
        wp, wd, ast, rd_t0, rd_t1, rd_w);
    const unsigned x0 = (unsigned)(rl0 * 512) + sw0, x1 = (unsigned)(rl1 * 512) + sw1;
    xpasses<8, 4>(F, acc, xb, x0, x1, W2, 1024,
        [&](int q4) { return (unsigned)(256 * q4 + 32 * wave + 4 * (lane & 7) + (4 * kgrp) * 1024); },
        [&](int q4) {
            const int col0 = 256 * q4 + 32 * wave;
            int ln = lane; asm volatile("" : "+v"(ln)); const int e31 = ln & 31, ehi = ln >> 5;
            LAS unsigned char* ys = lds + XYS_OFF + wave * XYS_WAVE;
#pragma unroll
            for (int tt = 0; tt < 8; ++tt) {
#pragma unroll
                for (int g = 0; g < 4; ++g) { u32x2 w; w.x = pg8::cvt_pk_bf16(acc[tt][4 * g], acc[tt][4 * g + 1]); w.y = pg8::cvt_pk_bf16(acc[tt][4 * g + 2], acc[tt][4 * g + 3]);
                    *(LAS u32x2*)(ys + e31 * XYS_STRIDE + (8 * g + 4 * ehi) * 2) = w; }
                asm volatile("s_waitcnt lgkmcnt(0)" ::: "memory");
#pragma unroll
                for (int pp = 0; pp < 2; ++pp) { const int rl = 16 * pp + (ln >> 2); const int r = r0 + 32 * tt + rl;
                    const v4u v = *(const LAS v4u*)(ys + rl * XYS_STRIDE + (ln & 3) * 16);
                    if (r < total) *(v4u*)(Y + (size_t)list[r] * 1024 + col0 + (ln & 3) * 8) = v; }
                asm volatile("s_waitcnt lgkmcnt(0)" ::: "memory");
            } },
        wp, wd, ast, rd_t0, rd_t1, rd_w);
}

__device__ __forceinline__ void moe_phase(Frame& F, const Args& A, int rep = 0) {
    LAS int* cnts = (LAS int*)(F.lds + XCNT_OFF);
    const unsigned* ecnt = (const unsigned*)(F.ws + WS_CTL) + CW_ECNT;
    unsigned* mq = (unsigned*)(F.ws + WS_CTL) + CW_MQ + 1024 * rep;
    volatile LAS int* slot = (volatile LAS int*)(F.lds + CTRL_OFF + 64);
    if (F.tid < 256) cnts[F.tid] = (int)ecnt[F.tid];
    __syncthreads();
    const int x0 = (int)(xb_xcc_id() & 7u);
    for (int xi = 0; xi < 8; ++xi) {
        const int x = (x0 + xi) & 7;
        int ntiles = 0;
#pragma unroll 1
        for (int i = 0; i < 32; ++i) ntiles += (cnts[x + 8 * i] + XT - 1) / XT;
        for (;;) {
            __syncthreads();
            if (F.tid == 0) slot[0] = (int)__hip_atomic_fetch_add(mq + 64 * x, 1u, __ATOMIC_RELAXED, __HIP_MEMORY_SCOPE_AGENT);
            __syncthreads();
            int k = slot[0];
            if (k >= ntiles) break;
            int e = x, tot = 0;
#pragma unroll 1
            for (int i = 0; i < 32; ++i) { const int c = cnts[x + 8 * i], t = (c + XT - 1) / XT; if (k < t) { e = x + 8 * i; tot = c; break; } k -= t; }
            moe_item(F, A, __builtin_amdgcn_readfirstlane(e), __builtin_amdgcn_readfirstlane(k), __builtin_amdgcn_readfirstlane(tot));
        }
    }
}
__device__ __forceinline__ void attn_prep_phase(Frame& F, const Args& A) {
    const bf16_t* P = (const bf16_t*)(F.ws + WS_P); bf16_t* QN = (bf16_t*)(F.ws + WS_QN); bf16_t* KN = (bf16_t*)(F.ws + WS_KN);
    const float* qg = A.in[11]; const float* kg = A.in[12];
    const int gw = F.vcu * NWAVES + F.wave, NGW = F.G * NWAVES, lane = F.lane;
    f32x4 gq0 = *(const f32x4*)(qg + (lane & 7) * 8), gq1 = *(const f32x4*)(qg + (lane & 7) * 8 + 4);
    f32x4 gk0 = *(const f32x4*)(kg + (lane & 7) * 8), gk1 = *(const f32x4*)(kg + (lane & 7) * 8 + 4);
    for (int t = gw; t < T; t += NGW) {
#pragma unroll
        for (int which = 0; which < 2; ++which) {
            const v4u w = *(const v4u*)(P + (size_t)t * LDP + (which ? C_KB : C_QB) + lane * 8);
            float v[8] = {pg8::bflo(w.x), pg8::bfhi(w.x), pg8::bflo(w.y), pg8::bfhi(w.y), pg8::bflo(w.z), pg8::bfhi(w.z), pg8::bflo(w.w), pg8::bfhi(w.w)};
            float ss = 0.f;
#pragma unroll
            for (int i = 0; i < 8; ++i) ss += v[i] * v[i];
            ss += __shfl_xor(ss, 1); ss += __shfl_xor(ss, 2); ss += __shfl_xor(ss, 4);
            const float r = rsqrtf(ss * (1.f / 64.f) + EPS) * (which ? 1.f : 0.125f * 1.4426950408889634f);
            const f32x4 g0 = which ? gk0 : gq0, g1 = which ? gk1 : gq1;
            v4u o; o.x = pk2(v[0] * r * g0[0], v[1] * r * g0[1]); o.y = pk2(v[2] * r * g0[2], v[3] * r * g0[3]); o.z = pk2(v[4] * r * g1[0], v[5] * r * g1[1]); o.w = pk2(v[6] * r * g1[2], v[7] * r * g1[3]);
            *(v4u*)((which ? KN : QN) + (size_t)t * 512 + lane * 8) = o;
        }
    }
}

typedef short s16x4 __attribute__((ext_vector_type(4)));
constexpr int AT_KPLANE = 1040;
constexpr int AT_KBYTES = 8 * AT_KPLANE;
constexpr int AT_VROW = 320;
constexpr int AT_VBYTES = 64 * AT_VROW;
constexpr int AT_BUF = AT_KBYTES + AT_VBYTES;
template <int OFF> __device__ __forceinline__ s16x4 tr_read(int vb) {
    s16x4 r; asm volatile("ds_read_b64_tr_b16 %0, %1 offset:%2" : "=&v"(r) : "v"(vb), "i"(OFF) : "memory"); return r;
}
template <int ND> __device__ __forceinline__ void pv_one(f32x16& od, int vb, const bf16x8 (&pf)[4]) {
#define VOFF(mt, s, half) (AT_KBYTES + (32 * (mt) + 16 * (s) + 8 * (half)) * AT_VROW + ND * 64)
    const s16x4 a0 = tr_read<VOFF(0, 0, 0)>(vb), b0 = tr_read<VOFF(0, 0, 1)>(vb), a1 = tr_read<VOFF(0, 1, 0)>(vb), b1 = tr_read<VOFF(0, 1, 1)>(vb);
    const s16x4 a2 = tr_read<VOFF(1, 0, 0)>(vb), b2 = tr_read<VOFF(1, 0, 1)>(vb), a3 = tr_read<VOFF(1, 1, 0)>(vb), b3 = tr_read<VOFF(1, 1, 1)>(vb);
#undef VOFF
    asm volatile("s_waitcnt lgkmcnt(0)" ::: "memory"); __builtin_amdgcn_sched_barrier(0);
#define PK(L, H) (bf16x8){L[0], L[1], L[2], L[3], H[0], H[1], H[2], H[3]}
    od = __builtin_amdgcn_mfma_f32_32x32x16_bf16(PK(a0, b0), pf[0], od, 0, 0, 0);
    od = __builtin_amdgcn_mfma_f32_32x32x16_bf16(PK(a1, b1), pf[1], od, 0, 0, 0);
    od = __builtin_amdgcn_mfma_f32_32x32x16_bf16(PK(a2, b2), pf[2], od, 0, 0, 0);
    od = __builtin_amdgcn_mfma_f32_32x32x16_bf16(PK(a3, b3), pf[3], od, 0, 0, 0);
#undef PK
}
__device__ __forceinline__ void attn_unit(Frame& F, int b, int h, int c, int qb) {
    const int tid = F.tid, lane = F.lane, wave = F.wave, r32 = lane & 31, hi = lane >> 5;
    LAS unsigned char* lds = F.lds;
    const bf16_t* QN = (const bf16_t*)(F.ws + WS_QN); const bf16_t* KN = (const bf16_t*)(F.ws + WS_KN); const bf16_t* P = (const bf16_t*)(F.ws + WS_P);
    const float sl2 = exp2f(-2.f * (float)(h + 1)) * 1.4426950408889634f;
    const float M2 = ((const float*)(F.ws + WS_SCAL))[1];
    const int tq = qb * 256 + wave * 32 + r32;
    const int ctw = 4 * qb + (wave >> 1), ntiles = 4 * qb + 4;
    const float dmax = (2.f * M2 + 40.f) / sl2 + 63.f;
    int tile_lo = (int)ceilf(((float)(qb * 256 - 63) - dmax) * (1.f / 64.f)); tile_lo = tile_lo < 0 ? 0 : tile_lo;
    tile_lo = __builtin_amdgcn_readfirstlane(tile_lo);
    bf16x8 qf[4];
    { const bf16_t* qp = QN + (size_t)(b * S + tq) * 512 + h * 128 + c * 64 + hi * 8;
#pragma unroll
      for (int ks = 0; ks < 4; ++ks) qf[ks] = *(const bf16x8*)(qp + 16 * ks); }
    float koffs[16];
#pragma unroll
    for (int r = 0; r < 16; ++r) koffs[r] = sl2 * (float)((r & 3) + 8 * (r >> 2) + 4 * hi);
    f32x16 oacc[4];
#pragma unroll
    for (int nd = 0; nd < 4; ++nd)
#pragma unroll
        for (int r = 0; r < 16; ++r) oacc[nd][r] = 0.f;
    float lsum = 0.f;
    const int s_key = tid >> 3, s_kg = tid & 7;
    const bf16_t* kg_src = KN + (size_t)(b * S + s_key) * 512 + h * 128 + c * 64 + s_kg * 8;
    const bf16_t* vg_src = P + (size_t)(b * S + s_key) * LDP + C_VB + h * 128 + s_kg * 8;
    const int st_k = s_kg * AT_KPLANE + s_key * 16, st_v = AT_KBYTES + s_key * AT_VROW + s_kg * 16;
    const int rd_k = hi * AT_KPLANE + r32 * 16;
    const int rd_v = (hi * 4 + ((lane & 15) >> 2)) * AT_VROW + ((lane >> 4) & 1) * 32 + (lane & 3) * 8;
    v4u rk, rv0, rv1;
    auto gload = [&](int tile) { rk = *(const v4u*)(kg_src + (size_t)tile * 64 * 512); const bf16_t* vp = vg_src + (size_t)tile * 64 * LDP; rv0 = *(const v4u*)vp; rv1 = *(const v4u*)(vp + 64); };
    auto lstore = [&](int buf) { LAS unsigned char* bb = lds + buf * AT_BUF; *(LAS v4u*)(bb + st_k) = rk; *(LAS v4u*)(bb + st_v) = rv0; *(LAS v4u*)(bb + st_v + 128) = rv1; };
    __syncthreads();
    gload(tile_lo); lstore(tile_lo & 1); __syncthreads();
    for (int tile = tile_lo; tile < ntiles; ++tile) {
        gload(tile + 1 < ntiles ? tile + 1 : tile);
        if (tile <= ctw) {
            const LAS unsigned char* kb = lds + (tile & 1) * AT_BUF;
            f32x16 sacc[2];
            if (tile != ctw) {
                const float ct = sl2 * (float)(64 * tile - tq) - M2;
#pragma unroll
                for (int mt = 0; mt < 2; ++mt)
#pragma unroll
                    for (int r = 0; r < 16; ++r) sacc[mt][r] = koffs[r] + (ct + sl2 * 32.f * mt);
            } else {
                const float base = sl2 * (float)(64 * tile - tq);
#pragma unroll
                for (int mt = 0; mt < 2; ++mt)
#pragma unroll
                    for (int r = 0; r < 16; ++r) sacc[mt][r] = -fabsf(koffs[r] + (base + sl2 * 32.f * mt)) - M2;
            }
#pragma unroll
            for (int ks = 0; ks < 4; ++ks)
#pragma unroll
                for (int mt = 0; mt < 2; ++mt) { const bf16x8 kf = *(const LAS bf16x8*)(kb + rd_k + ks * 2 * AT_KPLANE + mt * 512);
                    sacc[mt] = __builtin_amdgcn_mfma_f32_32x32x16_bf16(kf, qf[ks], sacc[mt], 0, 0, 0); }
            bf16x8 pf[4];
#pragma unroll
            for (int mt = 0; mt < 2; ++mt) {
#pragma unroll
                for (int r = 0; r < 16; ++r) { const float p = __builtin_amdgcn_exp2f(sacc[mt][r]); lsum += p; sacc[mt][r] = p; }
#pragma unroll
                for (int s = 0; s < 2; ++s) { v4u w;
                    w.x = pg8::cvt_pk_bf16(sacc[mt][8 * s + 0], sacc[mt][8 * s + 1]); w.y = pg8::cvt_pk_bf16(sacc[mt][8 * s + 2], sacc[mt][8 * s + 3]);
                    w.z = pg8::cvt_pk_bf16(sacc[mt][8 * s + 4], sacc[mt][8 * s + 5]); w.w = pg8::cvt_pk_bf16(sacc[mt][8 * s + 6], sacc[mt][8 * s + 7]);
                    pf[mt * 2 + s] = __builtin_bit_cast(bf16x8, w); }
            }
            const int vb = (int)(uintptr_t)kb + rd_v;
            pv_one<0>(oacc[0], vb, pf); pv_one<1>(oacc[1], vb, pf); pv_one<2>(oacc[2], vb, pf); pv_one<3>(oacc[3], vb, pf);
        }
        lstore((tile + 1) & 1);
        __syncthreads();
    }
    lsum += __shfl_xor(lsum, 32);
    const float inv = 1.f / lsum;
    bf16_t* ob = (bf16_t*)(F.ws + WS_OB) + (size_t)c * T * 512 + (size_t)(b * S + tq) * 512 + h * 128 + 4 * hi;
#pragma unroll
    for (int nd = 0; nd < 4; ++nd)
#pragma unroll
        for (int g = 0; g < 4; ++g) { uint2 w; w.x = pk2(oacc[nd][4 * g] * inv, oacc[nd][4 * g + 1] * inv); w.y = pk2(oacc[nd][4 * g + 2] * inv, oacc[nd][4 * g + 3] * inv);
            *(uint2*)(ob + 32 * nd + 8 * g) = w; }
}
__device__ __forceinline__ void post_norm_phase(Frame& F, const Args& A) {
    const float* oa = (const float*)(F.ws + WS_OA); const bf16_t* ob = (const bf16_t*)(F.ws + WS_OB); const bf16_t* P = (const bf16_t*)(F.ws + WS_P);
    bf16_t* oan = (bf16_t*)(F.ws + WS_OAN); bf16_t* obn = (bf16_t*)(F.ws + WS_OBN);
    const float* gg = A.in[9]; const float* sg = A.in[17];
    const float lam = ((const float*)(F.ws + WS_SCAL))[0];
    const int gw = F.vcu * NWAVES + F.wave, NGW = F.G * NWAVES, lane = F.lane;
    const int gc = (lane & 15) * 8;
    const f32x4 g0 = *(const f32x4*)(gg + gc), g1 = *(const f32x4*)(gg + gc + 4), s0 = *(const f32x4*)(sg + gc), s1 = *(const f32x4*)(sg + gc + 4);
    for (int t = gw; t < T; t += NGW) {
        { const f32x4 a0 = *(const f32x4*)(oa + (size_t)t * 512 + lane * 8), a1 = *(const f32x4*)(oa + (size_t)t * 512 + lane * 8 + 4);
          float ss = (a0[0] * a0[0] + a0[1] * a0[1]) + (a0[2] * a0[2] + a0[3] * a0[3]) + (a1[0] * a1[0] + a1[1] * a1[1]) + (a1[2] * a1[2] + a1[3] * a1[3]);
          ss += __shfl_xor(ss, 1); ss += __shfl_xor(ss, 2); ss += __shfl_xor(ss, 4); ss += __shfl_xor(ss, 8);
          const float r = rsqrtf(ss * (1.f / 128.f) + EPS);
          const v4u zw = *(const v4u*)(P + (size_t)t * LDP + C_ZA + lane * 8);
          const float z[8] = {pg8::bflo(zw.x), pg8::bfhi(zw.x), pg8::bflo(zw.y), pg8::bfhi(zw.y), pg8::bflo(zw.z), pg8::bfhi(zw.z), pg8::bflo(zw.w), pg8::bfhi(zw.w)};
          float o[8];
#pragma unroll
          for (int i = 0; i < 4; ++i) { o[i] = a0[i] * r * g0[i] * siluf(z[i]); o[4 + i] = a1[i] * r * g1[i] * siluf(z[4 + i]); }
          v4u w; w.x = pk2(o[0], o[1]); w.y = pk2(o[2], o[3]); w.z = pk2(o[4], o[5]); w.w = pk2(o[6], o[7]);
          *(v4u*)(oan + (size_t)t * 512 + lane * 8) = w; }
        { const v4u w1 = *(const v4u*)(ob + (size_t)t * 512 + lane * 8), w2 = *(const v4u*)(ob + (size_t)T * 512 + (size_t)t * 512 + lane * 8);
          float d[8] = {pg8::bflo(w1.x) - lam * pg8::bflo(w2.x), pg8::bfhi(w1.x) - lam * pg8::bfhi(w2.x), pg8::bflo(w1.y) - lam * pg8::bflo(w2.y), pg8::bfhi(w1.y) - lam * pg8::bfhi(w2.y),
                        pg8::bflo(w1.z) - lam * pg8::bflo(w2.z), pg8::bfhi(w1.z) - lam * pg8::bfhi(w2.z), pg8::bflo(w1.w) - lam * pg8::bflo(w2.w), pg8::bfhi(w1.w) - lam * pg8::bfhi(w2.w)};
          float ss = 0.f;
#pragma unroll
          for (int i = 0; i < 8; ++i) ss += d[i] * d[i];
          ss += __shfl_xor(ss, 1); ss += __shfl_xor(ss, 2); ss += __shfl_xor(ss, 4); ss += __shfl_xor(ss, 8);
          const float r = rsqrtf(ss * (1.f / 128.f) + EPS) * (1.f - LAM_INIT);
          v4u w; w.x = pk2(d[0] * r * s0[0], d[1] * r * s0[1]); w.y = pk2(d[2] * r * s0[2], d[3] * r * s0[3]); w.z = pk2(d[4] * r * s1[0], d[5] * r * s1[1]); w.w = pk2(d[6] * r * s1[2], d[7] * r * s1[3]);
          *(v4u*)(obn + (size_t)t * 512 + lane * 8) = w; }
    }
}
constexpr int GD_KA = 0, GD_QA = 17408, GD_VN = 34816, GD_KB = 55296, GD_LM = 75776, GD_T1 = 93184, GD_T2 = 102400, GD_SC = 111616;
constexpr int GD_AQ = 114688;
constexpr int GD_SA = 272, GD_SB = 320, GD_SL = 272, GD_ST = 144;
constexpr size_t GDN_WF = 0, GDN_QF = 16384, GDN_AF = 32768, GDN_KF = 40960, GDN_UF = 57344, GDN_EG = 90112, GDN_ITEM = 90368;
__device__ __forceinline__ int perm16_h(int n) { return (n >> 2) & 1; }
__device__ __forceinline__ int perm16_j(int n) { return (n & 3) + 4 * (n >> 3); }

__device__ __forceinline__ void gdn_prep_item(Frame& F, const Args& A, int item) {
    const int tid = F.tid, lane = F.lane, wave = F.wave, r32 = lane & 31, hi = lane >> 5;
    LAS unsigned char* lds = F.lds;
    const int b = item >> 9, h = (item >> 7) & 3, n = item & 127;
    const int t0 = b * S + n * 64;
    const bf16_t* P = (const bf16_t*)(F.ws + WS_P); const float* bd = (const float*)(F.ws + WS_BD);
    unsigned char* gi = F.ws + WS_GDN + (size_t)item * GDN_ITEM;
    LAS float* sc_g = (LAS float*)(lds + GD_SC);
    LAS float* sc_b = sc_g + 64;
    LAS float* sc_e = sc_g + 128;
    LAS float* sc_l = sc_g + 192;
#ifndef NO_S1
    if (tid < 128) *((LAS float*)(lds + GD_SC + 1024) + tid) = (tid == 63) ? 1.f : 0.f;
    {
        const float* cw = A.in[6];
        float w[3][4][2];
#pragma unroll
        for (int p = 0; p < 3; ++p)
#pragma unroll
            for (int j = 0; j < 4; ++j) { const float2 t = *(const float2*)(cw + j * 1536 + p * 512 + h * 128 + 2 * lane); w[p][j][0] = t.x; w[p][j][1] = t.y; }
        const int rl0 = n * 64 + wave * 8;
#pragma unroll
        for (int p = 0; p < 3; ++p) {
            float x[11][2];
#pragma unroll
            for (int i = 0; i < 11; ++i) { const int tl = rl0 - 3 + i; unsigned u = 0u;
                if (tl >= 0) u = *(const unsigned*)(P + (size_t)(b * S + tl) * LDP + p * 512 + h * 128 + 2 * lane);
                x[i][0] = pg8::bflo(u); x[i][1] = pg8::bfhi(u); }
#pragma unroll
            for (int r = 0; r < 8; ++r) {
                float a0 = 0.f, a1 = 0.f;
#pragma unroll
                for (int j = 0; j < 4; ++j) { a0 += x[r + j][0] * w[p][j][0]; a1 += x[r + j][1] * w[p][j][1]; }
                a0 = siluf(a0); a1 = siluf(a1);
                const int row = wave * 8 + r;
                if (p < 2) { const float ss = wave_sum(a0 * a0 + a1 * a1); const float rs = rsqrtf(ss + EPS) * (p == 0 ? 0.08838834764831845f : 1.f); a0 *= rs; a1 *= rs; }
                const unsigned pk = pk2(a0, a1);
                if (p == 0) *(LAS unsigned*)(lds + GD_QA + row * GD_SA + lane * 4) = pk;
                else if (p == 1) { *(LAS unsigned*)(lds + GD_KA + row * GD_SA + lane * 4) = pk; *(LAS unsigned*)(lds + GD_KB + row * GD_SB + lane * 4) = pk; }
                else *(LAS unsigned*)(lds + GD_VN + row * GD_SB + lane * 4) = pk;
            }
        }
        if (wave == 0) {
            const float bl = bd[(size_t)(t0 + lane) * 8 + h], dl = bd[(size_t)(t0 + lane) * 8 + 4 + h];
            const float beta = 1.f / (1.f + __expf(-bl));
            float g = -expf(A.in[7][h]) * softplusf(dl + A.in[8][h]);
#pragma unroll
            for (int o = 1; o < 64; o <<= 1) { const float up = __shfl_up(g, o); if (lane >= o) g += up; }
            const float glast = __shfl(g, 63);
            sc_g[lane] = g; sc_b[lane] = beta; sc_e[lane] = __expf(g); sc_l[lane] = __expf(glast - g);
            if (lane == 0) *(float*)(gi + GDN_EG) = __expf(glast);
        }
    }
#endif
    __syncthreads();
#ifndef NO_S2
    {
        const int which = wave >> 2, ti = (wave >> 1) & 1, tj = wave & 1;
        f32x16 acc;
#pragma unroll
        for (int r = 0; r < 16; ++r) acc[r] = 0.f;
        if (ti >= tj) {
            const LAS unsigned char* ap = lds + (which ? GD_QA : GD_KA) + (32 * ti + r32) * GD_SA + hi * 16;
            const LAS unsigned char* bp = lds + GD_KA + (32 * tj + r32) * GD_SA + hi * 16;
#pragma unroll
            for (int ks = 0; ks < 8; ++ks) acc = __builtin_amdgcn_mfma_f32_32x32x16_bf16(*(const LAS bf16x8*)(ap + ks * 32), *(const LAS bf16x8*)(bp + ks * 32), acc, 0, 0, 0);
        }
        const int j = 32 * tj + r32; const float Gj = sc_g[j];
        const int ibase = 32 * ti + 4 * hi, dij = ibase - j;
        const LAS float* gp = sc_g + ibase; const LAS float* bp2 = sc_b + ibase;
        if (which == 0) {
            LAS float* lm = (LAS float*)(lds + GD_LM + ibase * GD_SL + j * 4);
#pragma unroll
            for (int r = 0; r < 16; ++r) { const int off = (r & 3) + 8 * (r >> 2);
                const float v = (off + dij > 0) ? bp2[off] * acc[r] * __expf(fminf(gp[off] - Gj, 0.f)) : 0.f;
                lm[off * (GD_SL / 4)] = v; }
        } else {
            LAS bf16_t* aq = (LAS bf16_t*)(lds + GD_AQ) + ibase * 72 + j;
#pragma unroll
            for (int r = 0; r < 16; ++r) { const int off = (r & 3) + 8 * (r >> 2);
                const float v = (off + dij >= 0) ? acc[r] * __expf(fminf(gp[off] - Gj, 0.f)) : 0.f;
                aq[off * 72] = (bf16_t)f2bf(v); }
        }
    }
#endif
    __syncthreads();
#ifndef NO_S3
    if (wave == 0) {
        int ln = lane; asm volatile("" : "+v"(ln));
        LAS unsigned char* lmb = lds + GD_LM; asm volatile("" : "+v"(lmb));
        const LAS float* zz = (const LAS float*)(lds + GD_SC + 1024) + ln;
        float t[64];
#pragma unroll
        for (int i = 0; i < 64; ++i) {
            float s = zz[63 - i];
            const LAS float* Li = (const LAS float*)(lmb + i * GD_SL);
            float s1 = 0.f, s2 = 0.f, s3 = 0.f;
#pragma unroll
            for (int j4 = 0; j4 < (i + 3) / 4; ++j4) { const f32x4 l4 = *(const LAS f32x4*)(Li + 4 * j4);
                if (4 * j4 + 0 < i) s -= l4[0] * t[4 * j4 + 0];
                if (4 * j4 + 1 < i) s1 -= l4[1] * t[4 * j4 + 1];
                if (4 * j4 + 2 < i) s2 -= l4[2] * t[4 * j4 + 2];
                if (4 * j4 + 3 < i) s3 -= l4[3] * t[4 * j4 + 3]; }
            s = (s + s1) + (s2 + s3);
            t[i] = s;
            __builtin_amdgcn_sched_barrier(0);
        }
        const float bc = sc_b[lane], bec = bc * sc_e[lane];
#pragma unroll
        for (int i = 0; i < 64; ++i) { *(LAS bf16_t*)(lds + GD_T1 + i * GD_ST + lane * 2) = (bf16_t)f2bf(t[i] * bc); *(LAS bf16_t*)(lds + GD_T2 + i * GD_ST + lane * 2) = (bf16_t)f2bf(t[i] * bec); }
    } else {
        for (int cidx = tid - 64; cidx < 2560; cidx += 448) {
            if (cidx >= 2048) {
                const int cc = cidx - 2048, mt = cc >> 8, ks = (cc >> 6) & 3, lp = cc & 63, hp = lp >> 5, rr = lp & 31;
                const LAS unsigned char* ap = lds + GD_AQ + (32 * mt + rr) * 144 + (16 * ks + 4 * hp) * 2;
                const u32x2 lo = *(const LAS u32x2*)ap, hi2 = *(const LAS u32x2*)(ap + 16);
                *(v4u*)(gi + GDN_AF + (size_t)cc * 16) = (v4u){lo.x, lo.y, hi2.x, hi2.y};
                continue; }
            const bool isK = cidx >= 1024; const int cc = cidx & 1023; const int lp = cc & 63, hp = lp >> 5, rr = lp & 31;
            unsigned wds[4];
            if (!isK) { const int mt = cc >> 9, ks = (cc >> 6) & 7; const int i = 32 * mt + rr; const float e = sc_e[i];
#pragma unroll
                for (int q = 0; q < 4; ++q) { const int j0 = 2 * q, j1 = 2 * q + 1;
                    const int d0 = 16 * ks + 8 * (j0 >> 2) + 4 * hp + (j0 & 3), d1 = 16 * ks + 8 * (j1 >> 2) + 4 * hp + (j1 & 3);
                    wds[q] = pk2(bf2f(*(const LAS bf16_t*)(lds + GD_QA + i * GD_SA + d0 * 2)) * e, bf2f(*(const LAS bf16_t*)(lds + GD_QA + i * GD_SA + d1 * 2)) * e); }
                *(v4u*)(gi + GDN_QF + (size_t)cc * 16) = (v4u){wds[0], wds[1], wds[2], wds[3]};
            } else { const int dt = cc >> 8, ks = (cc >> 6) & 3; const int dk = 32 * dt + rr;
#pragma unroll
                for (int q = 0; q < 4; ++q) { const int j0 = 2 * q, j1 = 2 * q + 1;
                    const int k0 = 16 * ks + 8 * (j0 >> 2) + 4 * hp + (j0 & 3), k1 = 16 * ks + 8 * (j1 >> 2) + 4 * hp + (j1 & 3);
                    wds[q] = pk2(bf2f(*(const LAS bf16_t*)(lds + GD_KA + k0 * GD_SA + dk * 2)) * sc_l[k0], bf2f(*(const LAS bf16_t*)(lds + GD_KA + k1 * GD_SA + dk * 2)) * sc_l[k1]); }
                *(v4u*)(gi + GDN_KF + (size_t)cc * 16) = (v4u){wds[0], wds[1], wds[2], wds[3]};
            }
        }
    }
#endif
    __syncthreads();
#ifndef NO_S4
    {
        const int mt = wave >> 2, nt = wave & 3;
        const int trb = (hi * 8 + ((lane & 15) >> 2)) * GD_SB + (32 * nt + ((lane >> 4) & 1) * 16 + (lane & 3) * 4) * 2;
#pragma unroll
        for (int which = 0; which < 2; ++which) {
            f32x16 acc;
#pragma unroll
            for (int r = 0; r < 16; ++r) acc[r] = 0.f;
            const LAS unsigned char* tp = lds + (which ? GD_T2 : GD_T1) + (32 * mt + r32) * GD_ST + hi * 16;
            const int vb = (int)(uintptr_t)(lds + (which ? GD_KB : GD_VN)) + trb;
            s16x4 lo[4], hh[4];
            lo[0] = tr_read<0 * 16 * GD_SB>(vb); hh[0] = tr_read<0 * 16 * GD_SB + 4 * GD_SB>(vb); lo[1] = tr_read<1 * 16 * GD_SB>(vb); hh[1] = tr_read<1 * 16 * GD_SB + 4 * GD_SB>(vb);
            lo[2] = tr_read<2 * 16 * GD_SB>(vb); hh[2] = tr_read<2 * 16 * GD_SB + 4 * GD_SB>(vb); lo[3] = tr_read<3 * 16 * GD_SB>(vb); hh[3] = tr_read<3 * 16 * GD_SB + 4 * GD_SB>(vb);
            asm volatile("s_waitcnt lgkmcnt(0)" ::: "memory"); __builtin_amdgcn_sched_barrier(0);
#pragma unroll
            for (int ks = 0; ks < 4; ++ks) { const bf16x8 bfr = (bf16x8){lo[ks][0], lo[ks][1], lo[ks][2], lo[ks][3], hh[ks][0], hh[ks][1], hh[ks][2], hh[ks][3]};
                acc = __builtin_amdgcn_mfma_f32_32x32x16_bf16(*(const LAS bf16x8*)(tp + ks * 32), bfr, acc, 0, 0, 0); }
            if (which == 0) {
                float* uf = (float*)(gi + GDN_UF) + (size_t)nt * 2048 + (32 * mt + 4 * hi) * 32 + r32;
#pragma unroll
                for (int r = 0; r < 16; ++r) uf[((r & 3) + 8 * (r >> 2)) * 32] = acc[r];
            } else {
                LAS bf16_t* wq = (LAS bf16_t*)(lds + GD_QA + (32 * mt + 4 * hi) * GD_SA) + 32 * nt + r32;
#pragma unroll
                for (int r = 0; r < 16; ++r) wq[((r & 3) + 8 * (r >> 2)) * (GD_SA / 2)] = (bf16_t)f2bf(acc[r]);
            }
        }
    }
    __syncthreads();
    for (int cc = tid; cc < 1024; cc += NWAVES * 64) { const int mt = cc >> 9, ks = (cc >> 6) & 7, lp = cc & 63, hp = lp >> 5, rr = lp & 31;
        const LAS unsigned char* wq = lds + GD_QA + (32 * mt + rr) * GD_SA + (16 * ks + 4 * hp) * 2;
        const u32x2 lo = *(const LAS u32x2*)wq, hi2 = *(const LAS u32x2*)(wq + 16);
        *(v4u*)(gi + GDN_WF + (size_t)cc * 16) = (v4u){lo.x, lo.y, hi2.x, hi2.y}; }
#endif
    __syncthreads();
}
__device__ __forceinline__ void gdn_prep_phase(Frame& F, const Args& A) {
    for (int item = blockIdx.x; item < 1024; item += F.G) gdn_prep_item(F, A, item);
}

__device__ __forceinline__ bf16x8 pack8(const f32x16& a, int s) {
    v4u w; w.x = pg8::cvt_pk_bf16(a[8 * s + 0], a[8 * s + 1]); w.y = pg8::cvt_pk_bf16(a[8 * s + 2], a[8 * s + 3]); w.z = pg8::cvt_pk_bf16(a[8 * s + 4], a[8 * s + 5]); w.w = pg8::cvt_pk_bf16(a[8 * s + 6], a[8 * s + 7]);
    return __builtin_bit_cast(bf16x8, w);
}
constexpr int SC_STAGE = 65536;
__device__ __forceinline__ void gdn_scan_block(Frame& F, int task) {
    const int lane = F.lane, wave = F.wave, r32 = lane & 31, hi = lane >> 5;
    const int bh = task >> 2, sl = task & 3, b = bh >> 2, h = bh & 3;
    LAS unsigned char* lds = F.lds;
    float* oa = (float*)(F.ws + WS_OA);
    const unsigned char* g0 = F.ws + WS_GDN + (size_t)(bh * 128) * GDN_ITEM;
    auto issue = [&](int n) {
        const unsigned char* gi = g0 + (size_t)n * GDN_ITEM; LAS unsigned char* st = lds + (n & 1) * SC_STAGE;
        for (int p = wave - 1; p < 64; p += 7) {
            const unsigned char* src = (p < 56) ? gi + p * 1024 : gi + GDN_UF + (size_t)sl * 8192 + (p - 56) * 1024;
            __builtin_amdgcn_global_load_lds((const unsigned*)(src + lane * 16), (LAS unsigned*)(st + p * 1024), 16, 0, 0);
        }
    };
    f32x16 st4[4];
#pragma unroll
    for (int dt = 0; dt < 4; ++dt)
#pragma unroll
        for (int r = 0; r < 16; ++r) st4[dt][r] = 0.f;
    __syncthreads();
    if (wave != 0) issue(0);
    __syncthreads();
    for (int n = 0; n < 128; ++n) {
        if (wave != 0) { if (n + 1 < 128) issue(n + 1); }
        else {
            const LAS unsigned char* sg = lds + (n & 1) * SC_STAGE;
            const LAS bf16x8* wf = (const LAS bf16x8*)(sg + GDN_WF) + lane; const LAS bf16x8* qf = (const LAS bf16x8*)(sg + GDN_QF) + lane;
            const LAS bf16x8* af = (const LAS bf16x8*)(sg + GDN_AF) + lane; const LAS bf16x8* kf = (const LAS bf16x8*)(sg + GDN_KF) + lane;
            const LAS float* ufl = (const LAS float*)(sg + 57344) + 4 * hi * 32 + r32;
            const float egl = *(const float*)(g0 + (size_t)n * GDN_ITEM + GDN_EG);
            float* oap = oa + (size_t)(b * S + n * 64 + 4 * hi) * 512 + h * 128 + sl * 32 + r32;
            bf16x8 sb[8];
#pragma unroll
            for (int dt = 0; dt < 4; ++dt) { sb[2 * dt] = pack8(st4[dt], 0); sb[2 * dt + 1] = pack8(st4[dt], 1); }
            f32x16 vn[2], oc[2];
#pragma unroll
            for (int mt = 0; mt < 2; ++mt) {
                f32x16 ws_;
#pragma unroll
                for (int r = 0; r < 16; ++r) { ws_[r] = 0.f; oc[mt][r] = 0.f; }
#pragma unroll
                for (int ks = 0; ks < 8; ++ks) { ws_ = __builtin_amdgcn_mfma_f32_32x32x16_bf16(wf[(mt * 8 + ks) * 64], sb[ks], ws_, 0, 0, 0);
                                                 oc[mt] = __builtin_amdgcn_mfma_f32_32x32x16_bf16(qf[(mt * 8 + ks) * 64], sb[ks], oc[mt], 0, 0, 0); }
#pragma unroll
                for (int r = 0; r < 16; ++r) vn[mt][r] = ufl[(32 * mt + (r & 3) + 8 * (r >> 2)) * 32] - ws_[r];
            }
            bf16x8 vb[4];
#pragma unroll
            for (int mt = 0; mt < 2; ++mt) { vb[2 * mt] = pack8(vn[mt], 0); vb[2 * mt + 1] = pack8(vn[mt], 1); }
#pragma unroll
            for (int mt = 0; mt < 2; ++mt) {
#pragma unroll
                for (int ks = 0; ks < 4; ++ks) oc[mt] = __builtin_amdgcn_mfma_f32_32x32x16_bf16(af[(mt * 4 + ks) * 64], vb[ks], oc[mt], 0, 0, 0);
#pragma unroll
                for (int r = 0; r < 16; ++r) oap[(size_t)(32 * mt + (r & 3) + 8 * (r >> 2)) * 512] = oc[mt][r];
            }
#pragma unroll
            for (int dt = 0; dt < 4; ++dt) {
#pragma unroll
                for (int r = 0; r < 16; ++r) st4[dt][r] *= egl;
#pragma unroll
                for (int ks = 0; ks < 4; ++ks) st4[dt] = __builtin_amdgcn_mfma_f32_32x32x16_bf16(kf[(dt * 4 + ks) * 64], vb[ks], st4[dt], 0, 0, 0);
            }
        }
        __syncthreads();
    }
}
constexpr int CW_QUEUE = 64;
__device__ __forceinline__ void mixer_phase(Frame& F, const Args& A, int rep) {
#if defined(PROBE_M) && PROBE_M == 1
    if (rep == 0)
#endif
#if defined(PROBE_M) && PROBE_M == 2
    if (rep == 0 || true)
#endif
    if (blockIdx.x < 32) gdn_scan_block(F, (int)blockIdx.x);
#if defined(PROBE_M) && PROBE_M == 2
    if (rep == 1) return;
#endif
    unsigned* qctr = (unsigned*)(F.ws + WS_CTL) + CW_QUEUE + 64 * rep;
    volatile LAS int* slot = (volatile LAS int*)(F.lds + CTRL_OFF + 64);
    for (;;) {
        __syncthreads();
        if (F.tid == 0) slot[0] = (int)__hip_atomic_fetch_add(qctr, 1u, __ATOMIC_RELAXED, __HIP_MEMORY_SCOPE_AGENT);
        __syncthreads();
        const int i = slot[0];
        if (i >= 512) break;
        const int qb = 31 - (i >> 4), x = i & 15;
        attn_unit(F, x >> 3, (x >> 1) & 3, x & 1, qb);
    }
    __syncthreads();
    if (blockIdx.x >= 32) late_weight_copies(F, A, ((int)blockIdx.x - 32) * NWAVES + F.wave, (F.G - 32) * NWAVES);
    else if (F.G <= 32) late_weight_copies(F, A, (int)blockIdx.x * NWAVES + F.wave, F.G * NWAVES);
}
__global__ void __launch_bounds__(NWAVES * 64, 2) mega(Args args) {
    extern __shared__ __attribute__((aligned(16))) unsigned char lds_raw[];
    Frame F;
    F.lds = (LAS unsigned char*)lds_raw;
    F.MISC = (volatile LAS unsigned*)(F.lds + MISC_OFF);
    F.tid = threadIdx.x; F.lane = F.tid & 63; F.wave = __builtin_amdgcn_readfirstlane(F.tid >> 6);
    F.G = gridDim.x; { const int bx = blockIdx.x; F.vcu = (F.G % 8 == 0) ? (bx % 8) * (F.G / 8) + bx / 8 : bx; }
    F.out = args.out; F.ws = args.ws;
    for (int u = F.tid; u < (LDS_BYTES - CTRL_OFF) / 4; u += NWAVES * 64) ((LAS unsigned*)(F.lds + CTRL_OFF))[u] = 0u;
    __syncthreads();
    const int lo = args.ph_lo, hi = args.ph_hi;
    XcdBarrier bar; bar.bar = (unsigned*)(F.ws + WS_CTL) + CW_BAR; bar.x = 0; bar.st = nullptr;
    if (hi - lo > 1) bar = xcd_barrier_post((unsigned*)(F.ws + WS_CTL) + CW_BAR, F.MISC + 8);
#ifndef PHASE_MASK
#define PHASE_MASK 0xffff
#endif
#ifndef DUP_MASK
#define DUP_MASK 0
#endif
#define IN(k) (((PHASE_MASK >> (k)) & 1) && lo <= (k) && (k) < hi)
    if (IN(0)) { p0_phase(F, args); }
#if (DUP_MASK >> 0) & 1
    if (IN(0)) xcd_barrier(bar);
    if (IN(0)) { p0_phase(F, args); }
#endif
    if (IN(0) && IN(1)) xcd_barrier(bar);
#ifdef PROBE_BAR
    for (int pb = 0; pb < 12; ++pb) xcd_barrier(bar);
#endif
    if (IN(1)) { norm_mod_phase<true, true>(F, args, args.in[0], args.in[4], 0, 1024, (bf16_t*)(F.ws + WS_H)); }
#if (DUP_MASK >> 1) & 1
    if (IN(1)) xcd_barrier(bar);
    if (IN(1)) { norm_mod_phase<true, true>(F, args, args.in[0], args.in[4], 0, 1024, (bf16_t*)(F.ws + WS_H)); }
#endif
    if (IN(1) && IN(2)) xcd_barrier(bar);
    if (IN(2)) {
        pg8::Gemm g{(const bf16_t*)(F.ws + WS_H), (const bf16_t*)(F.ws + WS_WIN), T, LDP, D}; pg8::StaticOrder So; So.init(T, LDP, F.G, (int)blockIdx.x);
        pg8::EpiStoreBf16 E{(bf16_t*)(F.ws + WS_P), LDP, 0};
        pg8::gemm_phase<pg8::EpiStoreBf16, pg8::StaticOrder, true, true>(F.lds, g, So, E);
    }
#if (DUP_MASK >> 2) & 1
    if (IN(2)) xcd_barrier(bar);
    if (IN(2)) {
        pg8::Gemm g{(const bf16_t*)(F.ws + WS_H), (const bf16_t*)(F.ws + WS_WIN), T, LDP, D}; pg8::StaticOrder So; So.init(T, LDP, F.G, (int)blockIdx.x);
        pg8::EpiStoreBf16 E{(bf16_t*)(F.ws + WS_P), LDP, 0};
        pg8::gemm_phase<pg8::EpiStoreBf16, pg8::StaticOrder, true, true>(F.lds, g, So, E);
    }
#endif
    if (IN(2) && IN(3)) xcd_barrier(bar);
    if (IN(3)) { attn_prep_phase(F, args); gdn_prep_phase(F, args); }
#if (DUP_MASK >> 3) & 1
    if (IN(3)) xcd_barrier(bar);
    if (IN(3)) { attn_prep_phase(F, args); gdn_prep_phase(F, args); }
#endif
    if (IN(3) && IN(4)) xcd_barrier(bar);
    if (IN(4)) { mixer_phase(F, args, 0); }
#if (DUP_MASK >> 4) & 1
    if (IN(4)) xcd_barrier(bar);
    if (IN(4)) { mixer_phase(F, args, 1); }
#endif
    if (IN(4) && IN(5)) xcd_barrier(bar);
    if (IN(5)) { post_norm_phase(F, args); }
#if (DUP_MASK >> 5) & 1
    if (IN(5)) xcd_barrier(bar);
    if (IN(5)) { post_norm_phase(F, args); }
#endif
    if (IN(5) && IN(6)) xcd_barrier(bar);
    if (IN(6)) {
        { pg8::Gemm g{(const bf16_t*)(F.ws + WS_OAN), (const bf16_t*)(F.ws + WS_WOA), T, 1024, 512}; pg8::StaticOrder So; So.init(T, 1024, F.G, (int)blockIdx.x);
          pg8::EpiGate<false> E{(const bf16_t*)(F.ws + WS_P) + C_GA, nullptr, (bf16_t*)(F.ws + WS_TMPB), LDP, 0};
          pg8::gemm_phase<pg8::EpiGate<false>, pg8::StaticOrder, true, true>(F.lds, g, So, E); }
        { pg8::Gemm g{(const bf16_t*)(F.ws + WS_OBN), (const bf16_t*)(F.ws + WS_WOB), T, 1024, 512}; pg8::StaticOrder So; So.init(T, 1024, F.G, (int)blockIdx.x);
          pg8::EpiGate<true> E{(const bf16_t*)(F.ws + WS_P) + C_GB, (const bf16_t*)(F.ws + WS_TMPB), (bf16_t*)(F.ws + WS_MERGED), LDP, 0};
          pg8::gemm_phase<pg8::EpiGate<true>, pg8::StaticOrder, true, true>(F.lds, g, So, E); }
    }
#if (DUP_MASK >> 6) & 1
    if (IN(6)) xcd_barrier(bar);
    if (IN(6)) {
        { pg8::Gemm g{(const bf16_t*)(F.ws + WS_OAN), (const bf16_t*)(F.ws + WS_WOA), T, 1024, 512}; pg8::StaticOrder So; So.init(T, 1024, F.G, (int)blockIdx.x);
          pg8::EpiGate<false> E{(const bf16_t*)(F.ws + WS_P) + C_GA, nullptr, (bf16_t*)(F.ws + WS_TMPB), LDP, 0};
          pg8::gemm_phase<pg8::EpiGate<false>, pg8::StaticOrder, true, true>(F.lds, g, So, E); }
        { pg8::Gemm g{(const bf16_t*)(F.ws + WS_OBN), (const bf16_t*)(F.ws + WS_WOB), T, 1024, 512}; pg8::StaticOrder So; So.init(T, 1024, F.G, (int)blockIdx.x);
          pg8::EpiGate<true> E{(const bf16_t*)(F.ws + WS_P) + C_GB, (const bf16_t*)(F.ws + WS_TMPB), (bf16_t*)(F.ws + WS_MERGED), LDP, 0};
          pg8::gemm_phase<pg8::EpiGate<true>, pg8::StaticOrder, true, true>(F.lds, g, So, E); }
    }
#endif
    if (IN(6) && IN(7)) xcd_barrier(bar);
    if (IN(7)) {
        pg8::Gemm g{(const bf16_t*)(F.ws + WS_MERGED), (const bf16_t*)(F.ws + WS_WOUT), T, 1024, 1024}; pg8::StaticOrder So; So.init(T, 1024, F.G, (int)blockIdx.x);
        pg8::EpiResid E{args.in[0], (const float*)(F.ws + WS_MOD) + 2048, (float*)(F.ws + WS_X1)};
        pg8::gemm_phase<pg8::EpiResid, pg8::StaticOrder, true, true>(F.lds, g, So, E);
    }
#if (DUP_MASK >> 7) & 1
    if (IN(7)) xcd_barrier(bar);
    if (IN(7)) {
        pg8::Gemm g{(const bf16_t*)(F.ws + WS_MERGED), (const bf16_t*)(F.ws + WS_WOUT), T, 1024, 1024}; pg8::StaticOrder So; So.init(T, 1024, F.G, (int)blockIdx.x);
        pg8::EpiResid E{args.in[0], (const float*)(F.ws + WS_MOD) + 2048, (float*)(F.ws + WS_X1)};
        pg8::gemm_phase<pg8::EpiResid, pg8::StaticOrder, true, true>(F.lds, g, So, E);
    }
#endif
    if (IN(7) && IN(8)) xcd_barrier(bar);
    if (IN(8)) { norm_mod_phase<false, false>(F, args, (const float*)(F.ws + WS_X1), args.in[20], 3072, 4096, (bf16_t*)(F.ws + WS_H)); }
#if (DUP_MASK >> 8) & 1
    if (IN(8)) xcd_barrier(bar);
    if (IN(8)) { norm_mod_phase<false, false>(F, args, (const float*)(F.ws + WS_X1), args.in[20], 3072, 4096, (bf16_t*)(F.ws + WS_H)); }
#endif
    if (IN(8) && IN(9)) xcd_barrier(bar);
    if (IN(9)) {
        pg8::Gemm g{(const bf16_t*)(F.ws + WS_H), (const bf16_t*)(F.ws + WS_W9), T, 768, 1024}; pg8::StaticOrder So; So.init(T, 768, F.G, (int)blockIdx.x);
        pg8::EpiSharedRouter E{(bf16_t*)(F.ws + WS_SACT), (float*)(F.ws + WS_LOGITS)};
        pg8::gemm_phase<pg8::EpiSharedRouter, pg8::StaticOrder, true, true>(F.lds, g, So, E);
    }
#if (DUP_MASK >> 9) & 1
    if (IN(9)) xcd_barrier(bar);
    if (IN(9)) {
        pg8::Gemm g{(const bf16_t*)(F.ws + WS_H), (const bf16_t*)(F.ws + WS_W9), T, 768, 1024}; pg8::StaticOrder So; So.init(T, 768, F.G, (int)blockIdx.x);
        pg8::EpiSharedRouter E{(bf16_t*)(F.ws + WS_SACT), (float*)(F.ws + WS_LOGITS)};
        pg8::gemm_phase<pg8::EpiSharedRouter, pg8::StaticOrder, true, true>(F.lds, g, So, E);
    }
#endif
    if (IN(9) && IN(10)) xcd_barrier(bar);
    if (IN(10)) { route_phase(F, args); }
#if (DUP_MASK >> 10) & 1
    if (IN(10)) xcd_barrier(bar);
    if (IN(10)) { route_phase(F, args); }
#endif
    if (IN(10) && IN(11)) xcd_barrier(bar);
    if (IN(11)) { moe_phase(F, args); }
#if (DUP_MASK >> 11) & 1
    if (IN(11)) xcd_barrier(bar);
    if (IN(11)) { moe_phase(F, args, 1); }
#endif
    if (IN(11) && IN(12)) xcd_barrier(bar);
    if (IN(12)) {
        pg8::Gemm g{(const bf16_t*)(F.ws + WS_SACT), (const bf16_t*)(F.ws + WS_WSD), T, 1024, 256}; pg8::StaticOrder So; So.init(T, 1024, F.G, (int)blockIdx.x);
        pg8::EpiFinal E{(const float*)(F.ws + WS_X1), (const float*)(F.ws + WS_MOD) + 5120, (const bf16_t*)(F.ws + WS_Y), F.out};
        pg8::gemm_phase<pg8::EpiFinal, pg8::StaticOrder, true, true>(F.lds, g, So, E);
    }
#if (DUP_MASK >> 12) & 1
    if (IN(12)) xcd_barrier(bar);
    if (IN(12)) {
        pg8::Gemm g{(const bf16_t*)(F.ws + WS_SACT), (const bf16_t*)(F.ws + WS_WSD), T, 1024, 256}; pg8::StaticOrder So; So.init(T, 1024, F.G, (int)blockIdx.x);
        pg8::EpiFinal E{(const float*)(F.ws + WS_X1), (const float*)(F.ws + WS_MOD) + 5120, (const bf16_t*)(F.ws + WS_Y), F.out};
        pg8::gemm_phase<pg8::EpiFinal, pg8::StaticOrder, true, true>(F.lds, g, So, E);
    }
#endif
#undef IN
}
extern "C" void kernel_launch(void* const* d_in, const int* in_sizes, int n_in, void* d_out, int out_size, void* d_ws, size_t ws_size, hipStream_t stream) {
  static int grid = 0;
  if (grid == 0) {
    int dev = 0, cus = 0;
    if (n_in != 27 || out_size != T * D || ws_size < WS_END) { fprintf(stderr, "kernel_launch: unexpected problem (n_in %d, out %d, ws %zu < %zu)\n", n_in, out_size, ws_size, (size_t)WS_END); grid = -1; return; }
    if (hipGetDevice(&dev) != hipSuccess || hipDeviceGetAttribute(&cus, hipDeviceAttributeMultiprocessorCount, dev) != hipSuccess) { fprintf(stderr, "kernel_launch: device query failed\n"); grid = -1; return; }
    if (hipFuncSetAttribute((const void*)mega, hipFuncAttributeMaxDynamicSharedMemorySize, LDS_BYTES) != hipSuccess) { fprintf(stderr, "kernel_launch: hipFuncSetAttribute failed\n"); grid = -1; return; }
    int per_cu = 0;
    if (hipOccupancyMaxActiveBlocksPerMultiprocessor(&per_cu, (const void*)mega, NWAVES * 64, LDS_BYTES) != hipSuccess || per_cu < 1) fprintf(stderr, "kernel_launch: occupancy query says %d blocks per CU\n", per_cu);
    (void)hipGetLastError();
    grid = cus;
  }
  if (grid < 0) return;
  (void)hipMemsetAsync((unsigned char*)d_ws + WS_CTL, 0, CTL_ZERO_BYTES, stream);
  Args a{};
  for (int i = 0; i < 27; ++i) a.in[i] = (const float*)d_in[i];
  a.out = (float*)d_out; a.ws = (unsigned char*)d_ws;
#ifndef N_LAUNCH_PHASES
  a.ph_lo = 0; a.ph_hi = 13;
  hipLaunchKernelGGL(mega, dim3(grid), dim3(NWAVES * 64), LDS_BYTES, stream, a);
#else
  for (int ph = 0; ph < 13; ++ph) { a.ph_lo = ph; a.ph_hi = ph + 1; hipLaunchKernelGGL(mega, dim3(grid), dim3(NWAVES * 64), LDS_BYTES, stream, a); }
#endif
}
```

```cpp
#include <hip/hip_runtime.h>
#include <stdint.h>
#include <cstdio>

typedef unsigned short bf16_t;
constexpr int D = 1024, NB = 2, S = 8192, T = NB * S;
constexpr int INC = 5640;
constexpr int LDP = 5632;
constexpr int C_QA = 0, C_KA = 512, C_VA = 1024, C_ZA = 1536, C_QB = 2048, C_KB = 2560, C_VB = 3072, C_GA = 3584, C_GB = 4608;
constexpr int NE = 256, TOPK = 8, NA = T * TOPK;
constexpr float EPS = 1e-6f;
constexpr float LAM_INIT = 0.2f;
__device__ __forceinline__ float bf2f(bf16_t v) { return __uint_as_float(((unsigned)v) << 16); }
__device__ __forceinline__ float siluf(float x) { return x / (1.f + __expf(-x)); }
__device__ __forceinline__ float sigmf(float x) { return 1.f / (1.f + __expf(-x)); }
__device__ __forceinline__ float softplusf(float x) { return x > 20.f ? x : log1pf(__expf(x)); }
__device__ __forceinline__ float wave_sum(float v) {
#pragma unroll
  for (int o = 1; o < 64; o <<= 1) v += __shfl_xor(v, o);
  return v;
}
constexpr size_t MiB = 1u << 20;
constexpr size_t WS_CTL = 0, CTL_ZERO_BYTES = 1 * MiB;
constexpr size_t WS_MODP = 1 * MiB;
constexpr size_t WS_MOD = 1 * MiB + 256 * 1024;
constexpr size_t WS_SCAL = 1 * MiB + 320 * 1024;
constexpr size_t WS_WIN = 2 * MiB;
constexpr size_t WS_WOA = 13 * MiB, WS_WOB = 14 * MiB;
constexpr size_t WS_WOUT = 15 * MiB;
constexpr size_t WS_W9 = 17 * MiB;
constexpr size_t WS_WSD = 19 * MiB;
constexpr size_t WS_BD = 20 * MiB;
constexpr size_t WS_H = 32 * MiB;
constexpr size_t WS_P = 64 * MiB;
constexpr size_t WS_OAN = 240 * MiB, WS_OBN = 256 * MiB;
constexpr size_t WS_TMPB = 272 * MiB;
constexpr size_t WS_MERGED = 304 * MiB;
constexpr size_t WS_X1 = 336 * MiB;
constexpr size_t WS_LOGITS = 400 * MiB;
constexpr size_t WS_SACT = 416 * MiB;
constexpr size_t WS_TOPI = 424 * MiB, WS_TOPW = 425 * MiB;
constexpr size_t WS_Y = 432 * MiB;
constexpr size_t WS_ACTB = 704 * MiB;
constexpr size_t WS_LIST = 768 * MiB;
constexpr size_t WS_QN = 800 * MiB, WS_KN = 816 * MiB;
constexpr size_t WS_OB = 832 * MiB;
constexpr size_t WS_OA = 864 * MiB;
constexpr size_t WS_GDN = 896 * MiB;
constexpr size_t WS_XA = 992 * MiB;
constexpr size_t XA_BLOCK = (size_t)32 * 640 * 16;
constexpr size_t WS_END = WS_XA + 256 * XA_BLOCK;
constexpr int CW_BAR = 4096;

#define GAS __attribute__((address_space(1)))
#define LAS __attribute__((address_space(3)))
typedef unsigned v4u __attribute__((ext_vector_type(4)));
typedef float f32x4 __attribute__((ext_vector_type(4)));
typedef unsigned u32x2 __attribute__((ext_vector_type(2)));
typedef short bf16x8 __attribute__((ext_vector_type(8)));
typedef GAS unsigned gu32;
typedef GAS unsigned long long gu64;
#define RLX_AGENT __ATOMIC_RELAXED, __HIP_MEMORY_SCOPE_AGENT
#define LDS_WAIT() asm volatile("s_waitcnt lgkmcnt(0)" ::: "memory")
#define VM_WAIT() asm volatile("s_waitcnt vmcnt(0)" ::: "memory")
__device__ __forceinline__ unsigned f2bf(float f) { unsigned u = __builtin_bit_cast(unsigned, f); return (u + 0x7fffu + ((u >> 16) & 1u)) >> 16; }
__device__ __forceinline__ unsigned pk2(float lo, float hi) { return f2bf(lo) | (f2bf(hi) << 16); }

constexpr int NWAVES = 8;
constexpr int LDS_BYTES = 163840;
constexpr int CTRL_OFF = 159744;
constexpr int MISC_OFF = CTRL_OFF + 320;
constexpr int CW_ECNT = 256;

struct Frame {
    LAS unsigned char* lds;
    volatile LAS unsigned* MISC;
    int tid, lane, wave, vcu, G;
    float* out; unsigned char* ws;
    const __attribute__((address_space(4))) unsigned char* karg;
};
#define KIN(k) (*(const float* const __attribute__((address_space(4)))*)(F.karg + 8 * (k)))
struct Args { const float* in[27]; float* out; unsigned char* ws; int ph_lo, ph_hi; };
namespace pg8 {
#define PG8_LAS __attribute__((address_space(3)))
typedef unsigned short bf16_t;
typedef short bf16x8 __attribute__((ext_vector_type(8)));
typedef float f32x4 __attribute__((ext_vector_type(4)));
typedef unsigned u32x4 __attribute__((ext_vector_type(4)));
constexpr int BM = 256, BK = 64, HALF = 128, HTB = HALF * BK * 2  , STAGE_BYTES = 8 * HTB, NXCD = 8, WGM = 8;

__host__ __device__ __forceinline__ int lds_byte(int r, int c) { const int st = (r >> 4) * 2 + (c >> 5), rr = r & 15, cc = c & 31, ob = rr * 64 + cc * 2; return st * 1024 + (ob ^ (((ob >> 9) & 1) << 5)); }
__host__ __device__ __forceinline__ void stage_rc(int b, int& R, int& C) { const int st = b / 1024, sb = b % 1024, swz = sb ^ (((sb >> 9) & 1) << 5); R = (st >> 1) * 16 + swz / 64; C = (st & 1) * 32 + (swz % 64) / 2; }
__host__ __device__ __forceinline__ int perm32(int rho) { const int n = rho >> 4, i = rho & 15; return 8 * (i >> 2) + 4 * n + (i & 3); }

struct Unit { int pm, pn; };
struct Gemm { const bf16_t* A; const bf16_t* Bt; int M, N, K; };

struct StaticOrder {
    int nM, nN, nwg, G, c;
    __host__ __device__ void init(int M, int N, int G_, int c_) { nM = M / BM; nN = N / BM; nwg = nM * nN; G = G_; c = c_; }
    __host__ __device__ bool next(int i, Unit& u) const {
        const long L = (long)i * G + c; if (L >= nwg) return false;
        int wgid = (int)L; { const int q = nwg / NXCD, r = nwg % NXCD, xcd = wgid % NXCD, off = wgid / NXCD; wgid = (xcd < r ? xcd * (q + 1) : r * (q + 1) + (xcd - r) * q) + off; }
        const int nig = WGM * nN, gid = wgid / nig, fm = gid * WGM, gsz = (nM - fm) < WGM ? (nM - fm) : WGM;
        u.pm = fm + ((wgid % nig) % gsz); u.pn = (wgid % nig) / gsz; return true;
    }
    __device__ __forceinline__ void a_ready(const Unit&) const {}
    __device__ __forceinline__ void done(const Unit&) const {}
};

__device__ __forceinline__ unsigned cvt_pk_bf16(float lo, float hi) { unsigned r; asm volatile("v_cvt_pk_bf16_f32 %0, %1, %2" : "=v"(r) : "v"(lo), "v"(hi)); return r; }
typedef float f32x2 __attribute__((ext_vector_type(2)));
template <class Epi, class Sched, bool ALIGN_EPI = false, bool SP2 = false>
__device__ __forceinline__ void gemm_phase(PG8_LAS unsigned char* lds, const Gemm g, const Sched& S, const Epi& E) {
    const int tid = threadIdx.x, wid = __builtin_amdgcn_readfirstlane(tid >> 6), lane = tid & 63, wr = wid >> 2, wc = wid & 3, fr = lane & 15, fq = lane >> 4;
    const int K = g.K, nt = K / BK;
    unsigned voffA[2], voffB[2];
#pragma unroll
    for (int i = 0; i < 2; ++i) { int R, C; stage_rc(tid * 16 + i * 8192, R, C); const int Rb = Epi::PERM ? ((R & ~31) + perm32(R & 31)) : R;
        voffA[i] = (unsigned)(R * K + C) * 2u; voffB[i] = (unsigned)(Rb * K + C) * 2u; }
    const size_t kstep = (size_t)(BK * 2);
    const size_t hstep = (size_t)HALF * K * 2;
    const size_t tstep = 2 * hstep;
    const unsigned ldsw = (unsigned)wid * 1024u;
    const int aoff = lds_byte(wr * 64 + fr, fq * 8), boff = lds_byte(wc * 32 + fr, fq * 8);
#define PG8_SA(b, h) (((b) * 2 + (h)) * HTB)
#define PG8_SB(b, h) ((4 + (b) * 2 + (h)) * HTB)
#define PG8_STAGE(bufoff, gbase, voff) do { _Pragma("unroll") for (int _i = 0; _i < 2; ++_i) \
        __builtin_amdgcn_global_load_lds((const unsigned*)((const char*)(gbase) + (voff)[_i]), (PG8_LAS unsigned*)(lds + (bufoff) + ldsw + _i * 8192), 16, 0, 0); } while (0)
#define PG8_LDA(dst, b, h) do { _Pragma("unroll") for (int m = 0; m < 4; ++m) _Pragma("unroll") for (int k = 0; k < 2; ++k) dst[m][k] = *(const PG8_LAS bf16x8*)(lds + PG8_SA(b, h) + aoff + m * 2048 + k * 1024); } while (0)
#define PG8_LDB(dst, b, h) do { _Pragma("unroll") for (int n = 0; n < 2; ++n) _Pragma("unroll") for (int k = 0; k < 2; ++k) dst[n][k] = *(const PG8_LAS bf16x8*)(lds + PG8_SB(b, h) + boff + n * 2048 + k * 1024); } while (0)
#define PG8_MMA(ai, bj, At, Bt) do { __builtin_amdgcn_s_setprio(1); _Pragma("unroll") for (int m = 0; m < 4; ++m) _Pragma("unroll") for (int n = 0; n < 2; ++n) _Pragma("unroll") for (int k = 0; k < 2; ++k) \
        acc[ai][bj][m][n] = __builtin_amdgcn_mfma_f32_16x16x32_bf16(Bt[n][k], At[m][k], acc[ai][bj][m][n], 0, 0, 0); __builtin_amdgcn_s_setprio(0); } while (0)
#define PG8_WAIT_V(n) asm volatile("s_waitcnt vmcnt(" #n ")" ::: "memory")
#define PG8_WAIT_L(n) asm volatile("s_waitcnt lgkmcnt(" #n ")" ::: "memory")
#define PG8_BAR __builtin_amdgcn_s_barrier()
#define PG8_SCHED __builtin_amdgcn_sched_barrier(0)
    Unit cur, nxt; int ui = 0;
    if (!S.next(0, cur)) return;
    f32x4 acc[2][2][4][2];
#pragma unroll
    for (int a = 0; a < 2; ++a)
#pragma unroll
        for (int b = 0; b < 2; ++b)
#pragma unroll
            for (int m = 0; m < 4; ++m)
#pragma unroll
                for (int n = 0; n < 2; ++n) acc[a][b][m][n] = (f32x4){0.f, 0.f, 0.f, 0.f};
    bf16x8 At[4][2], B0[2][2], B1[2][2];
    const char* cA = (const char*)g.A + (size_t)cur.pm * tstep; const char* cB = (const char*)g.Bt + (size_t)cur.pn * tstep;
    S.a_ready(cur);
    if constexpr (SP2) {
        PG8_STAGE(PG8_SB(0, 0), cB, voffB); PG8_STAGE(PG8_SB(0, 1), cB + hstep, voffB); PG8_STAGE(PG8_SA(0, 0), cA, voffA); PG8_STAGE(PG8_SA(0, 1), cA + hstep, voffA);
        if (wr == 1) PG8_BAR;
        PG8_WAIT_V(2); PG8_BAR;
        PG8_STAGE(PG8_SB(1, 0), cB + kstep, voffB); PG8_STAGE(PG8_SA(1, 0), cA + kstep, voffA); PG8_STAGE(PG8_SB(1, 1), cB + hstep + kstep, voffB);
        PG8_WAIT_V(6); PG8_BAR;
    } else {
        PG8_STAGE(PG8_SB(0, 0), cB, voffB); PG8_STAGE(PG8_SA(0, 0), cA, voffA); PG8_STAGE(PG8_SB(0, 1), cB + hstep, voffB); PG8_STAGE(PG8_SA(0, 1), cA + hstep, voffA);
        if (wr == 1) PG8_BAR;
        PG8_WAIT_V(4); PG8_BAR;
        PG8_STAGE(PG8_SB(1, 0), cB + kstep, voffB); PG8_STAGE(PG8_SA(1, 0), cA + kstep, voffA); PG8_STAGE(PG8_SB(1, 1), cB + hstep + kstep, voffB);
        PG8_WAIT_V(6); PG8_BAR;
    }
    for (;;) {
        const bool has_next = S.next(ui + 1, nxt);
        const char* nA = has_next ? (const char*)g.A + (size_t)nxt.pm * tstep : cA; const char* nB = has_next ? (const char*)g.Bt + (size_t)nxt.pn * tstep : cB;
        for (int t = 0; t < nt; t += 2) {
            const bool last = (t == nt - 2);
            const char* a1 = cA + (size_t)(t + 1) * kstep;
            const char* a2 = last ? nA : cA + (size_t)(t + 2) * kstep; const char* b2 = last ? nB : cB + (size_t)(t + 2) * kstep;
            const char* a3 = a2 + kstep; const char* b3 = b2 + kstep;
            if (last && has_next) S.a_ready(nxt);
            if constexpr (SP2) {
            PG8_LDB(B0, 0, 0); PG8_LDB(B1, 0, 1); PG8_SCHED; PG8_LDA(At, 0, 0); PG8_STAGE(PG8_SA(1, 1), a1 + hstep, voffA);
            PG8_WAIT_V(8); PG8_WAIT_L(0); PG8_BAR; PG8_MMA(0, 0, At, B0); PG8_MMA(0, 1, At, B1); PG8_BAR; PG8_SCHED;
            PG8_LDA(At, 0, 1); PG8_STAGE(PG8_SB(0, 0), b2, voffB); PG8_STAGE(PG8_SB(0, 1), b2 + hstep, voffB); PG8_STAGE(PG8_SA(0, 0), a2, voffA);
            PG8_WAIT_V(8); PG8_WAIT_L(0); PG8_BAR; PG8_MMA(1, 0, At, B0); PG8_MMA(1, 1, At, B1); PG8_BAR; PG8_SCHED;
            PG8_LDB(B0, 1, 0); PG8_LDB(B1, 1, 1); PG8_SCHED; PG8_LDA(At, 1, 0); PG8_STAGE(PG8_SA(0, 1), a2 + hstep, voffA);
            PG8_WAIT_V(8); PG8_WAIT_L(0); PG8_BAR; PG8_MMA(0, 0, At, B0); PG8_MMA(0, 1, At, B1); PG8_BAR; PG8_SCHED;
            PG8_LDA(At, 1, 1); PG8_STAGE(PG8_SB(1, 0), b3, voffB); PG8_STAGE(PG8_SB(1, 1), b3 + hstep, voffB); PG8_STAGE(PG8_SA(1, 0), a3, voffA);
            PG8_WAIT_V(8); PG8_WAIT_L(0); PG8_BAR; PG8_MMA(1, 0, At, B0); PG8_MMA(1, 1, At, B1); PG8_BAR; PG8_SCHED;
            } else {
            PG8_LDB(B0, 0, 0); PG8_SCHED; PG8_LDA(At, 0, 0); PG8_STAGE(PG8_SA(1, 1), a1 + hstep, voffA);
            PG8_WAIT_L(8); PG8_BAR; PG8_WAIT_L(0); PG8_MMA(0, 0, At, B0); PG8_BAR; PG8_SCHED;
            PG8_LDB(B1, 0, 1); PG8_STAGE(PG8_SB(0, 0), b2, voffB);
            PG8_BAR; PG8_WAIT_L(0); PG8_MMA(0, 1, At, B1); PG8_BAR;
            PG8_LDA(At, 0, 1); PG8_STAGE(PG8_SA(0, 0), a2, voffA);
            PG8_BAR; PG8_WAIT_L(0); PG8_MMA(1, 0, At, B0); PG8_BAR; PG8_SCHED;
            PG8_STAGE(PG8_SB(0, 1), b2 + hstep, voffB);
            PG8_WAIT_V(6); PG8_BAR; PG8_MMA(1, 1, At, B1); PG8_BAR;
            PG8_LDB(B0, 1, 0); PG8_SCHED; PG8_LDA(At, 1, 0); PG8_STAGE(PG8_SA(0, 1), a2 + hstep, voffA);
            PG8_WAIT_L(8); PG8_BAR; PG8_WAIT_L(0); PG8_MMA(0, 0, At, B0); PG8_BAR; PG8_SCHED;
            PG8_LDB(B1, 1, 1); PG8_STAGE(PG8_SB(1, 0), b3, voffB);
            PG8_BAR; PG8_WAIT_L(0); PG8_MMA(0, 1, At, B1); PG8_BAR;
            PG8_LDA(At, 1, 1); PG8_STAGE(PG8_SA(1, 0), a3, voffA);
            PG8_BAR; PG8_WAIT_L(0); PG8_MMA(1, 0, At, B0); PG8_BAR; PG8_SCHED;
            PG8_STAGE(PG8_SB(1, 1), b3 + hstep, voffB);
            PG8_WAIT_V(6); PG8_BAR; PG8_MMA(1, 1, At, B1); PG8_BAR;
            }
        }
        if constexpr (ALIGN_EPI) { if (wr == 0) PG8_BAR; }
        if constexpr (!Epi::AFTER_DRAIN) { E(acc, cur, wr, wc, fr, fq); S.done(cur); }
        if (!has_next) break;
#pragma unroll
        for (int a = 0; a < 2; ++a)
#pragma unroll
            for (int b = 0; b < 2; ++b)
#pragma unroll
                for (int m = 0; m < 4; ++m)
#pragma unroll
                    for (int n = 0; n < 2; ++n) acc[a][b][m][n] = (f32x4){0.f, 0.f, 0.f, 0.f};
        cur = nxt; cA = nA; cB = nB; ++ui;
        if constexpr (ALIGN_EPI) { if (wr == 1) PG8_BAR; }
    }
    PG8_WAIT_V(0);
    if constexpr (!ALIGN_EPI) { if (wr == 0) PG8_BAR; }
    PG8_BAR;
    if constexpr (Epi::AFTER_DRAIN) { E.fused(acc, cur, wr, wc, fr, fq, lds, wid, lane); S.done(cur); }
#undef PG8_SA
#undef PG8_SB
#undef PG8_STAGE
#undef PG8_LDA
#undef PG8_LDB
#undef PG8_MMA
#undef PG8_WAIT_V
#undef PG8_WAIT_L
#undef PG8_BAR
#undef PG8_SCHED
}
}
namespace pg8 {
struct EpiStoreBf16 {
    static constexpr bool PERM = true, AFTER_DRAIN = false;
    bf16_t* O; int ldc; int pad;
    __device__ __forceinline__ void operator()(const f32x4 (&acc)[2][2][4][2], const Unit& u, int wr, int wc, int fr, int fq) const {
        const int row0 = u.pm * BM + wr * 64 + fr, col0 = u.pn * BM + wc * 32 + 8 * fq;
#pragma unroll
        for (int ai = 0; ai < 2; ++ai)
#pragma unroll
            for (int m = 0; m < 4; ++m) { bf16_t* rowp = O + (size_t)(row0 + ai * HALF + m * 16) * ldc + col0;
#pragma unroll
                for (int bj = 0; bj < 2; ++bj) { const f32x4 v0 = acc[ai][bj][m][0], v1 = acc[ai][bj][m][1];
                    u32x4 w; w.x = cvt_pk_bf16(v0[0], v0[1]); w.y = cvt_pk_bf16(v0[2], v0[3]); w.z = cvt_pk_bf16(v1[0], v1[1]); w.w = cvt_pk_bf16(v1[2], v1[3]);
                    *(u32x4*)(rowp + bj * HALF) = w; } }
    }
};
__device__ __forceinline__ float bflo(unsigned w) { return __uint_as_float(w << 16); }
__device__ __forceinline__ float bfhi(unsigned w) { return __uint_as_float(w & 0xffff0000u); }
__device__ __forceinline__ float sigm(float x) { return __builtin_amdgcn_rcpf(1.f + __expf(-x)); }
template <bool ADD> struct EpiGate {
    static constexpr bool PERM = true, AFTER_DRAIN = false;
    const bf16_t* gate; const bf16_t* prev; bf16_t* O; int ldg; int pad;
    __device__ __forceinline__ void operator()(const f32x4 (&acc)[2][2][4][2], const Unit& u, int wr, int wc, int fr, int fq) const {
        const int row0 = u.pm * BM + wr * 64 + fr, col0 = u.pn * BM + wc * 32 + 8 * fq;
#pragma unroll
        for (int ai = 0; ai < 2; ++ai)
#pragma unroll
            for (int m = 0; m < 4; ++m) { const size_t r = (size_t)(row0 + ai * HALF + m * 16);
#pragma unroll
                for (int bj = 0; bj < 2; ++bj) { const int c = col0 + bj * HALF;
                    const u32x4 gw = *(const u32x4*)(gate + r * ldg + c);
                    const f32x4 v0 = acc[ai][bj][m][0], v1 = acc[ai][bj][m][1];
                    float o[8];
                    o[0] = sigm(bflo(gw.x)) * v0[0]; o[1] = sigm(bfhi(gw.x)) * v0[1]; o[2] = sigm(bflo(gw.y)) * v0[2]; o[3] = sigm(bfhi(gw.y)) * v0[3];
                    o[4] = sigm(bflo(gw.z)) * v1[0]; o[5] = sigm(bfhi(gw.z)) * v1[1]; o[6] = sigm(bflo(gw.w)) * v1[2]; o[7] = sigm(bfhi(gw.w)) * v1[3];
                    if (ADD) { const u32x4 pw = *(const u32x4*)(prev + r * 1024 + c);
                        o[0] += bflo(pw.x); o[1] += bfhi(pw.x); o[2] += bflo(pw.y); o[3] += bfhi(pw.y); o[4] += bflo(pw.z); o[5] += bfhi(pw.z); o[6] += bflo(pw.w); o[7] += bfhi(pw.w); }
                    u32x4 w; w.x = cvt_pk_bf16(o[0], o[1]); w.y = cvt_pk_bf16(o[2], o[3]); w.z = cvt_pk_bf16(o[4], o[5]); w.w = cvt_pk_bf16(o[6], o[7]);
                    *(u32x4*)(O + r * 1024 + c) = w; } }
    }
};
struct EpiResid {
    static constexpr bool PERM = false, AFTER_DRAIN = false;
    const float* base; const float* gvec; float* out;
    __device__ __forceinline__ void operator()(const f32x4 (&acc)[2][2][4][2], const Unit& u, int wr, int wc, int fr, int fq) const {
        const int row0 = u.pm * BM + wr * 64 + fr, col0 = u.pn * BM + wc * 32 + 4 * fq;
        const float* gv = gvec + ((u.pm * BM) / 8192) * 6144;
#pragma unroll
        for (int bj = 0; bj < 2; ++bj)
#pragma unroll
            for (int n = 0; n < 2; ++n) { const int c = col0 + bj * HALF + n * 16; const f32x4 g = *(const f32x4*)(gv + c);
#pragma unroll
                for (int ai = 0; ai < 2; ++ai)
#pragma unroll
                    for (int m = 0; m < 4; ++m) { const size_t off = (size_t)(row0 + ai * HALF + m * 16) * 1024 + c;
                        const f32x4 b = *(const f32x4*)(base + off); *(f32x4*)(out + off) = b + g * acc[ai][bj][m][n]; } }
    }
};
struct EpiSharedRouter {
    static constexpr bool PERM = true, AFTER_DRAIN = false;
    bf16_t* sact; float* logits;
    __device__ __forceinline__ void operator()(const f32x4 (&acc)[2][2][4][2], const Unit& u, int wr, int wc, int fr, int fq) const {
        const int row0 = u.pm * BM + wr * 64 + fr;
        if (u.pn < 2) {
#pragma unroll
            for (int ai = 0; ai < 2; ++ai)
#pragma unroll
                for (int m = 0; m < 4; ++m) { const size_t r = (size_t)(row0 + ai * HALF + m * 16);
#pragma unroll
                    for (int bj = 0; bj < 2; ++bj) { const int c8 = (u.pn * BM + bj * HALF + wc * 32 + 8 * fq) >> 1;
                        const f32x4 g = acc[ai][bj][m][0], up = acc[ai][bj][m][1];
                        float a0 = g[0] * sigm(g[0]) * up[0], a1 = g[1] * sigm(g[1]) * up[1], a2 = g[2] * sigm(g[2]) * up[2], a3 = g[3] * sigm(g[3]) * up[3];
                        uint2 w; w.x = cvt_pk_bf16(a0, a1); w.y = cvt_pk_bf16(a2, a3);
                        *(uint2*)(sact + r * 256 + c8) = w; } }
        } else {
#pragma unroll
            for (int ai = 0; ai < 2; ++ai)
#pragma unroll
                for (int m = 0; m < 4; ++m) { const size_t r = (size_t)(row0 + ai * HALF + m * 16);
#pragma unroll
                    for (int bj = 0; bj < 2; ++bj) { const int c = bj * HALF + wc * 32 + 8 * fq;
                        *(f32x4*)(logits + r * 256 + c) = acc[ai][bj][m][0]; *(f32x4*)(logits + r * 256 + c + 4) = acc[ai][bj][m][1]; } }
        }
    }
};
struct EpiFinal {
    static constexpr bool PERM = true, AFTER_DRAIN = false;
    const float* x1; const float* gvec; const bf16_t* Y; float* out;
    __device__ __forceinline__ void operator()(const f32x4 (&acc)[2][2][4][2], const Unit& u, int wr, int wc, int fr, int fq) const {
        const int row0 = u.pm * BM + wr * 64 + fr, col0 = u.pn * BM + wc * 32 + 8 * fq;
        const float* gv = gvec + ((u.pm * BM) / 8192) * 6144;
#pragma unroll
        for (int ai = 0; ai < 2; ++ai)
#pragma unroll
            for (int m = 0; m < 4; ++m) { const size_t r = (size_t)(row0 + ai * HALF + m * 16);
#pragma unroll
                for (int bj = 0; bj < 2; ++bj) { const int c = col0 + bj * HALF;
                    f32x4 s0 = acc[ai][bj][m][0], s1 = acc[ai][bj][m][1];
#pragma unroll
                    for (int k = 0; k < 8; ++k) { const u32x4 yw = *(const u32x4*)(Y + (r * 8 + k) * 1024 + c);
                        s0[0] += bflo(yw.x); s0[1] += bfhi(yw.x); s0[2] += bflo(yw.y); s0[3] += bfhi(yw.y);
                        s1[0] += bflo(yw.z); s1[1] += bfhi(yw.z); s1[2] += bflo(yw.w); s1[3] += bfhi(yw.w); }
                    const f32x4 g0 = *(const f32x4*)(gv + c), g1 = *(const f32x4*)(gv + c + 4);
                    const f32x4 b0 = *(const f32x4*)(x1 + r * 1024 + c), b1 = *(const f32x4*)(x1 + r * 1024 + c + 4);
                    *(f32x4*)(out + r * 1024 + c) = b0 + g0 * s0; *(f32x4*)(out + r * 1024 + c + 4) = b1 + g1 * s1; } }
    }
};
}
#define XB_TMO      128
#define XB_XCNT(j)  (256  + 64 * (j))
#define XB_XSUB(j)  (1280 + 64 * (j))
#define XB_XGEN(j)  (2304 + 64 * (j))
#define XB_TOP      3328
#define XB_TOPGEN   3392
#define XCD_BAR_WORDS 3456
#define XB_SPIN_CAP (1u << 18)

__device__ __forceinline__ unsigned xb_ld(unsigned* p)              { return __hip_atomic_load(p, __ATOMIC_RELAXED, __HIP_MEMORY_SCOPE_AGENT); }
__device__ __forceinline__ unsigned xb_add(unsigned* p, unsigned v) { return __hip_atomic_fetch_add(p, v, __ATOMIC_RELAXED, __HIP_MEMORY_SCOPE_AGENT); }
__device__ __forceinline__ unsigned xb_xcc_id() { return (unsigned)__builtin_amdgcn_s_getreg((3 << 11) | 20) & 0xFu; }
#define XB_SPIN(cond, bar) do { unsigned _sp = 0; while (cond) { __builtin_amdgcn_s_sleep(1); \
    if ((++_sp & 255u) == 0u) { if (xb_ld(&(bar)[XB_TMO])) break; if (_sp > XB_SPIN_CAP) { atomicAdd(&(bar)[XB_TMO], 1u); break; } } } } while (0)

struct XcdBarrier {
    unsigned* bar; unsigned x;
    volatile LAS unsigned* st;
};

__device__ __forceinline__ XcdBarrier xcd_barrier_post(unsigned* bar, volatile LAS unsigned* st) {
    XcdBarrier b; b.bar = bar; b.x = xb_xcc_id(); b.st = st;
    if (threadIdx.x == 0) (void)xb_add(&bar[XB_XCNT(b.x)], 1u);
    return b;
}
__device__ __forceinline__ void xcd_barrier_complete(unsigned* bar, unsigned x, unsigned& nloc, unsigned& nx) {
    const unsigned G = gridDim.x * gridDim.y * gridDim.z;
    unsigned sum, cnt, mine, sp = 0u;
    for (;;) {
        sum = 0u; cnt = 0u; mine = 0u;
#pragma unroll
        for (unsigned j = 0; j < 16; ++j) { const unsigned c = xb_ld(&bar[XB_XCNT(j)]); sum += c; cnt += (c > 0u) ? 1u : 0u; mine = (j == x) ? c : mine; }
        if (sum == G) break;
        __builtin_amdgcn_s_sleep(1);
        if ((++sp & 255u) == 0u) { if (xb_ld(&bar[XB_TMO])) break; if (sp > XB_SPIN_CAP) { atomicAdd(&bar[XB_TMO], 1u); break; } }
    }
    nloc = mine > 0u ? mine : 1u; nx = cnt > 0u ? cnt : 1u;
}

__device__ __forceinline__ void xcd_barrier(const XcdBarrier& b) {
    asm volatile("s_waitcnt vmcnt(0)" ::: "memory");
    __syncthreads();
    if (threadIdx.x == 0) {
        unsigned* bar = b.bar;
        __builtin_amdgcn_s_waitcnt(0);
        unsigned nloc = b.st[0], nx = b.st[1];
        if (nloc == 0u) { xcd_barrier_complete(bar, b.x, nloc, nx); b.st[0] = nloc; b.st[1] = nx; }
        const unsigned old = xb_add(&bar[XB_XSUB(b.x)], 1u);
        const unsigned gen = old / nloc;
        if (old + 1u == (gen + 1u) * nloc) {
            __builtin_amdgcn_fence(__ATOMIC_RELEASE, "agent");
            asm volatile("s_waitcnt vmcnt(0)" ::: "memory");
            const unsigned og = xb_add(&bar[XB_TOP], 1u);
            const unsigned tg = og / nx;
            if (og + 1u == (tg + 1u) * nx) xb_add(&bar[XB_TOPGEN], 1u);
            else XB_SPIN(xb_ld(&bar[XB_TOPGEN]) == tg, bar);
            __builtin_amdgcn_fence(__ATOMIC_ACQUIRE, "agent");
            xb_add(&bar[XB_XGEN(b.x)], 1u);
            asm volatile("s_waitcnt vmcnt(0)" ::: "memory");
        } else {
            XB_SPIN(xb_ld(&bar[XB_XGEN(b.x)]) == gen, bar);
            __builtin_amdgcn_fence(__ATOMIC_ACQUIRE, "agent");
            asm volatile("s_waitcnt vmcnt(0)" ::: "memory");
        }
    }
    __syncthreads();
}
template <class Map>
__device__ __forceinline__ void transpose_item(const float* W, int ldw, int K, bf16_t* WT, int row_off, int nblk, LAS float* scr, int item, int lane, Map srccol) {
    const int kb = item / nblk, nb = item % nblk, k0 = 64 * kb, n0 = 32 * nb;
    const int sc = srccol(n0 + (lane & 31));
#pragma unroll 8
    for (int i = 0; i < 32; ++i) { const int kk = 2 * i + (lane >> 5); scr[kk * 33 + (lane & 31)] = W[(size_t)(k0 + kk) * ldw + sc]; }
    LDS_WAIT(); asm volatile("" ::: "memory");
    const int c = lane & 7;
#pragma unroll
    for (int j = 0; j < 4; ++j) { const int n = (lane >> 3) + 8 * j; const LAS float* s = scr + (8 * c) * 33 + n;
        v4u o; o.x = pk2(s[0 * 33], s[1 * 33]); o.y = pk2(s[2 * 33], s[3 * 33]); o.z = pk2(s[4 * 33], s[5 * 33]); o.w = pk2(s[6 * 33], s[7 * 33]);
        *(v4u*)(WT + (size_t)(row_off + n0 + n) * K + k0 + 8 * c) = o; }
    LDS_WAIT(); asm volatile("" ::: "memory");
}
__device__ __forceinline__ void p0_phase(Frame& F, const Args& A) {
    const int gw = F.vcu * NWAVES + F.wave, NGW = F.G * NWAVES, lane = F.lane;
    const float* c = A.in[1]; const float* w_ada = A.in[2];
    for (int r = gw; r < 96 * 4; r += NGW) {
        const int eb = r >> 2, dc = r & 3, e = eb * 64 + lane; float a0 = 0.f, a1 = 0.f;
#pragma unroll 8
        for (int d = dc * 256; d < dc * 256 + 256; ++d) { const float w = w_ada[(size_t)d * 6144 + e]; a0 += siluf(c[d]) * w; a1 += siluf(c[D + d]) * w; }
        float* modp = (float*)(F.ws + WS_MODP) + dc * 12288; modp[e] = a0; modp[6144 + e] = a1; }
    if (gw == 0) {
        const float s1 = wave_sum(A.in[13][lane] * A.in[14][lane]), s2 = wave_sum(A.in[15][lane] * A.in[16][lane]);
        float qm = fabsf(A.in[11][lane]), km = fabsf(A.in[12][lane]);
#pragma unroll
        for (int o = 1; o < 64; o <<= 1) { qm = fmaxf(qm, __shfl_xor(qm, o)); km = fmaxf(km, __shfl_xor(km, o)); }
        if (lane == 0) { float* sc = (float*)(F.ws + WS_SCAL); sc[0] = expf(s1) - expf(s2) + LAM_INIT; sc[1] = 8.f * qm * km * 1.4426950408889634f; }
    }
}
__device__ __forceinline__ void late_weight_copies(Frame& F, const Args& A, int w0, int nw) {
    LAS float* scr = (LAS float*)(F.lds + F.wave * 16384);
    const int lane = F.lane;
    const float* w_o_gdn = A.in[10]; const float* w_o_diff = A.in[18]; const float* w_out = A.in[19]; const float* w_router = A.in[21];
    const float* ws_gu = A.in[25]; const float* ws_dn = A.in[26];
    constexpr int I_WOA = 8 * 32, I_WOB = 8 * 32, I_WOUT = 16 * 32, I_SGU = 16 * 16, I_RT = 16 * 8, I_SD = 4 * 32;
    constexpr int NITEMS = I_WOA + I_WOB + I_WOUT + I_SGU + I_RT + I_SD;
    for (int it = w0; it < NITEMS; it += nw) {
        int r = it;
        if (r < I_WOA) { transpose_item(w_o_gdn, 1024, 512, (bf16_t*)(F.ws + WS_WOA), 0, 32, scr, r, lane, [](int n) { return n; }); continue; } r -= I_WOA;
        if (r < I_WOB) { transpose_item(w_o_diff, 1024, 512, (bf16_t*)(F.ws + WS_WOB), 0, 32, scr, r, lane, [](int n) { return n; }); continue; } r -= I_WOB;
        if (r < I_WOUT) { transpose_item(w_out, 1024, 1024, (bf16_t*)(F.ws + WS_WOUT), 0, 32, scr, r, lane, [](int n) { return n; }); continue; } r -= I_WOUT;
        if (r < I_SGU) { transpose_item(ws_gu, 512, 1024, (bf16_t*)(F.ws + WS_W9), 0, 16, scr, r, lane, [](int n) { const int i8 = n >> 3, j = n & 7; return j < 4 ? 4 * i8 + j : 256 + 4 * i8 + (j - 4); }); continue; } r -= I_SGU;
        if (r < I_RT) { transpose_item(w_router, 256, 1024, (bf16_t*)(F.ws + WS_W9), 512, 8, scr, r, lane, [](int n) { return n; }); continue; } r -= I_RT;
        transpose_item(ws_dn, 1024, 256, (bf16_t*)(F.ws + WS_WSD), 0, 32, scr, r, lane, [](int n) { return n; });
    }
}
__device__ __forceinline__ float mod_reduce(const float* modp, const float* b_ada, int idx) {
    return ((modp[idx] + modp[12288 + idx]) + (modp[2 * 12288 + idx] + modp[3 * 12288 + idx])) + b_ada[idx % 6144];
}
template <bool FROM_PARTIALS, bool WITH_BD>
__device__ __forceinline__ void norm_mod_phase(Frame& F, const Args& A, const float* src, const float* gain, int sh_off, int sc_off, bf16_t* dst) {
    LAS float* shs = (LAS float*)F.lds;
    LAS float* scs = shs + 2048;
    LAS float* wbd = scs + 2048;
    const float* modp = (const float*)(F.ws + WS_MODP); const float* b_ada = A.in[3]; float* mod = (float*)(F.ws + WS_MOD);
    for (int i = F.tid; i < 4096; i += NWAVES * 64) { const int b = i >> 11, r = i & 2047; const int idx = b * 6144 + (r < 1024 ? sh_off + r : sc_off + r - 1024);
        const float v = FROM_PARTIALS ? mod_reduce(modp, b_ada, idx) : mod[idx];
        if (r < 1024) shs[b * 1024 + r] = v; else scs[b * 1024 + r - 1024] = v; }
    if (WITH_BD) { const float* w_in = A.in[5]; for (int i = F.tid; i < 8192; i += NWAVES * 64) wbd[i] = w_in[(size_t)(i >> 3) * INC + 2048 + (i & 7)]; }
    if (FROM_PARTIALS) for (int idx = blockIdx.x * (NWAVES * 64) + F.tid; idx < 12288; idx += F.G * NWAVES * 64) mod[idx] = mod_reduce(modp, b_ada, idx);
    __syncthreads();
    const int gw = F.vcu * NWAVES + F.wave, NGW = F.G * NWAVES, lane = F.lane;
    for (int row = gw; row < T; row += NGW) {
        const int b = row / S; const float* xr = src + (size_t)row * D;
        f32x4 v[4]; float ss = 0.f;
#pragma unroll
        for (int j = 0; j < 4; ++j) { v[j] = *(const f32x4*)(xr + j * 256 + lane * 4); ss += (v[j][0] * v[j][0] + v[j][1] * v[j][1]) + (v[j][2] * v[j][2] + v[j][3] * v[j][3]); }
        const float rs = rsqrtf(wave_sum(ss) * (1.f / D) + EPS);
        float bacc[8];
#pragma unroll
        for (int q = 0; q < 8; ++q) bacc[q] = 0.f;
#pragma unroll
        for (int j = 0; j < 4; ++j) { const int col = j * 256 + lane * 4; const f32x4 gn = *(const f32x4*)(gain + col);
            const f32x4 sh = *(const LAS f32x4*)(shs + b * 1024 + col), sc = *(const LAS f32x4*)(scs + b * 1024 + col);
            f32x4 hv = (v[j] * rs * gn) * (sc + 1.f) + sh;
            uint2 w; w.x = pk2(hv[0], hv[1]); w.y = pk2(hv[2], hv[3]);
            *(uint2*)(dst + (size_t)row * D + col) = w;
            if (WITH_BD) {
#pragma unroll
                for (int i = 0; i < 4; ++i) { const f32x4 w0 = *(const LAS f32x4*)(wbd + (col + i) * 8), w1 = *(const LAS f32x4*)(wbd + (col + i) * 8 + 4);
                    bacc[0] += hv[i] * w0[0]; bacc[1] += hv[i] * w0[1]; bacc[2] += hv[i] * w0[2]; bacc[3] += hv[i] * w0[3];
                    bacc[4] += hv[i] * w1[0]; bacc[5] += hv[i] * w1[1]; bacc[6] += hv[i] * w1[2]; bacc[7] += hv[i] * w1[3]; } } }
        if (WITH_BD) {
#pragma unroll
            for (int q = 0; q < 8; ++q) bacc[q] = wave_sum(bacc[q]);
            if (lane == 0) { float* bd = (float*)(F.ws + WS_BD) + (size_t)row * 8; *(f32x4*)bd = (f32x4){bacc[0], bacc[1], bacc[2], bacc[3]}; *(f32x4*)(bd + 4) = (f32x4){bacc[4], bacc[5], bacc[6], bacc[7]}; } }
    }    if (WITH_BD) {
        LAS float* scr = (LAS float*)(F.lds + 49152 + F.wave * 8704);
        const float* w_in = A.in[5];
        for (int it = gw; it < 16 * 176; it += NGW) transpose_item(w_in, INC, 1024, (bf16_t*)(F.ws + WS_WIN), 0, 176, scr, it, lane, [](int n) { return n < 2048 ? n : n + 8; });
    }
}
__device__ __forceinline__ void route_phase(Frame& F, const Args& A) {
    const float* logits = (const float*)(F.ws + WS_LOGITS); const float* rbias = A.in[22];
    int* top_idx = (int*)(F.ws + WS_TOPI); float* top_w = (float*)(F.ws + WS_TOPW);
    unsigned* ecnt = (unsigned*)(F.ws + WS_CTL) + CW_ECNT; int* lists = (int*)(F.ws + WS_LIST);
    const int gw = F.vcu * NWAVES + F.wave, NGW = F.G * NWAVES, lane = F.lane;
    const f32x4 rb = *(const f32x4*)(rbias + lane * 4);
    for (int t = gw; t < T; t += NGW) {
        float sc[4], ch[4];
        const f32x4 lg = *(const f32x4*)(logits + (size_t)t * 256 + lane * 4);
#pragma unroll
        for (int i = 0; i < 4; ++i) { sc[i] = 1.f / (1.f + __expf(-lg[i])); ch[i] = sc[i] + rb[i]; }
        float a1 = fmaxf(ch[0], ch[1]), a2 = fminf(ch[0], ch[1]);
        { const float b1 = fmaxf(ch[2], ch[3]), b2 = fminf(ch[2], ch[3]); const float m1 = fmaxf(a1, b1), m2 = fmaxf(fminf(a1, b1), fmaxf(a2, b2)); a1 = m1; a2 = m2; }
#pragma unroll
        for (int o = 1; o < 8; o <<= 1) { const float b1 = __shfl_xor(a1, o), b2 = __shfl_xor(a2, o); const float m1 = fmaxf(a1, b1), m2 = fmaxf(fminf(a1, b1), fmaxf(a2, b2)); a1 = m1; a2 = m2; }
        const float gs = a1 + a2; const int g = lane >> 3;
        int rank = 0;
#pragma unroll
        for (int gg = 0; gg < 8; ++gg) { const float o = __shfl(gs, gg * 8); rank += (o > gs || (o == gs && gg < g)) ? 1 : 0; }
        const bool sel = rank < 4;
        float mc[4];
#pragma unroll
        for (int i = 0; i < 4; ++i) mc[i] = sel ? ch[i] : -INFINITY;
        int my_idx = 0; float my_sc = 0.f, sum = 0.f;
#pragma unroll
        for (int r = 0; r < 8; ++r) {
            float bv = mc[0]; int bi = 0;
#pragma unroll
            for (int i = 1; i < 4; ++i) if (mc[i] > bv) { bv = mc[i]; bi = i; }
            int be = lane * 4 + bi;
#pragma unroll
            for (int o = 1; o < 64; o <<= 1) { const float ov = __shfl_xor(bv, o); const int oe = __shfl_xor(be, o); if (ov > bv || (ov == bv && oe < be)) { bv = ov; be = oe; } }
            float s = 0.f;
            if ((be >> 2) == lane) { const int b2 = be & 3;
                s = b2 == 0 ? sc[0] : b2 == 1 ? sc[1] : b2 == 2 ? sc[2] : sc[3];
                if (b2 == 0) mc[0] = -INFINITY; else if (b2 == 1) mc[1] = -INFINITY; else if (b2 == 2) mc[2] = -INFINITY; else mc[3] = -INFINITY; }
            s = __shfl(s, be >> 2);
            sum += s;
            if (lane == r) { my_idx = be; my_sc = s; }
        }
        if (lane < 8) { top_idx[t * 8 + lane] = my_idx; top_w[t * 8 + lane] = my_sc / sum * 2.5f;
            const unsigned slot = __hip_atomic_fetch_add(ecnt + my_idx, 1u, __ATOMIC_RELAXED, __HIP_MEMORY_SCOPE_AGENT);
            lists[(size_t)my_idx * T + slot] = t * 8 + lane; }
    }
}

typedef float f32x16 __attribute__((ext_vector_type(16)));
constexpr int XT = 256;
constexpr int XA_OFF = 0, XA_STAGE = 16384;
constexpr int XWP_OFF = 32768, XWP_WAVE = 2048;
constexpr int XYS_OFF = 49152, XYS_WAVE = 2560, XYS_STRIDE = 80;
constexpr int XCNT_OFF = XYS_OFF + 8 * XYS_WAVE;
static_assert(XCNT_OFF + 1024 <= CTRL_OFF, "MoE LDS map");
constexpr int CW_MQ = 1024;

struct WRegs { f32x4 v[4]; };
__device__ __forceinline__ void xw_load(WRegs& R, const float* wb, unsigned wo, int ldw, int k0) {
    const float* p = wb + (size_t)k0 * ldw + wo;
#pragma unroll
    for (int i = 0; i < 4; ++i) R.v[i] = *(const f32x4*)(p + (size_t)i * ldw);
}
__device__ __forceinline__ void xw_store(const WRegs& R, LAS unsigned char* wd) {
#pragma unroll
    for (int j = 0; j < 4; ++j) { u32x2 o; o.x = pg8::cvt_pk_bf16(R.v[0][j], R.v[1][j]); o.y = pg8::cvt_pk_bf16(R.v[2][j], R.v[3][j]); *(LAS u32x2*)(wd + j * 16) = o; }
}
template <int NS, int NP, class WOff, class Epi>
__device__ __forceinline__ void xpasses(Frame& F, f32x16 (&acc)[8], const unsigned char* ab0, unsigned o0, unsigned o1, const float* wb, int ldw, WOff wo, Epi epi,
                                        LAS unsigned char* wp, LAS unsigned char* wd, LAS unsigned char* ast, int rd_t0, int rd_t1, int rd_w) {
    LAS unsigned char* lds = F.lds;
    WRegs R[2]; v4u ra[2][2];
#pragma unroll
    for (int tt = 0; tt < 8; ++tt)
#pragma unroll
        for (int q = 0; q < 16; ++q) acc[tt][q] = 0.f;
    asm volatile("s_waitcnt vmcnt(0) lgkmcnt(0)" ::: "memory"); __builtin_amdgcn_s_barrier();
    { const unsigned w0 = wo(0);
      const v4u p0 = *(const v4u*)(ab0 + o0), p1 = *(const v4u*)(ab0 + o1);
      xw_load(R[0], wb, w0, ldw, 0); xw_load(R[1], wb, w0, ldw, 32);
      ra[1][0] = *(const v4u*)(ab0 + 64 + o0); ra[1][1] = *(const v4u*)(ab0 + 64 + o1);
      *(LAS v4u*)ast = p0; *(LAS v4u*)(ast + 1024) = p1; xw_store(R[0], wd); }
    asm volatile("s_waitcnt lgkmcnt(0)" ::: "memory"); __builtin_amdgcn_s_barrier();
#pragma unroll 1
    for (int p = 0; p < NP; ++p) {
        const unsigned wcur = wo(p), wnxt = wo(p + 1 < NP ? p + 1 : p);
#pragma unroll 1
        for (int s2 = 0; s2 < NS; s2 += 2) {
#pragma unroll
            for (int j = 0; j < 2; ++j) { const int s = s2 + j;
                {
                  const bool wrap = s + 2 >= NS; const bool last = p + 1 >= NP;
                  const int sl = wrap ? (last ? NS - 1 : s + 2 - NS) : s + 2;
                  xw_load(R[j], wb, wrap ? wnxt : wcur, ldw, sl * 32); const unsigned char* ap = ab0 + sl * 64; ra[j][0] = *(const v4u*)(ap + o0); ra[j][1] = *(const v4u*)(ap + o1); }
                const LAS unsigned char* ab = lds + XA_OFF + j * XA_STAGE;
#pragma unroll
                for (int ks = 0; ks < 2; ++ks) { const bf16x8 wf = *(const LAS bf16x8*)(wp + rd_w + ks * 1024);
                    bf16x8 tf[8];
#pragma unroll
                    for (int tt = 0; tt < 8; ++tt) tf[tt] = *(const LAS bf16x8*)(ab + (ks ? rd_t1 : rd_t0) + tt * 2048);
#pragma unroll
                    for (int tt = 0; tt < 8; ++tt) acc[tt] = __builtin_amdgcn_mfma_f32_32x32x16_bf16(wf, tf[tt], acc[tt], 0, 0, 0); }
                { asm volatile("s_waitcnt lgkmcnt(0)" ::: "memory"); xw_store(R[j ^ 1], wd);
                  LAS unsigned char* d = ast + (j ^ 1) * XA_STAGE; *(LAS v4u*)d = ra[j ^ 1][0]; *(LAS v4u*)(d + 1024) = ra[j ^ 1][1]; }
                asm volatile("s_waitcnt lgkmcnt(0)" ::: "memory"); __builtin_amdgcn_s_barrier();
            }
        }
        epi(p);
#pragma unroll
        for (int tt = 0; tt < 8; ++tt)
#pragma unroll
            for (int q = 0; q < 16; ++q) acc[tt][q] = 0.f;
    }
}

__device__ __forceinline__ void moe_item(Frame& F, const Args& A, int e, int rt, int total) {
    const int lane = F.lane, wave = F.wave, r31 = lane & 31, hi = lane >> 5;
    LAS unsigned char* lds = F.lds;
    const int* list = (const int*)(F.ws + WS_LIST) + (size_t)e * T;
    const float* top_w = (const float*)(F.ws + WS_TOPW);
    const unsigned char* hsrc = F.ws + WS_H; bf16_t* Y = (bf16_t*)(F.ws + WS_Y);
    unsigned char* xb = F.ws + WS_XA + (size_t)blockIdx.x * XA_BLOCK;
    const float* W1 = A.in[23] + (size_t)e * 1024 * 512; const float* W2 = A.in[24] + (size_t)e * 256 * 1024;
    const int r0 = rt * XT;
    LAS unsigned char* wp = lds + XWP_OFF + wave * XWP_WAVE;
    const int kgrp = lane >> 3;
    LAS unsigned char* wd = wp + ((kgrp >> 1) * 32 + 4 * (lane & 7)) * 16 + (kgrp & 1) * 8;
    const int rl0 = wave * 32 + (lane >> 2), rl1 = rl0 + 16;
    const unsigned sw0 = (unsigned)(((lane & 3) ^ ((rl0 >> 2) & 3)) * 16), sw1 = (unsigned)(((lane & 3) ^ ((rl1 >> 2) & 3)) * 16);
    unsigned g0, g1;
    { int ra_ = r0 + rl0; ra_ = ra_ < total ? ra_ : r0; int rb_ = r0 + rl1; rb_ = rb_ < total ? rb_ : r0;
      g0 = (unsigned)(list[ra_] >> 3) * 2048u + sw0; g1 = (unsigned)(list[rb_] >> 3) * 2048u + sw1; }
    LAS unsigned char* ast = lds + XA_OFF + wave * 2048 + lane * 16;
    const int rd_t0 = r31 * 64 + ((hi ^ ((r31 >> 2) & 3)) * 16), rd_t1 = r31 * 64 + (((2 + hi) ^ ((r31 >> 2) & 3)) * 16);
    const int rd_w = (hi * 32 + r31) * 16;
    f32x16 acc[8];
    xpasses<32, 2>(F, acc, hsrc, g0, g1, W1, 512,
        [&](int p) { return (unsigned)(((lane & 4) ? 256 + 128 * p + 16 * wave : 128 * p + 16 * wave) + 4 * (lane & 3) + (4 * kgrp) * 512); },
        [&](int p) {
            int ln = lane; asm volatile("" : "+v"(ln)); const int e31 = ln & 31, ehi = ln >> 5;
#pragma unroll
            for (int tt = 0; tt < 8; ++tt) { const int rl = 32 * tt + e31; const int r = r0 + rl; const float rw = r < total ? top_w[list[r]] : 0.f;
#pragma unroll
                for (int g = 0; g < 2; ++g) { float a[4];
#pragma unroll
                    for (int q = 0; q < 4; ++q) { const float gt = acc[tt][4 * g + q], up = acc[tt][8 + 4 * g + q]; a[q] = gt / (1.f + __expf(-gt)) * up * rw; }
                    u32x2 w; w.x = pg8::cvt_pk_bf16(a[0], a[1]); w.y = pg8::cvt_pk_bf16(a[2], a[3]);
                    *(u32x2*)(xb + (unsigned)(rl * 512 + (128 * p + 16 * wave + 8 * g + 4 * ehi) * 2)) = w; } } },
        wp, wd, ast, rd_t0, rd_t1, rd_w);
    const unsigned x0 = (unsigned)(rl0 * 512) + sw0, x1 = (unsigned)(rl1 * 512) + sw1;
    xpasses<8, 4>(F, acc, xb, x0, x1, W2, 1024,
        [&](int q4) { return (unsigned)(256 * q4 + 32 * wave + 4 * (lane & 7) + (4 * kgrp) * 1024); },
        [&](int q4) {
            const int col0 = 256 * q4 + 32 * wave;
            int ln = lane; asm volatile("" : "+v"(ln)); const int e31 = ln & 31, ehi = ln >> 5;
            LAS unsigned char* ys = lds + XYS_OFF + wave * XYS_WAVE;
#pragma unroll
            for (int tt = 0; tt < 8; ++tt) {
#pragma unroll
                for (int g = 0; g < 4; ++g) { u32x2 w; w.x = pg8::cvt_pk_bf16(acc[tt][4 * g], acc[tt][4 * g + 1]); w.y = pg8::cvt_pk_bf16(acc[tt][4 * g + 2], acc[tt][4 * g + 3]);
                    *(LAS u32x2*)(ys + e31 * XYS_STRIDE + (8 * g + 4 * ehi) * 2) = w; }
                asm volatile("s_waitcnt lgkmcnt(0)" ::: "memory");
#pragma unroll
                for (int pp = 0; pp < 2; ++pp) { const int rl = 16 * pp + (ln >> 2); const int r = r0 + 32 * tt + rl;
                    const v4u v = *(const LAS v4u*)(ys + rl * XYS_STRIDE + (ln & 3) * 16);
                    if (r < total) *(v4u*)(Y + (size_t)list[r] * 1024 + col0 + (ln & 3) * 8) = v; }
                asm volatile("s_waitcnt lgkmcnt(0)" ::: "memory");
            } },
        wp, wd, ast, rd_t0, rd_t1, rd_w);
}

__device__ __forceinline__ void moe_phase(Frame& F, const Args& A, int rep = 0) {
    LAS int* cnts = (LAS int*)(F.lds + XCNT_OFF);
    const unsigned* ecnt = (const unsigned*)(F.ws + WS_CTL) + CW_ECNT;
    unsigned* mq = (unsigned*)(F.ws + WS_CTL) + CW_MQ + 1024 * rep;
    volatile LAS int* slot = (volatile LAS int*)(F.lds + CTRL_OFF + 64);
    if (F.tid < 256) cnts[F.tid] = (int)ecnt[F.tid];
    __syncthreads();
    const int x0 = (int)(xb_xcc_id() & 7u);
    for (int xi = 0; xi < 8; ++xi) {
        const int x = (x0 + xi) & 7;
        int ntiles = 0;
#pragma unroll 1
        for (int i = 0; i < 32; ++i) ntiles += (cnts[x + 8 * i] + XT - 1) / XT;
        for (;;) {
            __syncthreads();
            if (F.tid == 0) slot[0] = (int)__hip_atomic_fetch_add(mq + 64 * x, 1u, __ATOMIC_RELAXED, __HIP_MEMORY_SCOPE_AGENT);
            __syncthreads();
            int k = slot[0];
            if (k >= ntiles) break;
            int e = x, tot = 0;
#pragma unroll 1
            for (int i = 0; i < 32; ++i) { const int c = cnts[x + 8 * i], t = (c + XT - 1) / XT; if (k < t) { e = x + 8 * i; tot = c; break; } k -= t; }
            moe_item(F, A, __builtin_amdgcn_readfirstlane(e), __builtin_amdgcn_readfirstlane(k), __builtin_amdgcn_readfirstlane(tot));
        }
    }
}
__device__ __forceinline__ void attn_prep_phase(Frame& F, const Args& A) {
    const bf16_t* P = (const bf16_t*)(F.ws + WS_P); bf16_t* QN = (bf16_t*)(F.ws + WS_QN); bf16_t* KN = (bf16_t*)(F.ws + WS_KN);
    const float* qg = A.in[11]; const float* kg = A.in[12];
    const int gw = F.vcu * NWAVES + F.wave, NGW = F.G * NWAVES, lane = F.lane;
    f32x4 gq0 = *(const f32x4*)(qg + (lane & 7) * 8), gq1 = *(const f32x4*)(qg + (lane & 7) * 8 + 4);
    f32x4 gk0 = *(const f32x4*)(kg + (lane & 7) * 8), gk1 = *(const f32x4*)(kg + (lane & 7) * 8 + 4);
    for (int t = gw; t < T; t += NGW) {
#pragma unroll
        for (int which = 0; which < 2; ++which) {
            const v4u w = *(const v4u*)(P + (size_t)t * LDP + (which ? C_KB : C_QB) + lane * 8);
            float v[8] = {pg8::bflo(w.x), pg8::bfhi(w.x), pg8::bflo(w.y), pg8::bfhi(w.y), pg8::bflo(w.z), pg8::bfhi(w.z), pg8::bflo(w.w), pg8::bfhi(w.w)};
            float ss = 0.f;
#pragma unroll
            for (int i = 0; i < 8; ++i) ss += v[i] * v[i];
            ss += __shfl_xor(ss, 1); ss += __shfl_xor(ss, 2); ss += __shfl_xor(ss, 4);
            const float r = rsqrtf(ss * (1.f / 64.f) + EPS) * (which ? 1.f : 0.125f * 1.4426950408889634f);
            const f32x4 g0 = which ? gk0 : gq0, g1 = which ? gk1 : gq1;
            v4u o; o.x = pk2(v[0] * r * g0[0], v[1] * r * g0[1]); o.y = pk2(v[2] * r * g0[2], v[3] * r * g0[3]); o.z = pk2(v[4] * r * g1[0], v[5] * r * g1[1]); o.w = pk2(v[6] * r * g1[2], v[7] * r * g1[3]);
            *(v4u*)((which ? KN : QN) + (size_t)t * 512 + lane * 8) = o;
        }
    }
}

typedef short s16x4 __attribute__((ext_vector_type(4)));
constexpr int AT_KPLANE = 1040;
constexpr int AT_KBYTES = 8 * AT_KPLANE;
constexpr int AT_VROW = 320;
constexpr int AT_VBYTES = 64 * AT_VROW;
constexpr int AT_BUF = AT_KBYTES + AT_VBYTES;
template <int OFF> __device__ __forceinline__ s16x4 tr_read(int vb) {
    s16x4 r; asm volatile("ds_read_b64_tr_b16 %0, %1 offset:%2" : "=&v"(r) : "v"(vb), "i"(OFF) : "memory"); return r;
}
template <int ND> __device__ __forceinline__ void pv_one(f32x16& od, int vb, const bf16x8 (&pf)[4]) {
#define VOFF(mt, s, half) (AT_KBYTES + (32 * (mt) + 16 * (s) + 8 * (half)) * AT_VROW + ND * 64)
    const s16x4 a0 = tr_read<VOFF(0, 0, 0)>(vb), b0 = tr_read<VOFF(0, 0, 1)>(vb), a1 = tr_read<VOFF(0, 1, 0)>(vb), b1 = tr_read<VOFF(0, 1, 1)>(vb);
    const s16x4 a2 = tr_read<VOFF(1, 0, 0)>(vb), b2 = tr_read<VOFF(1, 0, 1)>(vb), a3 = tr_read<VOFF(1, 1, 0)>(vb), b3 = tr_read<VOFF(1, 1, 1)>(vb);
#undef VOFF
    asm volatile("s_waitcnt lgkmcnt(0)" ::: "memory"); __builtin_amdgcn_sched_barrier(0);
#define PK(L, H) (bf16x8){L[0], L[1], L[2], L[3], H[0], H[1], H[2], H[3]}
    od = __builtin_amdgcn_mfma_f32_32x32x16_bf16(PK(a0, b0), pf[0], od, 0, 0, 0);
    od = __builtin_amdgcn_mfma_f32_32x32x16_bf16(PK(a1, b1), pf[1], od, 0, 0, 0);
    od = __builtin_amdgcn_mfma_f32_32x32x16_bf16(PK(a2, b2), pf[2], od, 0, 0, 0);
    od = __builtin_amdgcn_mfma_f32_32x32x16_bf16(PK(a3, b3), pf[3], od, 0, 0, 0);
#undef PK
}
__device__ __forceinline__ void attn_unit(Frame& F, int b, int h, int c, int qb) {
    const int tid = F.tid, lane = F.lane, wave = F.wave, r32 = lane & 31, hi = lane >> 5;
    LAS unsigned char* lds = F.lds;
    const bf16_t* QN = (const bf16_t*)(F.ws + WS_QN); const bf16_t* KN = (const bf16_t*)(F.ws + WS_KN); const bf16_t* P = (const bf16_t*)(F.ws + WS_P);
    const float sl2 = exp2f(-2.f * (float)(h + 1)) * 1.4426950408889634f;
    const float M2 = ((const float*)(F.ws + WS_SCAL))[1];
    const int tq = qb * 256 + wave * 32 + r32;
    const int ctw = 4 * qb + (wave >> 1), ntiles = 4 * qb + 4;
    const float dmax = (2.f * M2 + 40.f) / sl2 + 63.f;
    int tile_lo = (int)ceilf(((float)(qb * 256 - 63) - dmax) * (1.f / 64.f)); tile_lo = tile_lo < 0 ? 0 : tile_lo;
    tile_lo = __builtin_amdgcn_readfirstlane(tile_lo);
    bf16x8 qf[4];
    { const bf16_t* qp = QN + (size_t)(b * S + tq) * 512 + h * 128 + c * 64 + hi * 8;
#pragma unroll
      for (int ks = 0; ks < 4; ++ks) qf[ks] = *(const bf16x8*)(qp + 16 * ks); }
    float koffs[16];
#pragma unroll
    for (int r = 0; r < 16; ++r) koffs[r] = sl2 * (float)((r & 3) + 8 * (r >> 2) + 4 * hi);
    f32x16 oacc[4];
#pragma unroll
    for (int nd = 0; nd < 4; ++nd)
#pragma unroll
        for (int r = 0; r < 16; ++r) oacc[nd][r] = 0.f;
    float lsum = 0.f;
    const int s_key = tid >> 3, s_kg = tid & 7;
    const bf16_t* kg_src = KN + (size_t)(b * S + s_key) * 512 + h * 128 + c * 64 + s_kg * 8;
    const bf16_t* vg_src = P + (size_t)(b * S + s_key) * LDP + C_VB + h * 128 + s_kg * 8;
    const int st_k = s_kg * AT_KPLANE + s_key * 16, st_v = AT_KBYTES + s_key * AT_VROW + s_kg * 16;
    const int rd_k = hi * AT_KPLANE + r32 * 16;
    const int rd_v = (hi * 4 + ((lane & 15) >> 2)) * AT_VROW + ((lane >> 4) & 1) * 32 + (lane & 3) * 8;
    v4u rk, rv0, rv1;
    auto gload = [&](int tile) { rk = *(const v4u*)(kg_src + (size_t)tile * 64 * 512); const bf16_t* vp = vg_src + (size_t)tile * 64 * LDP; rv0 = *(const v4u*)vp; rv1 = *(const v4u*)(vp + 64); };
    auto lstore = [&](int buf) { LAS unsigned char* bb = lds + buf * AT_BUF; *(LAS v4u*)(bb + st_k) = rk; *(LAS v4u*)(bb + st_v) = rv0; *(LAS v4u*)(bb + st_v + 128) = rv1; };
    __syncthreads();
    gload(tile_lo); lstore(tile_lo & 1); __syncthreads();
    for (int tile = tile_lo; tile < ntiles; ++tile) {
        gload(tile + 1 < ntiles ? tile + 1 : tile);
        if (tile <= ctw) {
            const LAS unsigned char* kb = lds + (tile & 1) * AT_BUF;
            f32x16 sacc[2];
            if (tile != ctw) {
                const float ct = sl2 * (float)(64 * tile - tq) - M2;
#pragma unroll
                for (int mt = 0; mt < 2; ++mt)
#pragma unroll
                    for (int r = 0; r < 16; ++r) sacc[mt][r] = koffs[r] + (ct + sl2 * 32.f * mt);
            } else {
                const float base = sl2 * (float)(64 * tile - tq);
#pragma unroll
                for (int mt = 0; mt < 2; ++mt)
#pragma unroll
                    for (int r = 0; r < 16; ++r) sacc[mt][r] = -fabsf(koffs[r] + (base + sl2 * 32.f * mt)) - M2;
            }
#pragma unroll
            for (int ks = 0; ks < 4; ++ks)
#pragma unroll
                for (int mt = 0; mt < 2; ++mt) { const bf16x8 kf = *(const LAS bf16x8*)(kb + rd_k + ks * 2 * AT_KPLANE + mt * 512);
                    sacc[mt] = __builtin_amdgcn_mfma_f32_32x32x16_bf16(kf, qf[ks], sacc[mt], 0, 0, 0); }
            bf16x8 pf[4];
#pragma unroll
            for (int mt = 0; mt < 2; ++mt) {
#pragma unroll
                for (int r = 0; r < 16; ++r) { const float p = __builtin_amdgcn_exp2f(sacc[mt][r]); lsum += p; sacc[mt][r] = p; }
#pragma unroll
                for (int s = 0; s < 2; ++s) { v4u w;
                    w.x = pg8::cvt_pk_bf16(sacc[mt][8 * s + 0], sacc[mt][8 * s + 1]); w.y = pg8::cvt_pk_bf16(sacc[mt][8 * s + 2], sacc[mt][8 * s + 3]);
                    w.z = pg8::cvt_pk_bf16(sacc[mt][8 * s + 4], sacc[mt][8 * s + 5]); w.w = pg8::cvt_pk_bf16(sacc[mt][8 * s + 6], sacc[mt][8 * s + 7]);
                    pf[mt * 2 + s] = __builtin_bit_cast(bf16x8, w); }
            }
            const int vb = (int)(uintptr_t)kb + rd_v;
            pv_one<0>(oacc[0], vb, pf); pv_one<1>(oacc[1], vb, pf); pv_one<2>(oacc[2], vb, pf); pv_one<3>(oacc[3], vb, pf);
        }
        lstore((tile + 1) & 1);
        __syncthreads();
    }
    lsum += __shfl_xor(lsum, 32);
    const float inv = 1.f / lsum;
    bf16_t* ob = (bf16_t*)(F.ws + WS_OB) + (size_t)c * T * 512 + (size_t)(b * S + tq) * 512 + h * 128 + 4 * hi;
#pragma unroll
    for (int nd = 0; nd < 4; ++nd)
#pragma unroll
        for (int g = 0; g < 4; ++g) { uint2 w; w.x = pk2(oacc[nd][4 * g] * inv, oacc[nd][4 * g + 1] * inv); w.y = pk2(oacc[nd][4 * g + 2] * inv, oacc[nd][4 * g + 3] * inv);
            *(uint2*)(ob + 32 * nd + 8 * g) = w; }
}
__device__ __forceinline__ void post_norm_phase(Frame& F, const Args& A) {
    const float* oa = (const float*)(F.ws + WS_OA); const bf16_t* ob = (const bf16_t*)(F.ws + WS_OB); const bf16_t* P = (const bf16_t*)(F.ws + WS_P);
    bf16_t* oan = (bf16_t*)(F.ws + WS_OAN); bf16_t* obn = (bf16_t*)(F.ws + WS_OBN);
    const float* gg = A.in[9]; const float* sg = A.in[17];
    const float lam = ((const float*)(F.ws + WS_SCAL))[0];
    const int gw = F.vcu * NWAVES + F.wave, NGW = F.G * NWAVES, lane = F.lane;
    const int gc = (lane & 15) * 8;
    const f32x4 g0 = *(const f32x4*)(gg + gc), g1 = *(const f32x4*)(gg + gc + 4), s0 = *(const f32x4*)(sg + gc), s1 = *(const f32x4*)(sg + gc + 4);
    for (int t = gw; t < T; t += NGW) {
        { const f32x4 a0 = *(const f32x4*)(oa + (size_t)t * 512 + lane * 8), a1 = *(const f32x4*)(oa + (size_t)t * 512 + lane * 8 + 4);
          float ss = (a0[0] * a0[0] + a0[1] * a0[1]) + (a0[2] * a0[2] + a0[3] * a0[3]) + (a1[0] * a1[0] + a1[1] * a1[1]) + (a1[2] * a1[2] + a1[3] * a1[3]);
          ss += __shfl_xor(ss, 1); ss += __shfl_xor(ss, 2); ss += __shfl_xor(ss, 4); ss += __shfl_xor(ss, 8);
          const float r = rsqrtf(ss * (1.f / 128.f) + EPS);
          const v4u zw = *(const v4u*)(P + (size_t)t * LDP + C_ZA + lane * 8);
          const float z[8] = {pg8::bflo(zw.x), pg8::bfhi(zw.x), pg8::bflo(zw.y), pg8::bfhi(zw.y), pg8::bflo(zw.z), pg8::bfhi(zw.z), pg8::bflo(zw.w), pg8::bfhi(zw.w)};
          float o[8];
#pragma unroll
          for (int i = 0; i < 4; ++i) { o[i] = a0[i] * r * g0[i] * siluf(z[i]); o[4 + i] = a1[i] * r * g1[i] * siluf(z[4 + i]); }
          v4u w; w.x = pk2(o[0], o[1]); w.y = pk2(o[2], o[3]); w.z = pk2(o[4], o[5]); w.w = pk2(o[6], o[7]);
          *(v4u*)(oan + (size_t)t * 512 + lane * 8) = w; }
        { const v4u w1 = *(const v4u*)(ob + (size_t)t * 512 + lane * 8), w2 = *(const v4u*)(ob + (size_t)T * 512 + (size_t)t * 512 + lane * 8);
          float d[8] = {pg8::bflo(w1.x) - lam * pg8::bflo(w2.x), pg8::bfhi(w1.x) - lam * pg8::bfhi(w2.x), pg8::bflo(w1.y) - lam * pg8::bflo(w2.y), pg8::bfhi(w1.y) - lam * pg8::bfhi(w2.y),
                        pg8::bflo(w1.z) - lam * pg8::bflo(w2.z), pg8::bfhi(w1.z) - lam * pg8::bfhi(w2.z), pg8::bflo(w1.w) - lam * pg8::bflo(w2.w), pg8::bfhi(w1.w) - lam * pg8::bfhi(w2.w)};
          float ss = 0.f;
#pragma unroll
          for (int i = 0; i < 8; ++i) ss += d[i] * d[i];
          ss += __shfl_xor(ss, 1); ss += __shfl_xor(ss, 2); ss += __shfl_xor(ss, 4); ss += __shfl_xor(ss, 8);
          const float r = rsqrtf(ss * (1.f / 128.f) + EPS) * (1.f - LAM_INIT);
          v4u w; w.x = pk2(d[0] * r * s0[0], d[1] * r * s0[1]); w.y = pk2(d[2] * r * s0[2], d[3] * r * s0[3]); w.z = pk2(d[4] * r * s1[0], d[5] * r * s1[1]); w.w = pk2(d[6] * r * s1[2], d[7] * r * s1[3]);
          *(v4u*)(obn + (size_t)t * 512 + lane * 8) = w; }
    }
}
constexpr int GD_KA = 0, GD_QA = 17408, GD_VN = 34816, GD_KB = 55296, GD_LM = 75776, GD_T1 = 93184, GD_T2 = 102400, GD_SC = 111616;
constexpr int GD_AQ = 114688;
constexpr int GD_SA = 272, GD_SB = 320, GD_SL = 272, GD_ST = 144;
constexpr size_t GDN_WF = 0, GDN_QF = 16384, GDN_AF = 32768, GDN_KF = 40960, GDN_UF = 57344, GDN_EG = 90112, GDN_ITEM = 90368;
__device__ __forceinline__ int perm16_h(int n) { return (n >> 2) & 1; }
__device__ __forceinline__ int perm16_j(int n) { return (n & 3) + 4 * (n >> 3); }

#ifndef PROBE_SC1
#define PROBE_SC1 0
#endif
#ifndef PROBE_PUB
#define PROBE_PUB 0
#endif
#ifndef PROBE_INPH
#define PROBE_INPH 1
#endif
constexpr int CW_GFLAG = 8192;
constexpr int CW_PQ = 96;
__device__ __forceinline__ void gst16(unsigned char* p, v4u v, bool wt) {
    if (wt) asm volatile("global_store_dwordx4 %0, %1, off sc0 sc1" :: "v"(p), "v"(v) : "memory"); else *(v4u*)p = v; }
__device__ __forceinline__ void gst4(float* p, float v, bool wt) {
    if (wt) asm volatile("global_store_dword %0, %1, off sc0 sc1" :: "v"(p), "v"(v) : "memory"); else *p = v; }
__device__ __forceinline__ void gdn_prep_item(Frame& F, const Args& A, int item, bool publish = false) {
    const int tid = F.tid, lane = F.lane, wave = F.wave, r32 = lane & 31, hi = lane >> 5;
    LAS unsigned char* lds = F.lds;
    const int b = item >> 9, h = (item >> 7) & 3, n = item & 127;
    const int t0 = b * S + n * 64;
    const bf16_t* P = (const bf16_t*)(F.ws + WS_P); const float* bd = (const float*)(F.ws + WS_BD);
    unsigned char* gi = F.ws + WS_GDN + (size_t)item * GDN_ITEM;
    LAS float* sc_g = (LAS float*)(lds + GD_SC);
    LAS float* sc_b = sc_g + 64;
    LAS float* sc_e = sc_g + 128;
    LAS float* sc_l = sc_g + 192;
#ifndef NO_S1
    if (tid < 128) *((LAS float*)(lds + GD_SC + 1024) + tid) = (tid == 63) ? 1.f : 0.f;
    {
        const float* cw = A.in[6];
        float w[3][4][2];
#pragma unroll
        for (int p = 0; p < 3; ++p)
#pragma unroll
            for (int j = 0; j < 4; ++j) { const float2 t = *(const float2*)(cw + j * 1536 + p * 512 + h * 128 + 2 * lane); w[p][j][0] = t.x; w[p][j][1] = t.y; }
        const int rl0 = n * 64 + wave * 8;
#pragma unroll
        for (int p = 0; p < 3; ++p) {
            float x[11][2];
#pragma unroll
            for (int i = 0; i < 11; ++i) { const int tl = rl0 - 3 + i; unsigned u = 0u;
                if (tl >= 0) u = *(const unsigned*)(P + (size_t)(b * S + tl) * LDP + p * 512 + h * 128 + 2 * lane);
                x[i][0] = pg8::bflo(u); x[i][1] = pg8::bfhi(u); }
#pragma unroll
            for (int r = 0; r < 8; ++r) {
                float a0 = 0.f, a1 = 0.f;
#pragma unroll
                for (int j = 0; j < 4; ++j) { a0 += x[r + j][0] * w[p][j][0]; a1 += x[r + j][1] * w[p][j][1]; }
                a0 = siluf(a0); a1 = siluf(a1);
                const int row = wave * 8 + r;
                if (p < 2) { const float ss = wave_sum(a0 * a0 + a1 * a1); const float rs = rsqrtf(ss + EPS) * (p == 0 ? 0.08838834764831845f : 1.f); a0 *= rs; a1 *= rs; }
                const unsigned pk = pk2(a0, a1);
                if (p == 0) *(LAS unsigned*)(lds + GD_QA + row * GD_SA + lane * 4) = pk;
                else if (p == 1) { *(LAS unsigned*)(lds + GD_KA + row * GD_SA + lane * 4) = pk; *(LAS unsigned*)(lds + GD_KB + row * GD_SB + lane * 4) = pk; }
                else *(LAS unsigned*)(lds + GD_VN + row * GD_SB + lane * 4) = pk;
            }
        }
        if (wave == 0) {
            const float bl = bd[(size_t)(t0 + lane) * 8 + h], dl = bd[(size_t)(t0 + lane) * 8 + 4 + h];
            const float beta = 1.f / (1.f + __expf(-bl));
            float g = -expf(A.in[7][h]) * softplusf(dl + A.in[8][h]);
#pragma unroll
            for (int o = 1; o < 64; o <<= 1) { const float up = __shfl_up(g, o); if (lane >= o) g += up; }
            const float glast = __shfl(g, 63);
            sc_g[lane] = g; sc_b[lane] = beta; sc_e[lane] = __expf(g); sc_l[lane] = __expf(glast - g);
            if (lane == 0) gst4((float*)(gi + GDN_EG), __expf(glast), publish);
        }
    }
#endif
    __syncthreads();
#ifndef NO_S2
    {
        const int which = wave >> 2, ti = (wave >> 1) & 1, tj = wave & 1;
        f32x16 acc;
#pragma unroll
        for (int r = 0; r < 16; ++r) acc[r] = 0.f;
        if (ti >= tj) {
            const LAS unsigned char* ap = lds + (which ? GD_QA : GD_KA) + (32 * ti + r32) * GD_SA + hi * 16;
            const LAS unsigned char* bp = lds + GD_KA + (32 * tj + r32) * GD_SA + hi * 16;
#pragma unroll
            for (int ks = 0; ks < 8; ++ks) acc = __builtin_amdgcn_mfma_f32_32x32x16_bf16(*(const LAS bf16x8*)(ap + ks * 32), *(const LAS bf16x8*)(bp + ks * 32), acc, 0, 0, 0);
        }
        const int j = 32 * tj + r32; const float Gj = sc_g[j];
        const int ibase = 32 * ti + 4 * hi, dij = ibase - j;
        const LAS float* gp = sc_g + ibase; const LAS float* bp2 = sc_b + ibase;
        if (which == 0) {
            LAS float* lm = (LAS float*)(lds + GD_LM + ibase * GD_SL + j * 4);
#pragma unroll
            for (int r = 0; r < 16; ++r) { const int off = (r & 3) + 8 * (r >> 2);
                const float v = (off + dij > 0) ? bp2[off] * acc[r] * __expf(fminf(gp[off] - Gj, 0.f)) : 0.f;
                lm[off * (GD_SL / 4)] = v; }
        } else {
            LAS bf16_t* aq = (LAS bf16_t*)(lds + GD_AQ) + ibase * 72 + j;
#pragma unroll
            for (int r = 0; r < 16; ++r) { const int off = (r & 3) + 8 * (r >> 2);
                const float v = (off + dij >= 0) ? acc[r] * __expf(fminf(gp[off] - Gj, 0.f)) : 0.f;
                aq[off * 72] = (bf16_t)f2bf(v); }
        }
    }
#endif
    __syncthreads();
#ifndef NO_S3
    if (wave == 0) {
        int ln = lane; asm volatile("" : "+v"(ln));
        LAS unsigned char* lmb = lds + GD_LM; asm volatile("" : "+v"(lmb));
        const LAS float* zz = (const LAS float*)(lds + GD_SC + 1024) + ln;
        float t[64];
#pragma unroll
        for (int i = 0; i < 64; ++i) {
            float s = zz[63 - i];
            const LAS float* Li = (const LAS float*)(lmb + i * GD_SL);
            float s1 = 0.f, s2 = 0.f, s3 = 0.f;
#pragma unroll
            for (int j4 = 0; j4 < (i + 3) / 4; ++j4) { const f32x4 l4 = *(const LAS f32x4*)(Li + 4 * j4);
                if (4 * j4 + 0 < i) s -= l4[0] * t[4 * j4 + 0];
                if (4 * j4 + 1 < i) s1 -= l4[1] * t[4 * j4 + 1];
                if (4 * j4 + 2 < i) s2 -= l4[2] * t[4 * j4 + 2];
                if (4 * j4 + 3 < i) s3 -= l4[3] * t[4 * j4 + 3]; }
            s = (s + s1) + (s2 + s3);
            t[i] = s;
            __builtin_amdgcn_sched_barrier(0);
        }
        const float bc = sc_b[lane], bec = bc * sc_e[lane];
#pragma unroll
        for (int i = 0; i < 64; ++i) { *(LAS bf16_t*)(lds + GD_T1 + i * GD_ST + lane * 2) = (bf16_t)f2bf(t[i] * bc); *(LAS bf16_t*)(lds + GD_T2 + i * GD_ST + lane * 2) = (bf16_t)f2bf(t[i] * bec); }
    } else {
        for (int cidx = tid - 64; cidx < 2560; cidx += 448) {
            if (cidx >= 2048) {
                const int cc = cidx - 2048, mt = cc >> 8, ks = (cc >> 6) & 3, lp = cc & 63, hp = lp >> 5, rr = lp & 31;
                const LAS unsigned char* ap = lds + GD_AQ + (32 * mt + rr) * 144 + (16 * ks + 4 * hp) * 2;
                const u32x2 lo = *(const LAS u32x2*)ap, hi2 = *(const LAS u32x2*)(ap + 16);
                gst16(gi + GDN_AF + (size_t)cc * 16, (v4u){lo.x, lo.y, hi2.x, hi2.y}, publish);
                continue; }
            const bool isK = cidx >= 1024; const int cc = cidx & 1023; const int lp = cc & 63, hp = lp >> 5, rr = lp & 31;
            unsigned wds[4];
            if (!isK) { const int mt = cc >> 9, ks = (cc >> 6) & 7; const int i = 32 * mt + rr; const float e = sc_e[i];
#pragma unroll
                for (int q = 0; q < 4; ++q) { const int j0 = 2 * q, j1 = 2 * q + 1;
                    const int d0 = 16 * ks + 8 * (j0 >> 2) + 4 * hp + (j0 & 3), d1 = 16 * ks + 8 * (j1 >> 2) + 4 * hp + (j1 & 3);
                    wds[q] = pk2(bf2f(*(const LAS bf16_t*)(lds + GD_QA + i * GD_SA + d0 * 2)) * e, bf2f(*(const LAS bf16_t*)(lds + GD_QA + i * GD_SA + d1 * 2)) * e); }
                gst16(gi + GDN_QF + (size_t)cc * 16, (v4u){wds[0], wds[1], wds[2], wds[3]}, publish);
            } else { const int dt = cc >> 8, ks = (cc >> 6) & 3; const int dk = 32 * dt + rr;
#pragma unroll
                for (int q = 0; q < 4; ++q) { const int j0 = 2 * q, j1 = 2 * q + 1;
                    const int k0 = 16 * ks + 8 * (j0 >> 2) + 4 * hp + (j0 & 3), k1 = 16 * ks + 8 * (j1 >> 2) + 4 * hp + (j1 & 3);
                    wds[q] = pk2(bf2f(*(const LAS bf16_t*)(lds + GD_KA + k0 * GD_SA + dk * 2)) * sc_l[k0], bf2f(*(const LAS bf16_t*)(lds + GD_KA + k1 * GD_SA + dk * 2)) * sc_l[k1]); }
                gst16(gi + GDN_KF + (size_t)cc * 16, (v4u){wds[0], wds[1], wds[2], wds[3]}, publish);
            }
        }
    }
#endif
    __syncthreads();
#ifndef NO_S4
    {
        const int mt = wave >> 2, nt = wave & 3;
        const int trb = (hi * 8 + ((lane & 15) >> 2)) * GD_SB + (32 * nt + ((lane >> 4) & 1) * 16 + (lane & 3) * 4) * 2;
#pragma unroll
        for (int which = 0; which < 2; ++which) {
            f32x16 acc;
#pragma unroll
            for (int r = 0; r < 16; ++r) acc[r] = 0.f;
            const LAS unsigned char* tp = lds + (which ? GD_T2 : GD_T1) + (32 * mt + r32) * GD_ST + hi * 16;
            const int vb = (int)(uintptr_t)(lds + (which ? GD_KB : GD_VN)) + trb;
            s16x4 lo[4], hh[4];
            lo[0] = tr_read<0 * 16 * GD_SB>(vb); hh[0] = tr_read<0 * 16 * GD_SB + 4 * GD_SB>(vb); lo[1] = tr_read<1 * 16 * GD_SB>(vb); hh[1] = tr_read<1 * 16 * GD_SB + 4 * GD_SB>(vb);
            lo[2] = tr_read<2 * 16 * GD_SB>(vb); hh[2] = tr_read<2 * 16 * GD_SB + 4 * GD_SB>(vb); lo[3] = tr_read<3 * 16 * GD_SB>(vb); hh[3] = tr_read<3 * 16 * GD_SB + 4 * GD_SB>(vb);
            asm volatile("s_waitcnt lgkmcnt(0)" ::: "memory"); __builtin_amdgcn_sched_barrier(0);
#pragma unroll
            for (int ks = 0; ks < 4; ++ks) { const bf16x8 bfr = (bf16x8){lo[ks][0], lo[ks][1], lo[ks][2], lo[ks][3], hh[ks][0], hh[ks][1], hh[ks][2], hh[ks][3]};
                acc = __builtin_amdgcn_mfma_f32_32x32x16_bf16(*(const LAS bf16x8*)(tp + ks * 32), bfr, acc, 0, 0, 0); }
            if (which == 0) {
                float* uf = (float*)(gi + GDN_UF) + (size_t)nt * 2048 + (32 * mt + 4 * hi) * 32 + r32;
#pragma unroll
                for (int r = 0; r < 16; ++r) gst4(uf + ((r & 3) + 8 * (r >> 2)) * 32, acc[r], publish);
            } else {
                LAS bf16_t* wq = (LAS bf16_t*)(lds + GD_QA + (32 * mt + 4 * hi) * GD_SA) + 32 * nt + r32;
#pragma unroll
                for (int r = 0; r < 16; ++r) wq[((r & 3) + 8 * (r >> 2)) * (GD_SA / 2)] = (bf16_t)f2bf(acc[r]);
            }
        }
    }
    __syncthreads();
    for (int cc = tid; cc < 1024; cc += NWAVES * 64) { const int mt = cc >> 9, ks = (cc >> 6) & 7, lp = cc & 63, hp = lp >> 5, rr = lp & 31;
        const LAS unsigned char* wq = lds + GD_QA + (32 * mt + rr) * GD_SA + (16 * ks + 4 * hp) * 2;
        const u32x2 lo = *(const LAS u32x2*)wq, hi2 = *(const LAS u32x2*)(wq + 16);
        gst16(gi + GDN_WF + (size_t)cc * 16, (v4u){lo.x, lo.y, hi2.x, hi2.y}, publish); }
#endif
    asm volatile("s_waitcnt vmcnt(0)" ::: "memory");
    __syncthreads();
    if (publish && tid == 0)
        __hip_atomic_store((unsigned*)(F.ws + WS_CTL) + CW_GFLAG + item, 1u, __ATOMIC_RELAXED, __HIP_MEMORY_SCOPE_AGENT);
}
__device__ __forceinline__ void gdn_prep_phase(Frame& F, const Args& A) {
    if (F.G >= 64 && PROBE_INPH) return;
    for (int item = blockIdx.x; item < 1024; item += F.G) gdn_prep_item(F, A, item, PROBE_PUB);
}

__device__ __forceinline__ bf16x8 pack8(const f32x16& a, int s) {
    v4u w; w.x = pg8::cvt_pk_bf16(a[8 * s + 0], a[8 * s + 1]); w.y = pg8::cvt_pk_bf16(a[8 * s + 2], a[8 * s + 3]); w.z = pg8::cvt_pk_bf16(a[8 * s + 4], a[8 * s + 5]); w.w = pg8::cvt_pk_bf16(a[8 * s + 6], a[8 * s + 7]);
    return __builtin_bit_cast(bf16x8, w);
}
constexpr int SC_STAGE = 65536;
template <bool WAITF>
__device__ __forceinline__ void gdn_scan_block(Frame& F, int task, int mode = 0) {
    const int lane = F.lane, wave = F.wave, r32 = lane & 31, hi = lane >> 5;
    const int bh = task >> 2, sl = task & 3, b = bh >> 2, h = bh & 3;
    LAS unsigned char* lds = F.lds;
    float* oa = (float*)(F.ws + WS_OA);
    const unsigned char* g0 = F.ws + WS_GDN + (size_t)(bh * 128) * GDN_ITEM;
    auto wait_group = [&](int n) {
        if (!WAITF) return;
        const unsigned* fl = (const unsigned*)(F.ws + WS_CTL) + CW_GFLAG + bh * 128 + n;
        for (int sp = 0; sp < 400000; ++sp) { unsigned ok = 1u;
#pragma unroll
            for (int i = 0; i < 8; ++i) ok &= __hip_atomic_load(fl + i, __ATOMIC_RELAXED, __HIP_MEMORY_SCOPE_AGENT);
            if (ok) break; __builtin_amdgcn_s_sleep(8); }
        asm volatile("" ::: "memory");
    };
    auto issue = [&](int n) {
        const unsigned char* gi = g0 + (size_t)n * GDN_ITEM; LAS unsigned char* st = lds + (n & 1) * SC_STAGE;
        for (int p = wave - 1; p < 64; p += 7) {
            const unsigned char* src = (p < 56) ? gi + p * 1024 : gi + GDN_UF + (size_t)sl * 8192 + (p - 56) * 1024;
            __builtin_amdgcn_global_load_lds((const unsigned*)(src + lane * 16), (LAS unsigned*)(st + p * 1024), 16, 0, (WAITF || PROBE_SC1) ? 17 : 0);
        }
    };
    f32x16 st4[4];
#pragma unroll
    for (int dt = 0; dt < 4; ++dt)
#pragma unroll
        for (int r = 0; r < 16; ++r) st4[dt][r] = 0.f;
    __syncthreads();
    wait_group(0);
    if (wave != 0) issue(0);
    __syncthreads();
    for (int n = 0; n < 128; ++n) {
        if (((n + 1) & 7) == 0 && n + 1 < 128) wait_group(n + 1);
        if (wave != 0) { if (n + 1 < 128 && !(mode & 1)) issue(n + 1); }
        else if (!(mode & 2)) {
            const LAS unsigned char* sg = lds + (n & 1) * SC_STAGE;
            const LAS bf16x8* wf = (const LAS bf16x8*)(sg + GDN_WF) + lane; const LAS bf16x8* qf = (const LAS bf16x8*)(sg + GDN_QF) + lane;
            const LAS bf16x8* af = (const LAS bf16x8*)(sg + GDN_AF) + lane; const LAS bf16x8* kf = (const LAS bf16x8*)(sg + GDN_KF) + lane;
            const LAS float* ufl = (const LAS float*)(sg + 57344) + 4 * hi * 32 + r32;
            const float egl = WAITF ? __uint_as_float(__hip_atomic_load((const unsigned*)(g0 + (size_t)n * GDN_ITEM + GDN_EG), __ATOMIC_RELAXED, __HIP_MEMORY_SCOPE_AGENT))
                                    : *(const float*)(g0 + (size_t)n * GDN_ITEM + GDN_EG);
            float* oap = oa + (size_t)(b * S + n * 64 + 4 * hi) * 512 + h * 128 + sl * 32 + r32;
            bf16x8 sb[8];
#pragma unroll
            for (int dt = 0; dt < 4; ++dt) { sb[2 * dt] = pack8(st4[dt], 0); sb[2 * dt + 1] = pack8(st4[dt], 1); }
            f32x16 vn[2], oc[2];
#pragma unroll
            for (int mt = 0; mt < 2; ++mt) {
                f32x16 ws_;
#pragma unroll
                for (int r = 0; r < 16; ++r) { ws_[r] = 0.f; oc[mt][r] = 0.f; }
#pragma unroll
                for (int ks = 0; ks < 8; ++ks) { ws_ = __builtin_amdgcn_mfma_f32_32x32x16_bf16(wf[(mt * 8 + ks) * 64], sb[ks], ws_, 0, 0, 0);
                                                 oc[mt] = __builtin_amdgcn_mfma_f32_32x32x16_bf16(qf[(mt * 8 + ks) * 64], sb[ks], oc[mt], 0, 0, 0); }
#pragma unroll
                for (int r = 0; r < 16; ++r) vn[mt][r] = ufl[(32 * mt + (r & 3) + 8 * (r >> 2)) * 32] - ws_[r];
            }
            bf16x8 vb[4];
#pragma unroll
            for (int mt = 0; mt < 2; ++mt) { vb[2 * mt] = pack8(vn[mt], 0); vb[2 * mt + 1] = pack8(vn[mt], 1); }
#pragma unroll
            for (int mt = 0; mt < 2; ++mt) {
#pragma unroll
                for (int ks = 0; ks < 4; ++ks) oc[mt] = __builtin_amdgcn_mfma_f32_32x32x16_bf16(af[(mt * 4 + ks) * 64], vb[ks], oc[mt], 0, 0, 0);
#pragma unroll
                for (int r = 0; r < 16; ++r) oap[(size_t)(32 * mt + (r & 3) + 8 * (r >> 2)) * 512] = oc[mt][r];
            }
#pragma unroll
            for (int dt = 0; dt < 4; ++dt) {
#pragma unroll
                for (int r = 0; r < 16; ++r) st4[dt][r] *= egl;
#pragma unroll
                for (int ks = 0; ks < 4; ++ks) st4[dt] = __builtin_amdgcn_mfma_f32_32x32x16_bf16(kf[(dt * 4 + ks) * 64], vb[ks], st4[dt], 0, 0, 0);
            }
        }
        __syncthreads();
    }
}
constexpr int CW_QUEUE = 64;
__device__ __forceinline__ void mixer_phase(Frame& F, const Args& A, int rep) {
    const bool inphase = F.G >= 64 && PROBE_INPH;
    volatile LAS int* slot = (volatile LAS int*)(F.lds + CTRL_OFF + 64);
    if (blockIdx.x < 32) {
#ifdef PROBE_SC
        if (inphase) gdn_scan_block<true>(F, (int)blockIdx.x, rep ? PROBE_SC : 0); else gdn_scan_block<false>(F, (int)blockIdx.x, rep ? PROBE_SC : 0);
#else
        if (inphase && rep == 0) gdn_scan_block<true>(F, (int)blockIdx.x); else gdn_scan_block<false>(F, (int)blockIdx.x);
#endif
    } else if (inphase && rep == 0) {
        unsigned* pq = (unsigned*)(F.ws + WS_CTL) + CW_PQ;
        for (;;) {
            __syncthreads();
            if (F.tid == 0) slot[0] = (int)__hip_atomic_fetch_add(pq, 1u, __ATOMIC_RELAXED, __HIP_MEMORY_SCOPE_AGENT);
            __syncthreads();
            const int i = slot[0];
            if (i >= 1024) break;
            gdn_prep_item(F, A, (i & 7) * 128 + (i >> 3), true);
        }
    }
    unsigned* qctr = (unsigned*)(F.ws + WS_CTL) + CW_QUEUE + 64 * rep;
    for (;;) {
        __syncthreads();
        if (F.tid == 0) slot[0] = (int)__hip_atomic_fetch_add(qctr, 1u, __ATOMIC_RELAXED, __HIP_MEMORY_SCOPE_AGENT);
        __syncthreads();
        const int i = slot[0];
        if (i >= 512) break;
        const int qb = 31 - (i >> 4), x = i & 15;
        attn_unit(F, x >> 3, (x >> 1) & 3, x & 1, qb);
    }
    __syncthreads();
    if (blockIdx.x >= 32) late_weight_copies(F, A, ((int)blockIdx.x - 32) * NWAVES + F.wave, (F.G - 32) * NWAVES);
    else if (F.G <= 32) late_weight_copies(F, A, (int)blockIdx.x * NWAVES + F.wave, F.G * NWAVES);
}
__global__ void __launch_bounds__(NWAVES * 64, 2) mega(Args args) {
    extern __shared__ __attribute__((aligned(16))) unsigned char lds_raw[];
    Frame F;
    F.lds = (LAS unsigned char*)lds_raw;
    F.MISC = (volatile LAS unsigned*)(F.lds + MISC_OFF);
    F.tid = threadIdx.x; F.lane = F.tid & 63; F.wave = __builtin_amdgcn_readfirstlane(F.tid >> 6);
    F.G = gridDim.x; { const int bx = blockIdx.x; F.vcu = (F.G % 8 == 0) ? (bx % 8) * (F.G / 8) + bx / 8 : bx; }
    F.out = args.out; F.ws = args.ws;
    for (int u = F.tid; u < (LDS_BYTES - CTRL_OFF) / 4; u += NWAVES * 64) ((LAS unsigned*)(F.lds + CTRL_OFF))[u] = 0u;
    __syncthreads();
    const int lo = args.ph_lo, hi = args.ph_hi;
    XcdBarrier bar; bar.bar = (unsigned*)(F.ws + WS_CTL) + CW_BAR; bar.x = 0; bar.st = nullptr;
    if (hi - lo > 1) bar = xcd_barrier_post((unsigned*)(F.ws + WS_CTL) + CW_BAR, F.MISC + 8);
#ifndef PHASE_MASK
#define PHASE_MASK 0xffff
#endif
#ifndef DUP_MASK
#define DUP_MASK 0
#endif
#define IN(k) (((PHASE_MASK >> (k)) & 1) && lo <= (k) && (k) < hi)
    if (IN(0)) { p0_phase(F, args); }
#if (DUP_MASK >> 0) & 1
    if (IN(0)) xcd_barrier(bar);
    if (IN(0)) { p0_phase(F, args); }
#endif
    if (IN(0) && IN(1)) xcd_barrier(bar);
#ifdef PROBE_BAR
    for (int pb = 0; pb < 12; ++pb) xcd_barrier(bar);
#endif
    if (IN(1)) { norm_mod_phase<true, true>(F, args, args.in[0], args.in[4], 0, 1024, (bf16_t*)(F.ws + WS_H)); }
#if (DUP_MASK >> 1) & 1
    if (IN(1)) xcd_barrier(bar);
    if (IN(1)) { norm_mod_phase<true, true>(F, args, args.in[0], args.in[4], 0, 1024, (bf16_t*)(F.ws + WS_H)); }
#endif
    if (IN(1) && IN(2)) xcd_barrier(bar);
    if (IN(2)) {
        pg8::Gemm g{(const bf16_t*)(F.ws + WS_H), (const bf16_t*)(F.ws + WS_WIN), T, LDP, D}; pg8::StaticOrder So; So.init(T, LDP, F.G, (int)blockIdx.x);
        pg8::EpiStoreBf16 E{(bf16_t*)(F.ws + WS_P), LDP, 0};
        pg8::gemm_phase<pg8::EpiStoreBf16, pg8::StaticOrder, true, true>(F.lds, g, So, E);
    }
#if (DUP_MASK >> 2) & 1
    if (IN(2)) xcd_barrier(bar);
    if (IN(2)) {
        pg8::Gemm g{(const bf16_t*)(F.ws + WS_H), (const bf16_t*)(F.ws + WS_WIN), T, LDP, D}; pg8::StaticOrder So; So.init(T, LDP, F.G, (int)blockIdx.x);
        pg8::EpiStoreBf16 E{(bf16_t*)(F.ws + WS_P), LDP, 0};
        pg8::gemm_phase<pg8::EpiStoreBf16, pg8::StaticOrder, true, true>(F.lds, g, So, E);
    }
#endif
    if (IN(2) && IN(3)) xcd_barrier(bar);
    if (IN(3)) { attn_prep_phase(F, args); gdn_prep_phase(F, args); }
#if (DUP_MASK >> 3) & 1
    if (IN(3)) xcd_barrier(bar);
    if (IN(3)) { attn_prep_phase(F, args); gdn_prep_phase(F, args); }
#endif
    if (IN(3) && IN(4)) xcd_barrier(bar);
    if (IN(4)) { mixer_phase(F, args, 0); }
#if (DUP_MASK >> 4) & 1
    if (IN(4)) xcd_barrier(bar);
    if (IN(4)) { mixer_phase(F, args, 1); }
#endif
    if (IN(4) && IN(5)) xcd_barrier(bar);
    if (IN(5)) { post_norm_phase(F, args); }
#if (DUP_MASK >> 5) & 1
    if (IN(5)) xcd_barrier(bar);
    if (IN(5)) { post_norm_phase(F, args); }
#endif
    if (IN(5) && IN(6)) xcd_barrier(bar);
    if (IN(6)) {
        { pg8::Gemm g{(const bf16_t*)(F.ws + WS_OAN), (const bf16_t*)(F.ws + WS_WOA), T, 1024, 512}; pg8::StaticOrder So; So.init(T, 1024, F.G, (int)blockIdx.x);
          pg8::EpiGate<false> E{(const bf16_t*)(F.ws + WS_P) + C_GA, nullptr, (bf16_t*)(F.ws + WS_TMPB), LDP, 0};
          pg8::gemm_phase<pg8::EpiGate<false>, pg8::StaticOrder, true, true>(F.lds, g, So, E); }
        { pg8::Gemm g{(const bf16_t*)(F.ws + WS_OBN), (const bf16_t*)(F.ws + WS_WOB), T, 1024, 512}; pg8::StaticOrder So; So.init(T, 1024, F.G, (int)blockIdx.x);
          pg8::EpiGate<true> E{(const bf16_t*)(F.ws + WS_P) + C_GB, (const bf16_t*)(F.ws + WS_TMPB), (bf16_t*)(F.ws + WS_MERGED), LDP, 0};
          pg8::gemm_phase<pg8::EpiGate<true>, pg8::StaticOrder, true, true>(F.lds, g, So, E); }
    }
#if (DUP_MASK >> 6) & 1
    if (IN(6)) xcd_barrier(bar);
    if (IN(6)) {
        { pg8::Gemm g{(const bf16_t*)(F.ws + WS_OAN), (const bf16_t*)(F.ws + WS_WOA), T, 1024, 512}; pg8::StaticOrder So; So.init(T, 1024, F.G, (int)blockIdx.x);
          pg8::EpiGate<false> E{(const bf16_t*)(F.ws + WS_P) + C_GA, nullptr, (bf16_t*)(F.ws + WS_TMPB), LDP, 0};
          pg8::gemm_phase<pg8::EpiGate<false>, pg8::StaticOrder, true, true>(F.lds, g, So, E); }
        { pg8::Gemm g{(const bf16_t*)(F.ws + WS_OBN), (const bf16_t*)(F.ws + WS_WOB), T, 1024, 512}; pg8::StaticOrder So; So.init(T, 1024, F.G, (int)blockIdx.x);
          pg8::EpiGate<true> E{(const bf16_t*)(F.ws + WS_P) + C_GB, (const bf16_t*)(F.ws + WS_TMPB), (bf16_t*)(F.ws + WS_MERGED), LDP, 0};
          pg8::gemm_phase<pg8::EpiGate<true>, pg8::StaticOrder, true, true>(F.lds, g, So, E); }
    }
#endif
    if (IN(6) && IN(7)) xcd_barrier(bar);
    if (IN(7)) {
        pg8::Gemm g{(const bf16_t*)(F.ws + WS_MERGED), (const bf16_t*)(F.ws + WS_WOUT), T, 1024, 1024}; pg8::StaticOrder So; So.init(T, 1024, F.G, (int)blockIdx.x);
        pg8::EpiResid E{args.in[0], (const float*)(F.ws + WS_MOD) + 2048, (float*)(F.ws + WS_X1)};
        pg8::gemm_phase<pg8::EpiResid, pg8::StaticOrder, true, true>(F.lds, g, So, E);
    }
#if (DUP_MASK >> 7) & 1
    if (IN(7)) xcd_barrier(bar);
    if (IN(7)) {
        pg8::Gemm g{(const bf16_t*)(F.ws + WS_MERGED), (const bf16_t*)(F.ws + WS_WOUT), T, 1024, 1024}; pg8::StaticOrder So; So.init(T, 1024, F.G, (int)blockIdx.x);
        pg8::EpiResid E{args.in[0], (const float*)(F.ws + WS_MOD) + 2048, (float*)(F.ws + WS_X1)};
        pg8::gemm_phase<pg8::EpiResid, pg8::StaticOrder, true, true>(F.lds, g, So, E);
    }
#endif
    if (IN(7) && IN(8)) xcd_barrier(bar);
    if (IN(8)) { norm_mod_phase<false, false>(F, args, (const float*)(F.ws + WS_X1), args.in[20], 3072, 4096, (bf16_t*)(F.ws + WS_H)); }
#if (DUP_MASK >> 8) & 1
    if (IN(8)) xcd_barrier(bar);
    if (IN(8)) { norm_mod_phase<false, false>(F, args, (const float*)(F.ws + WS_X1), args.in[20], 3072, 4096, (bf16_t*)(F.ws + WS_H)); }
#endif
    if (IN(8) && IN(9)) xcd_barrier(bar);
    if (IN(9)) {
        pg8::Gemm g{(const bf16_t*)(F.ws + WS_H), (const bf16_t*)(F.ws + WS_W9), T, 768, 1024}; pg8::StaticOrder So; So.init(T, 768, F.G, (int)blockIdx.x);
        pg8::EpiSharedRouter E{(bf16_t*)(F.ws + WS_SACT), (float*)(F.ws + WS_LOGITS)};
        pg8::gemm_phase<pg8::EpiSharedRouter, pg8::StaticOrder, true, true>(F.lds, g, So, E);
    }
#if (DUP_MASK >> 9) & 1
    if (IN(9)) xcd_barrier(bar);
    if (IN(9)) {
        pg8::Gemm g{(const bf16_t*)(F.ws + WS_H), (const bf16_t*)(F.ws + WS_W9), T, 768, 1024}; pg8::StaticOrder So; So.init(T, 768, F.G, (int)blockIdx.x);
        pg8::EpiSharedRouter E{(bf16_t*)(F.ws + WS_SACT), (float*)(F.ws + WS_LOGITS)};
        pg8::gemm_phase<pg8::EpiSharedRouter, pg8::StaticOrder, true, true>(F.lds, g, So, E);
    }
#endif
    if (IN(9) && IN(10)) xcd_barrier(bar);
    if (IN(10)) { route_phase(F, args); }
#if (DUP_MASK >> 10) & 1
    if (IN(10)) xcd_barrier(bar);
    if (IN(10)) { route_phase(F, args); }
#endif
    if (IN(10) && IN(11)) xcd_barrier(bar);
    if (IN(11)) { moe_phase(F, args); }
#if (DUP_MASK >> 11) & 1
    if (IN(11)) xcd_barrier(bar);
    if (IN(11)) { moe_phase(F, args, 1); }
#endif
    if (IN(11) && IN(12)) xcd_barrier(bar);
    if (IN(12)) {
        pg8::Gemm g{(const bf16_t*)(F.ws + WS_SACT), (const bf16_t*)(F.ws + WS_WSD), T, 1024, 256}; pg8::StaticOrder So; So.init(T, 1024, F.G, (int)blockIdx.x);
        pg8::EpiFinal E{(const float*)(F.ws + WS_X1), (const float*)(F.ws + WS_MOD) + 5120, (const bf16_t*)(F.ws + WS_Y), F.out};
        pg8::gemm_phase<pg8::EpiFinal, pg8::StaticOrder, true, true>(F.lds, g, So, E);
    }
#if (DUP_MASK >> 12) & 1
    if (IN(12)) xcd_barrier(bar);
    if (IN(12)) {
        pg8::Gemm g{(const bf16_t*)(F.ws + WS_SACT), (const bf16_t*)(F.ws + WS_WSD), T, 1024, 256}; pg8::StaticOrder So; So.init(T, 1024, F.G, (int)blockIdx.x);
        pg8::EpiFinal E{(const float*)(F.ws + WS_X1), (const float*)(F.ws + WS_MOD) + 5120, (const bf16_t*)(F.ws + WS_Y), F.out};
        pg8::gemm_phase<pg8::EpiFinal, pg8::StaticOrder, true, true>(F.lds, g, So, E);
    }
#endif
#undef IN
}
extern "C" void kernel_launch(void* const* d_in, const int* in_sizes, int n_in, void* d_out, int out_size, void* d_ws, size_t ws_size, hipStream_t stream) {
  static int grid = 0;
  if (grid == 0) {
    int dev = 0, cus = 0;
    if (n_in != 27 || out_size != T * D || ws_size < WS_END) { fprintf(stderr, "kernel_launch: unexpected problem (n_in %d, out %d, ws %zu < %zu)\n", n_in, out_size, ws_size, (size_t)WS_END); grid = -1; return; }
    if (hipGetDevice(&dev) != hipSuccess || hipDeviceGetAttribute(&cus, hipDeviceAttributeMultiprocessorCount, dev) != hipSuccess) { fprintf(stderr, "kernel_launch: device query failed\n"); grid = -1; return; }
    if (hipFuncSetAttribute((const void*)mega, hipFuncAttributeMaxDynamicSharedMemorySize, LDS_BYTES) != hipSuccess) { fprintf(stderr, "kernel_launch: hipFuncSetAttribute failed\n"); grid = -1; return; }
    int per_cu = 0;
    if (hipOccupancyMaxActiveBlocksPerMultiprocessor(&per_cu, (const void*)mega, NWAVES * 64, LDS_BYTES) != hipSuccess || per_cu < 1) fprintf(stderr, "kernel_launch: occupancy query says %d blocks per CU\n", per_cu);
    (void)hipGetLastError();
    grid = cus;
  }
  if (grid < 0) return;
  (void)hipMemsetAsync((unsigned char*)d_ws + WS_CTL, 0, CTL_ZERO_BYTES, stream);
  Args a{};
  for (int i = 0; i < 27; ++i) a.in[i] = (const float*)d_in[i];
  a.out = (float*)d_out; a.ws = (unsigned char*)d_ws;
#ifndef N_LAUNCH_PHASES
  a.ph_lo = 0; a.ph_hi = 13;
  hipLaunchKernelGGL(mega, dim3(grid), dim3(NWAVES * 64), LDS_BYTES, stream, a);
#else
  for (int ph = 0; ph < 13; ++ph) { a.ph_lo = ph; a.ph_hi = ph + 1; hipLaunchKernelGGL(mega, dim3(grid), dim3(NWAVES * 64), LDS_BYTES, stream, a); }
#endif
}
```

```cpp
#include <hip/hip_runtime.h>
#include <stdint.h>
#include <cstdio>

typedef unsigned short bf16_t;
constexpr int D = 1024, NB = 2, S = 8192, T = NB * S;
constexpr int INC = 5640;
constexpr int LDP = 5632;
constexpr int C_QA = 0, C_KA = 512, C_VA = 1024, C_ZA = 1536, C_QB = 2048, C_KB = 2560, C_VB = 3072, C_GA = 3584, C_GB = 4608;
constexpr int NE = 256, TOPK = 8, NA = T * TOPK;
constexpr float EPS = 1e-6f;
constexpr float LAM_INIT = 0.2f;
__device__ __forceinline__ float bf2f(bf16_t v) { return __uint_as_float(((unsigned)v) << 16); }
__device__ __forceinline__ float siluf(float x) { return x / (1.f + __expf(-x)); }
__device__ __forceinline__ float sigmf(float x) { return 1.f / (1.f + __expf(-x)); }
__device__ __forceinline__ float softplusf(float x) { return x > 20.f ? x : log1pf(__expf(x)); }
__device__ __forceinline__ float wave_sum(float v) {
#pragma unroll
  for (int o = 1; o < 64; o <<= 1) v += __shfl_xor(v, o);
  return v;
}
constexpr size_t MiB = 1u << 20;
constexpr size_t WS_CTL = 0, CTL_ZERO_BYTES = 1 * MiB;
constexpr size_t WS_MODP = 1 * MiB;
constexpr size_t WS_MOD = 1 * MiB + 448 * 1024;
constexpr size_t WS_SCAL = 1 * MiB + 512 * 1024;
constexpr size_t WS_WIN = 2 * MiB;
constexpr size_t WS_WOA = 13 * MiB, WS_WOB = 14 * MiB;
constexpr size_t WS_WOUT = 15 * MiB;
constexpr size_t WS_W9 = 17 * MiB;
constexpr size_t WS_WSD = 19 * MiB;
constexpr size_t WS_BD = 20 * MiB;
constexpr size_t WS_H = 32 * MiB;
constexpr size_t WS_P = 64 * MiB;
constexpr size_t WS_OAN = 240 * MiB, WS_OBN = 256 * MiB;
constexpr size_t WS_TMPB = 272 * MiB;
constexpr size_t WS_MERGED = 304 * MiB;
constexpr size_t WS_X1 = 336 * MiB;
constexpr size_t WS_LOGITS = 400 * MiB;
constexpr size_t WS_SACT = 416 * MiB;
constexpr size_t WS_TOPI = 424 * MiB, WS_TOPW = 425 * MiB;
constexpr size_t WS_Y = 432 * MiB;
constexpr size_t WS_ACTB = 704 * MiB;
constexpr size_t WS_LIST = 768 * MiB;
constexpr size_t WS_QN = 800 * MiB, WS_KN = 816 * MiB;
constexpr size_t WS_OB = 832 * MiB;
constexpr size_t WS_OA = 864 * MiB;
constexpr size_t WS_GDN = 896 * MiB;
constexpr size_t WS_XA = 992 * MiB;
constexpr size_t XA_BLOCK = (size_t)32 * 640 * 16;
constexpr size_t WS_END = WS_XA + 256 * XA_BLOCK;
constexpr int CW_BAR = 4096;

#define GAS __attribute__((address_space(1)))
#define LAS __attribute__((address_space(3)))
typedef unsigned v4u __attribute__((ext_vector_type(4)));
typedef float f32x4 __attribute__((ext_vector_type(4)));
typedef unsigned u32x2 __attribute__((ext_vector_type(2)));
typedef short bf16x8 __attribute__((ext_vector_type(8)));
typedef GAS unsigned gu32;
typedef GAS unsigned long long gu64;
#define RLX_AGENT __ATOMIC_RELAXED, __HIP_MEMORY_SCOPE_AGENT
#define LDS_WAIT() asm volatile("s_waitcnt lgkmcnt(0)" ::: "memory")
#define VM_WAIT() asm volatile("s_waitcnt vmcnt(0)" ::: "memory")
__device__ __forceinline__ unsigned f2bf(float f) { unsigned u = __builtin_bit_cast(unsigned, f); return (u + 0x7fffu + ((u >> 16) & 1u)) >> 16; }
__device__ __forceinline__ unsigned pk2(float lo, float hi) { return f2bf(lo) | (f2bf(hi) << 16); }

constexpr int NWAVES = 8;
constexpr int LDS_BYTES = 163840;
constexpr int CTRL_OFF = 159744;
constexpr int MISC_OFF = CTRL_OFF + 320;
constexpr int CW_ECNT = 256;

struct Frame {
    LAS unsigned char* lds;
    volatile LAS unsigned* MISC;
    int tid, lane, wave, vcu, G;
    float* out; unsigned char* ws;
    const __attribute__((address_space(4))) unsigned char* karg;
};
#define KIN(k) (*(const float* const __attribute__((address_space(4)))*)(F.karg + 8 * (k)))
struct Args { const float* in[27]; float* out; unsigned char* ws; int ph_lo, ph_hi; };
namespace pg8 {
#define PG8_LAS __attribute__((address_space(3)))
typedef unsigned short bf16_t;
typedef short bf16x8 __attribute__((ext_vector_type(8)));
typedef float f32x4 __attribute__((ext_vector_type(4)));
typedef unsigned u32x4 __attribute__((ext_vector_type(4)));
constexpr int BM = 256, BK = 64, HALF = 128, HTB = HALF * BK * 2  , STAGE_BYTES = 8 * HTB, NXCD = 8, WGM = 8;

__host__ __device__ __forceinline__ int lds_byte(int r, int c) { const int st = (r >> 4) * 2 + (c >> 5), rr = r & 15, cc = c & 31, ob = rr * 64 + cc * 2; return st * 1024 + (ob ^ (((ob >> 9) & 1) << 5)); }
__host__ __device__ __forceinline__ void stage_rc(int b, int& R, int& C) { const int st = b / 1024, sb = b % 1024, swz = sb ^ (((sb >> 9) & 1) << 5); R = (st >> 1) * 16 + swz / 64; C = (st & 1) * 32 + (swz % 64) / 2; }
__host__ __device__ __forceinline__ int perm32(int rho) { const int n = rho >> 4, i = rho & 15; return 8 * (i >> 2) + 4 * n + (i & 3); }

struct Unit { int pm, pn; };
struct Gemm { const bf16_t* A; const bf16_t* Bt; int M, N, K; };

struct StaticOrder {
    int nM, nN, nwg, G, c;
    __host__ __device__ void init(int M, int N, int G_, int c_) { nM = M / BM; nN = N / BM; nwg = nM * nN; G = G_; c = c_; }
    __host__ __device__ bool next(int i, Unit& u) const {
        const long L = (long)i * G + c; if (L >= nwg) return false;
        int wgid = (int)L; { const int q = nwg / NXCD, r = nwg % NXCD, xcd = wgid % NXCD, off = wgid / NXCD; wgid = (xcd < r ? xcd * (q + 1) : r * (q + 1) + (xcd - r) * q) + off; }
        const int nig = WGM * nN, gid = wgid / nig, fm = gid * WGM, gsz = (nM - fm) < WGM ? (nM - fm) : WGM;
        u.pm = fm + ((wgid % nig) % gsz); u.pn = (wgid % nig) / gsz; return true;
    }
    __device__ __forceinline__ void a_ready(const Unit&) const {}
    __device__ __forceinline__ void done(const Unit&) const {}
};

__device__ __forceinline__ unsigned cvt_pk_bf16(float lo, float hi) { unsigned r; asm volatile("v_cvt_pk_bf16_f32 %0, %1, %2" : "=v"(r) : "v"(lo), "v"(hi)); return r; }
typedef float f32x2 __attribute__((ext_vector_type(2)));
template <class Epi, class Sched, bool ALIGN_EPI = false, bool SP2 = false>
__device__ __forceinline__ void gemm_phase(PG8_LAS unsigned char* lds, const Gemm g, const Sched& S, const Epi& E) {
    const int tid = threadIdx.x, wid = __builtin_amdgcn_readfirstlane(tid >> 6), lane = tid & 63, wr = wid >> 2, wc = wid & 3, fr = lane & 15, fq = lane >> 4;
    const int K = g.K, nt = K / BK;
    unsigned voffA[2], voffB[2];
#pragma unroll
    for (int i = 0; i < 2; ++i) { int R, C; stage_rc(tid * 16 + i * 8192, R, C); const int Rb = Epi::PERM ? ((R & ~31) + perm32(R & 31)) : R;
        voffA[i] = (unsigned)(R * K + C) * 2u; voffB[i] = (unsigned)(Rb * K + C) * 2u; }
    const size_t kstep = (size_t)(BK * 2);
    const size_t hstep = (size_t)HALF * K * 2;
    const size_t tstep = 2 * hstep;
    const unsigned ldsw = (unsigned)wid * 1024u;
    const int aoff = lds_byte(wr * 64 + fr, fq * 8), boff = lds_byte(wc * 32 + fr, fq * 8);
#define PG8_SA(b, h) (((b) * 2 + (h)) * HTB)
#define PG8_SB(b, h) ((4 + (b) * 2 + (h)) * HTB)
#define PG8_STAGE(bufoff, gbase, voff) do { _Pragma("unroll") for (int _i = 0; _i < 2; ++_i) \
        __builtin_amdgcn_global_load_lds((const unsigned*)((const char*)(gbase) + (voff)[_i]), (PG8_LAS unsigned*)(lds + (bufoff) + ldsw + _i * 8192), 16, 0, 0); } while (0)
#define PG8_LDA(dst, b, h) do { _Pragma("unroll") for (int m = 0; m < 4; ++m) _Pragma("unroll") for (int k = 0; k < 2; ++k) dst[m][k] = *(const PG8_LAS bf16x8*)(lds + PG8_SA(b, h) + aoff + m * 2048 + k * 1024); } while (0)
#define PG8_LDB(dst, b, h) do { _Pragma("unroll") for (int n = 0; n < 2; ++n) _Pragma("unroll") for (int k = 0; k < 2; ++k) dst[n][k] = *(const PG8_LAS bf16x8*)(lds + PG8_SB(b, h) + boff + n * 2048 + k * 1024); } while (0)
#define PG8_MMA(ai, bj, At, Bt) do { __builtin_amdgcn_s_setprio(1); _Pragma("unroll") for (int m = 0; m < 4; ++m) _Pragma("unroll") for (int n = 0; n < 2; ++n) _Pragma("unroll") for (int k = 0; k < 2; ++k) \
        acc[ai][bj][m][n] = __builtin_amdgcn_mfma_f32_16x16x32_bf16(Bt[n][k], At[m][k], acc[ai][bj][m][n], 0, 0, 0); __builtin_amdgcn_s_setprio(0); } while (0)
#define PG8_WAIT_V(n) asm volatile("s_waitcnt vmcnt(" #n ")" ::: "memory")
#define PG8_WAIT_L(n) asm volatile("s_waitcnt lgkmcnt(" #n ")" ::: "memory")
#define PG8_BAR __builtin_amdgcn_s_barrier()
#define PG8_SCHED __builtin_amdgcn_sched_barrier(0)
    Unit cur, nxt; int ui = 0;
    if (!S.next(0, cur)) return;
    f32x4 acc[2][2][4][2];
#pragma unroll
    for (int a = 0; a < 2; ++a)
#pragma unroll
        for (int b = 0; b < 2; ++b)
#pragma unroll
            for (int m = 0; m < 4; ++m)
#pragma unroll
                for (int n = 0; n < 2; ++n) acc[a][b][m][n] = (f32x4){0.f, 0.f, 0.f, 0.f};
    bf16x8 At[4][2], B0[2][2], B1[2][2];
    const char* cA = (const char*)g.A + (size_t)cur.pm * tstep; const char* cB = (const char*)g.Bt + (size_t)cur.pn * tstep;
    S.a_ready(cur);
    if constexpr (SP2) {
        PG8_STAGE(PG8_SB(0, 0), cB, voffB); PG8_STAGE(PG8_SB(0, 1), cB + hstep, voffB); PG8_STAGE(PG8_SA(0, 0), cA, voffA); PG8_STAGE(PG8_SA(0, 1), cA + hstep, voffA);
        if (wr == 1) PG8_BAR;
        PG8_WAIT_V(2); PG8_BAR;
        PG8_STAGE(PG8_SB(1, 0), cB + kstep, voffB); PG8_STAGE(PG8_SA(1, 0), cA + kstep, voffA); PG8_STAGE(PG8_SB(1, 1), cB + hstep + kstep, voffB);
        PG8_WAIT_V(6); PG8_BAR;
    } else {
        PG8_STAGE(PG8_SB(0, 0), cB, voffB); PG8_STAGE(PG8_SA(0, 0), cA, voffA); PG8_STAGE(PG8_SB(0, 1), cB + hstep, voffB); PG8_STAGE(PG8_SA(0, 1), cA + hstep, voffA);
        if (wr == 1) PG8_BAR;
        PG8_WAIT_V(4); PG8_BAR;
        PG8_STAGE(PG8_SB(1, 0), cB + kstep, voffB); PG8_STAGE(PG8_SA(1, 0), cA + kstep, voffA); PG8_STAGE(PG8_SB(1, 1), cB + hstep + kstep, voffB);
        PG8_WAIT_V(6); PG8_BAR;
    }
    for (;;) {
        const bool has_next = S.next(ui + 1, nxt);
        const char* nA = has_next ? (const char*)g.A + (size_t)nxt.pm * tstep : cA; const char* nB = has_next ? (const char*)g.Bt + (size_t)nxt.pn * tstep : cB;
        for (int t = 0; t < nt; t += 2) {
            const bool last = (t == nt - 2);
            const char* a1 = cA + (size_t)(t + 1) * kstep;
            const char* a2 = last ? nA : cA + (size_t)(t + 2) * kstep; const char* b2 = last ? nB : cB + (size_t)(t + 2) * kstep;
            const char* a3 = a2 + kstep; const char* b3 = b2 + kstep;
            if (last && has_next) S.a_ready(nxt);
            if constexpr (SP2) {
            PG8_LDB(B0, 0, 0); PG8_LDB(B1, 0, 1); PG8_SCHED; PG8_LDA(At, 0, 0); PG8_STAGE(PG8_SA(1, 1), a1 + hstep, voffA);
            PG8_WAIT_V(8); PG8_WAIT_L(0); PG8_BAR; PG8_MMA(0, 0, At, B0); PG8_MMA(0, 1, At, B1); PG8_BAR; PG8_SCHED;
            PG8_LDA(At, 0, 1); PG8_STAGE(PG8_SB(0, 0), b2, voffB); PG8_STAGE(PG8_SB(0, 1), b2 + hstep, voffB); PG8_STAGE(PG8_SA(0, 0), a2, voffA);
            PG8_WAIT_V(8); PG8_WAIT_L(0); PG8_BAR; PG8_MMA(1, 0, At, B0); PG8_MMA(1, 1, At, B1); PG8_BAR; PG8_SCHED;
            PG8_LDB(B0, 1, 0); PG8_LDB(B1, 1, 1); PG8_SCHED; PG8_LDA(At, 1, 0); PG8_STAGE(PG8_SA(0, 1), a2 + hstep, voffA);
            PG8_WAIT_V(8); PG8_WAIT_L(0); PG8_BAR; PG8_MMA(0, 0, At, B0); PG8_MMA(0, 1, At, B1); PG8_BAR; PG8_SCHED;
            PG8_LDA(At, 1, 1); PG8_STAGE(PG8_SB(1, 0), b3, voffB); PG8_STAGE(PG8_SB(1, 1), b3 + hstep, voffB); PG8_STAGE(PG8_SA(1, 0), a3, voffA);
            PG8_WAIT_V(8); PG8_WAIT_L(0); PG8_BAR; PG8_MMA(1, 0, At, B0); PG8_MMA(1, 1, At, B1); PG8_BAR; PG8_SCHED;
            } else {
            PG8_LDB(B0, 0, 0); PG8_SCHED; PG8_LDA(At, 0, 0); PG8_STAGE(PG8_SA(1, 1), a1 + hstep, voffA);
            PG8_WAIT_L(8); PG8_BAR; PG8_WAIT_L(0); PG8_MMA(0, 0, At, B0); PG8_BAR; PG8_SCHED;
            PG8_LDB(B1, 0, 1); PG8_STAGE(PG8_SB(0, 0), b2, voffB);
            PG8_BAR; PG8_WAIT_L(0); PG8_MMA(0, 1, At, B1); PG8_BAR;
            PG8_LDA(At, 0, 1); PG8_STAGE(PG8_SA(0, 0), a2, voffA);
            PG8_BAR; PG8_WAIT_L(0); PG8_MMA(1, 0, At, B0); PG8_BAR; PG8_SCHED;
            PG8_STAGE(PG8_SB(0, 1), b2 + hstep, voffB);
            PG8_WAIT_V(6); PG8_BAR; PG8_MMA(1, 1, At, B1); PG8_BAR;
            PG8_LDB(B0, 1, 0); PG8_SCHED; PG8_LDA(At, 1, 0); PG8_STAGE(PG8_SA(0, 1), a2 + hstep, voffA);
            PG8_WAIT_L(8); PG8_BAR; PG8_WAIT_L(0); PG8_MMA(0, 0, At, B0); PG8_BAR; PG8_SCHED;
            PG8_LDB(B1, 1, 1); PG8_STAGE(PG8_SB(1, 0), b3, voffB);
            PG8_BAR; PG8_WAIT_L(0); PG8_MMA(0, 1, At, B1); PG8_BAR;
            PG8_LDA(At, 1, 1); PG8_STAGE(PG8_SA(1, 0), a3, voffA);
            PG8_BAR; PG8_WAIT_L(0); PG8_MMA(1, 0, At, B0); PG8_BAR; PG8_SCHED;
            PG8_STAGE(PG8_SB(1, 1), b3 + hstep, voffB);
            PG8_WAIT_V(6); PG8_BAR; PG8_MMA(1, 1, At, B1); PG8_BAR;
            }
        }
        if constexpr (ALIGN_EPI) { if (wr == 0) PG8_BAR; }
        if constexpr (!Epi::AFTER_DRAIN) { E(acc, cur, wr, wc, fr, fq); S.done(cur); }
        if (!has_next) break;
#pragma unroll
        for (int a = 0; a < 2; ++a)
#pragma unroll
            for (int b = 0; b < 2; ++b)
#pragma unroll
                for (int m = 0; m < 4; ++m)
#pragma unroll
                    for (int n = 0; n < 2; ++n) acc[a][b][m][n] = (f32x4){0.f, 0.f, 0.f, 0.f};
        cur = nxt; cA = nA; cB = nB; ++ui;
        if constexpr (ALIGN_EPI) { if (wr == 1) PG8_BAR; }
    }
    PG8_WAIT_V(0);
    if constexpr (!ALIGN_EPI) { if (wr == 0) PG8_BAR; }
    PG8_BAR;
    if constexpr (Epi::AFTER_DRAIN) { E.fused(acc, cur, wr, wc, fr, fq, lds, wid, lane); S.done(cur); }
#undef PG8_SA
#undef PG8_SB
#undef PG8_STAGE
#undef PG8_LDA
#undef PG8_LDB
#undef PG8_MMA
#undef PG8_WAIT_V
#undef PG8_WAIT_L
#undef PG8_BAR
#undef PG8_SCHED
}
}
namespace pg8 {
struct EpiStoreBf16 {
    static constexpr bool PERM = true, AFTER_DRAIN = false;
    bf16_t* O; int ldc; int pad;
    __device__ __forceinline__ void operator()(const f32x4 (&acc)[2][2][4][2], const Unit& u, int wr, int wc, int fr, int fq) const {
        const int row0 = u.pm * BM + wr * 64 + fr, col0 = u.pn * BM + wc * 32 + 8 * fq;
#pragma unroll
        for (int ai = 0; ai < 2; ++ai)
#pragma unroll
            for (int m = 0; m < 4; ++m) { bf16_t* rowp = O + (size_t)(row0 + ai * HALF + m * 16) * ldc + col0;
#pragma unroll
                for (int bj = 0; bj < 2; ++bj) { const f32x4 v0 = acc[ai][bj][m][0], v1 = acc[ai][bj][m][1];
                    u32x4 w; w.x = cvt_pk_bf16(v0[0], v0[1]); w.y = cvt_pk_bf16(v0[2], v0[3]); w.z = cvt_pk_bf16(v1[0], v1[1]); w.w = cvt_pk_bf16(v1[2], v1[3]);
                    *(u32x4*)(rowp + bj * HALF) = w; } }
    }
};
__device__ __forceinline__ float bflo(unsigned w) { return __uint_as_float(w << 16); }
__device__ __forceinline__ float bfhi(unsigned w) { return __uint_as_float(w & 0xffff0000u); }
__device__ __forceinline__ float sigm(float x) { return __builtin_amdgcn_rcpf(1.f + __expf(-x)); }
template <bool ADD> struct EpiGate {
    static constexpr bool PERM = true, AFTER_DRAIN = false;
    const bf16_t* gate; const bf16_t* prev; bf16_t* O; int ldg; int pad;
    __device__ __forceinline__ void operator()(const f32x4 (&acc)[2][2][4][2], const Unit& u, int wr, int wc, int fr, int fq) const {
        const int row0 = u.pm * BM + wr * 64 + fr, col0 = u.pn * BM + wc * 32 + 8 * fq;
#pragma unroll
        for (int ai = 0; ai < 2; ++ai)
#pragma unroll
            for (int m = 0; m < 4; ++m) { const size_t r = (size_t)(row0 + ai * HALF + m * 16);
#pragma unroll
                for (int bj = 0; bj < 2; ++bj) { const int c = col0 + bj * HALF;
                    const u32x4 gw = *(const u32x4*)(gate + r * ldg + c);
                    const f32x4 v0 = acc[ai][bj][m][0], v1 = acc[ai][bj][m][1];
                    float o[8];
                    o[0] = sigm(bflo(gw.x)) * v0[0]; o[1] = sigm(bfhi(gw.x)) * v0[1]; o[2] = sigm(bflo(gw.y)) * v0[2]; o[3] = sigm(bfhi(gw.y)) * v0[3];
                    o[4] = sigm(bflo(gw.z)) * v1[0]; o[5] = sigm(bfhi(gw.z)) * v1[1]; o[6] = sigm(bflo(gw.w)) * v1[2]; o[7] = sigm(bfhi(gw.w)) * v1[3];
                    if (ADD) { const u32x4 pw = *(const u32x4*)(prev + r * 1024 + c);
                        o[0] += bflo(pw.x); o[1] += bfhi(pw.x); o[2] += bflo(pw.y); o[3] += bfhi(pw.y); o[4] += bflo(pw.z); o[5] += bfhi(pw.z); o[6] += bflo(pw.w); o[7] += bfhi(pw.w); }
                    u32x4 w; w.x = cvt_pk_bf16(o[0], o[1]); w.y = cvt_pk_bf16(o[2], o[3]); w.z = cvt_pk_bf16(o[4], o[5]); w.w = cvt_pk_bf16(o[6], o[7]);
                    *(u32x4*)(O + r * 1024 + c) = w; } }
    }
};
struct EpiResid {
    static constexpr bool PERM = false, AFTER_DRAIN = false;
    const float* base; const float* gvec; float* out;
    __device__ __forceinline__ void operator()(const f32x4 (&acc)[2][2][4][2], const Unit& u, int wr, int wc, int fr, int fq) const {
        const int row0 = u.pm * BM + wr * 64 + fr, col0 = u.pn * BM + wc * 32 + 4 * fq;
        const float* gv = gvec + ((u.pm * BM) / 8192) * 6144;
#pragma unroll
        for (int bj = 0; bj < 2; ++bj)
#pragma unroll
            for (int n = 0; n < 2; ++n) { const int c = col0 + bj * HALF + n * 16; const f32x4 g = *(const f32x4*)(gv + c);
#pragma unroll
                for (int ai = 0; ai < 2; ++ai)
#pragma unroll
                    for (int m = 0; m < 4; ++m) { const size_t off = (size_t)(row0 + ai * HALF + m * 16) * 1024 + c;
                        const f32x4 b = *(const f32x4*)(base + off); *(f32x4*)(out + off) = b + g * acc[ai][bj][m][n]; } }
    }
};
struct EpiSharedRouter {
    static constexpr bool PERM = true, AFTER_DRAIN = false;
    bf16_t* sact; float* logits;
    __device__ __forceinline__ void operator()(const f32x4 (&acc)[2][2][4][2], const Unit& u, int wr, int wc, int fr, int fq) const {
        const int row0 = u.pm * BM + wr * 64 + fr;
        if (u.pn < 2) {
#pragma unroll
            for (int ai = 0; ai < 2; ++ai)
#pragma unroll
                for (int m = 0; m < 4; ++m) { const size_t r = (size_t)(row0 + ai * HALF + m * 16);
#pragma unroll
                    for (int bj = 0; bj < 2; ++bj) { const int c8 = (u.pn * BM + bj * HALF + wc * 32 + 8 * fq) >> 1;
                        const f32x4 g = acc[ai][bj][m][0], up = acc[ai][bj][m][1];
                        float a0 = g[0] * sigm(g[0]) * up[0], a1 = g[1] * sigm(g[1]) * up[1], a2 = g[2] * sigm(g[2]) * up[2], a3 = g[3] * sigm(g[3]) * up[3];
                        uint2 w; w.x = cvt_pk_bf16(a0, a1); w.y = cvt_pk_bf16(a2, a3);
                        *(uint2*)(sact + r * 256 + c8) = w; } }
        } else {
#pragma unroll
            for (int ai = 0; ai < 2; ++ai)
#pragma unroll
                for (int m = 0; m < 4; ++m) { const size_t r = (size_t)(row0 + ai * HALF + m * 16);
#pragma unroll
                    for (int bj = 0; bj < 2; ++bj) { const int c = bj * HALF + wc * 32 + 8 * fq;
                        *(f32x4*)(logits + r * 256 + c) = acc[ai][bj][m][0]; *(f32x4*)(logits + r * 256 + c + 4) = acc[ai][bj][m][1]; } }
        }
    }
};
struct EpiFinal {
    static constexpr bool PERM = true, AFTER_DRAIN = false;
    const float* x1; const float* gvec; const bf16_t* Y; float* out;
    __device__ __forceinline__ void operator()(const f32x4 (&acc)[2][2][4][2], const Unit& u, int wr, int wc, int fr, int fq) const {
        const int row0 = u.pm * BM + wr * 64 + fr, col0 = u.pn * BM + wc * 32 + 8 * fq;
        const float* gv = gvec + ((u.pm * BM) / 8192) * 6144;
#pragma unroll
        for (int ai = 0; ai < 2; ++ai)
#pragma unroll
            for (int m = 0; m < 4; ++m) { const size_t r = (size_t)(row0 + ai * HALF + m * 16);
#pragma unroll
                for (int bj = 0; bj < 2; ++bj) { const int c = col0 + bj * HALF;
                    f32x4 s0 = acc[ai][bj][m][0], s1 = acc[ai][bj][m][1];
#pragma unroll
                    for (int k = 0; k < 8; ++k) { const u32x4 yw = *(const u32x4*)(Y + (r * 8 + k) * 1024 + c);
                        s0[0] += bflo(yw.x); s0[1] += bfhi(yw.x); s0[2] += bflo(yw.y); s0[3] += bfhi(yw.y);
                        s1[0] += bflo(yw.z); s1[1] += bfhi(yw.z); s1[2] += bflo(yw.w); s1[3] += bfhi(yw.w); }
                    const f32x4 g0 = *(const f32x4*)(gv + c), g1 = *(const f32x4*)(gv + c + 4);
                    const f32x4 b0 = *(const f32x4*)(x1 + r * 1024 + c), b1 = *(const f32x4*)(x1 + r * 1024 + c + 4);
                    *(f32x4*)(out + r * 1024 + c) = b0 + g0 * s0; *(f32x4*)(out + r * 1024 + c + 4) = b1 + g1 * s1; } }
    }
};
}
#define XB_TMO      128
#define XB_XCNT(j)  (256  + 64 * (j))
#define XB_XSUB(j)  (1280 + 64 * (j))
#define XB_XGEN(j)  (2304 + 64 * (j))
#define XB_TOP      3328
#define XB_TOPGEN   3392
#define XCD_BAR_WORDS 3456
#define XB_SPIN_CAP (1u << 18)

__device__ __forceinline__ unsigned xb_ld(unsigned* p)              { return __hip_atomic_load(p, __ATOMIC_RELAXED, __HIP_MEMORY_SCOPE_AGENT); }
__device__ __forceinline__ unsigned xb_add(unsigned* p, unsigned v) { return __hip_atomic_fetch_add(p, v, __ATOMIC_RELAXED, __HIP_MEMORY_SCOPE_AGENT); }
__device__ __forceinline__ unsigned xb_xcc_id() { return (unsigned)__builtin_amdgcn_s_getreg((3 << 11) | 20) & 0xFu; }
#define XB_SPIN(cond, bar) do { unsigned _sp = 0; while (cond) { __builtin_amdgcn_s_sleep(1); \
    if ((++_sp & 255u) == 0u) { if (xb_ld(&(bar)[XB_TMO])) break; if (_sp > XB_SPIN_CAP) { atomicAdd(&(bar)[XB_TMO], 1u); break; } } } } while (0)

struct XcdBarrier {
    unsigned* bar; unsigned x;
    volatile LAS unsigned* st;
};

__device__ __forceinline__ XcdBarrier xcd_barrier_post(unsigned* bar, volatile LAS unsigned* st) {
    XcdBarrier b; b.bar = bar; b.x = xb_xcc_id(); b.st = st;
    if (threadIdx.x == 0) (void)xb_add(&bar[XB_XCNT(b.x)], 1u);
    return b;
}
__device__ __forceinline__ void xcd_barrier_complete(unsigned* bar, unsigned x, unsigned& nloc, unsigned& nx) {
    const unsigned G = gridDim.x * gridDim.y * gridDim.z;
    unsigned sum, cnt, mine, sp = 0u;
    for (;;) {
        sum = 0u; cnt = 0u; mine = 0u;
#pragma unroll
        for (unsigned j = 0; j < 16; ++j) { const unsigned c = xb_ld(&bar[XB_XCNT(j)]); sum += c; cnt += (c > 0u) ? 1u : 0u; mine = (j == x) ? c : mine; }
        if (sum == G) break;
        __builtin_amdgcn_s_sleep(1);
        if ((++sp & 255u) == 0u) { if (xb_ld(&bar[XB_TMO])) break; if (sp > XB_SPIN_CAP) { atomicAdd(&bar[XB_TMO], 1u); break; } }
    }
    nloc = mine > 0u ? mine : 1u; nx = cnt > 0u ? cnt : 1u;
}

template <int PF = 0>
__device__ __forceinline__ void xcd_barrier(const XcdBarrier& b) {
    asm volatile("s_waitcnt vmcnt(0)" ::: "memory");
    __syncthreads();
    if (threadIdx.x == 0) {
        unsigned* bar = b.bar;
        __builtin_amdgcn_s_waitcnt(0);
        unsigned nloc = b.st[0], nx = b.st[1];
        if (nloc == 0u) { xcd_barrier_complete(bar, b.x, nloc, nx); b.st[0] = nloc; b.st[1] = nx; }
        const unsigned old = xb_add(&bar[XB_XSUB(b.x)], 1u);
        const unsigned gen = old / nloc;
        if (old + 1u == (gen + 1u) * nloc) {
            if (!(PF & 2)) __builtin_amdgcn_fence(__ATOMIC_RELEASE, "agent");
            asm volatile("s_waitcnt vmcnt(0)" ::: "memory");
            const unsigned og = xb_add(&bar[XB_TOP], 1u);
            const unsigned tg = og / nx;
            if (og + 1u == (tg + 1u) * nx) xb_add(&bar[XB_TOPGEN], 1u);
            else XB_SPIN(xb_ld(&bar[XB_TOPGEN]) == tg, bar);
            if (!(PF & 2)) __builtin_amdgcn_fence(__ATOMIC_ACQUIRE, "agent");
            xb_add(&bar[XB_XGEN(b.x)], 1u);
            asm volatile("s_waitcnt vmcnt(0)" ::: "memory");
        } else {
            XB_SPIN(xb_ld(&bar[XB_XGEN(b.x)]) == gen, bar);
            if (!(PF & 1)) __builtin_amdgcn_fence(__ATOMIC_ACQUIRE, "agent");
            asm volatile("s_waitcnt vmcnt(0)" ::: "memory");
        }
    }
    __syncthreads();
}
template <class Map>
__device__ __forceinline__ void transpose_item(const float* W, int ldw, int K, bf16_t* WT, int row_off, int nblk, LAS float* scr, int item, int lane, Map srccol) {
    const int kb = item / nblk, nb = item % nblk, k0 = 64 * kb, n0 = 32 * nb;
    const int sc = srccol(n0 + (lane & 31));
#pragma unroll 8
    for (int i = 0; i < 32; ++i) { const int kk = 2 * i + (lane >> 5); scr[kk * 33 + (lane & 31)] = W[(size_t)(k0 + kk) * ldw + sc]; }
    LDS_WAIT(); asm volatile("" ::: "memory");
    const int c = lane & 7;
#pragma unroll
    for (int j = 0; j < 4; ++j) { const int n = (lane >> 3) + 8 * j; const LAS float* s = scr + (8 * c) * 33 + n;
        v4u o; o.x = pk2(s[0 * 33], s[1 * 33]); o.y = pk2(s[2 * 33], s[3 * 33]); o.z = pk2(s[4 * 33], s[5 * 33]); o.w = pk2(s[6 * 33], s[7 * 33]);
        *(v4u*)(WT + (size_t)(row_off + n0 + n) * K + k0 + 8 * c) = o; }
    LDS_WAIT(); asm volatile("" ::: "memory");
}
__device__ __forceinline__ float rlane(float v, int i) { return __int_as_float(__builtin_amdgcn_readlane(__float_as_int(v), i)); }
__device__ __forceinline__ void p0_phase(Frame& F, const Args& A) {
    const int gw = F.vcu * NWAVES + F.wave, NGW = F.G * NWAVES, lane = F.lane;
    const float* c = A.in[1]; const float* w_ada = A.in[2]; const float* w_in = A.in[5];
    LAS float* scr = (LAS float*)(F.lds + F.wave * 8704);
    for (int u = gw; u < 768 + 16 * 176; u += NGW) {
        if (u < 768) {
            const int eb = u >> 3, dc = u & 7, e = eb * 64 + lane, d0 = dc * 128;
            const float sa0 = siluf(c[d0 + lane]), sa1 = siluf(c[d0 + 64 + lane]), sb0 = siluf(c[D + d0 + lane]), sb1 = siluf(c[D + d0 + 64 + lane]);
            const float* wp = w_ada + (size_t)d0 * 6144 + e; float a0 = 0.f, a1 = 0.f;
#pragma unroll 16
            for (int i = 0; i < 64; ++i) { const float w = wp[(size_t)i * 6144]; a0 += rlane(sa0, i) * w; a1 += rlane(sb0, i) * w; }
#pragma unroll 16
            for (int i = 0; i < 64; ++i) { const float w = wp[(size_t)(64 + i) * 6144]; a0 += rlane(sa1, i) * w; a1 += rlane(sb1, i) * w; }
            float* modp = (float*)(F.ws + WS_MODP) + dc * 12288; modp[e] = a0; modp[6144 + e] = a1;
        } else transpose_item(w_in, INC, 1024, (bf16_t*)(F.ws + WS_WIN), 0, 176, scr, u - 768, lane, [](int n) { return n < 2048 ? n : n + 8; });
    }
    if (gw == 0) {
        const float s1 = wave_sum(A.in[13][lane] * A.in[14][lane]), s2 = wave_sum(A.in[15][lane] * A.in[16][lane]);
        float qm = fabsf(A.in[11][lane]), km = fabsf(A.in[12][lane]);
#pragma unroll
        for (int o = 1; o < 64; o <<= 1) { qm = fmaxf(qm, __shfl_xor(qm, o)); km = fmaxf(km, __shfl_xor(km, o)); }
        if (lane == 0) { float* sc = (float*)(F.ws + WS_SCAL); sc[0] = expf(s1) - expf(s2) + LAM_INIT; sc[1] = 8.f * qm * km * 1.4426950408889634f; }
    }
}
__device__ __forceinline__ void late_weight_copies(Frame& F, const Args& A, int w0, int nw) {
    LAS float* scr = (LAS float*)(F.lds + F.wave * 16384);
    const int lane = F.lane;
    const float* w_o_gdn = A.in[10]; const float* w_o_diff = A.in[18]; const float* w_out = A.in[19]; const float* w_router = A.in[21];
    const float* ws_gu = A.in[25]; const float* ws_dn = A.in[26];
    constexpr int I_WOA = 8 * 32, I_WOB = 8 * 32, I_WOUT = 16 * 32, I_SGU = 16 * 16, I_RT = 16 * 8, I_SD = 4 * 32;
    constexpr int NITEMS = I_WOA + I_WOB + I_WOUT + I_SGU + I_RT + I_SD;
    for (int it = w0; it < NITEMS; it += nw) {
        int r = it;
        if (r < I_WOA) { transpose_item(w_o_gdn, 1024, 512, (bf16_t*)(F.ws + WS_WOA), 0, 32, scr, r, lane, [](int n) { return n; }); continue; } r -= I_WOA;
        if (r < I_WOB) { transpose_item(w_o_diff, 1024, 512, (bf16_t*)(F.ws + WS_WOB), 0, 32, scr, r, lane, [](int n) { return n; }); continue; } r -= I_WOB;
        if (r < I_WOUT) { transpose_item(w_out, 1024, 1024, (bf16_t*)(F.ws + WS_WOUT), 0, 32, scr, r, lane, [](int n) { return n; }); continue; } r -= I_WOUT;
        if (r < I_SGU) { transpose_item(ws_gu, 512, 1024, (bf16_t*)(F.ws + WS_W9), 0, 16, scr, r, lane, [](int n) { const int i8 = n >> 3, j = n & 7; return j < 4 ? 4 * i8 + j : 256 + 4 * i8 + (j - 4); }); continue; } r -= I_SGU;
        if (r < I_RT) { transpose_item(w_router, 256, 1024, (bf16_t*)(F.ws + WS_W9), 512, 8, scr, r, lane, [](int n) { return n; }); continue; } r -= I_RT;
        transpose_item(ws_dn, 1024, 256, (bf16_t*)(F.ws + WS_WSD), 0, 32, scr, r, lane, [](int n) { return n; });
    }
}
__device__ __forceinline__ float mod_reduce(const float* modp, const float* b_ada, int idx) {
    return (((modp[idx] + modp[12288 + idx]) + (modp[2 * 12288 + idx] + modp[3 * 12288 + idx])) + ((modp[4 * 12288 + idx] + modp[5 * 12288 + idx]) + (modp[6 * 12288 + idx] + modp[7 * 12288 + idx]))) + b_ada[idx % 6144];
}
template <bool FROM_PARTIALS, bool WITH_BD>
__device__ __forceinline__ void norm_mod_phase(Frame& F, const Args& A, const float* src, const float* gain, int sh_off, int sc_off, bf16_t* dst) {
    LAS float* shs = (LAS float*)F.lds;
    LAS float* scs = shs + 2048;
    LAS float* wbd = scs + 2048;
    const float* modp = (const float*)(F.ws + WS_MODP); const float* b_ada = A.in[3]; float* mod = (float*)(F.ws + WS_MOD);
    for (int i = F.tid; i < 4096; i += NWAVES * 64) { const int b = i >> 11, r = i & 2047; const int idx = b * 6144 + (r < 1024 ? sh_off + r : sc_off + r - 1024);
        const float v = FROM_PARTIALS ? mod_reduce(modp, b_ada, idx) : mod[idx];
        if (r < 1024) shs[b * 1024 + r] = v; else scs[b * 1024 + r - 1024] = v; }
    if (WITH_BD) { const float* w_in = A.in[5]; for (int i = F.tid; i < 8192; i += NWAVES * 64) wbd[i] = w_in[(size_t)(i >> 3) * INC + 2048 + (i & 7)]; }
    if (FROM_PARTIALS) for (int idx = blockIdx.x * (NWAVES * 64) + F.tid; idx < 12288; idx += F.G * NWAVES * 64) mod[idx] = mod_reduce(modp, b_ada, idx);
    __syncthreads();
    const int gw = F.vcu * NWAVES + F.wave, NGW = F.G * NWAVES, lane = F.lane;
    for (int row = gw; row < T; row += NGW) {
        const int b = row / S; const float* xr = src + (size_t)row * D;
        f32x4 v[4]; float ss = 0.f;
#pragma unroll
        for (int j = 0; j < 4; ++j) { v[j] = *(const f32x4*)(xr + j * 256 + lane * 4); ss += (v[j][0] * v[j][0] + v[j][1] * v[j][1]) + (v[j][2] * v[j][2] + v[j][3] * v[j][3]); }
        const float rs = rsqrtf(wave_sum(ss) * (1.f / D) + EPS);
        float bacc[8];
#pragma unroll
        for (int q = 0; q < 8; ++q) bacc[q] = 0.f;
#pragma unroll
        for (int j = 0; j < 4; ++j) { const int col = j * 256 + lane * 4; const f32x4 gn = *(const f32x4*)(gain + col);
            const f32x4 sh = *(const LAS f32x4*)(shs + b * 1024 + col), sc = *(const LAS f32x4*)(scs + b * 1024 + col);
            f32x4 hv = (v[j] * rs * gn) * (sc + 1.f) + sh;
            uint2 w; w.x = pk2(hv[0], hv[1]); w.y = pk2(hv[2], hv[3]);
            *(uint2*)(dst + (size_t)row * D + col) = w;
            if (WITH_BD) {
#pragma unroll
                for (int i = 0; i < 4; ++i) { const f32x4 w0 = *(const LAS f32x4*)(wbd + (col + i) * 8), w1 = *(const LAS f32x4*)(wbd + (col + i) * 8 + 4);
                    bacc[0] += hv[i] * w0[0]; bacc[1] += hv[i] * w0[1]; bacc[2] += hv[i] * w0[2]; bacc[3] += hv[i] * w0[3];
                    bacc[4] += hv[i] * w1[0]; bacc[5] += hv[i] * w1[1]; bacc[6] += hv[i] * w1[2]; bacc[7] += hv[i] * w1[3]; } } }
        if (WITH_BD) {
#pragma unroll
            for (int q = 0; q < 8; ++q) bacc[q] = wave_sum(bacc[q]);
            if (lane == 0) { float* bd = (float*)(F.ws + WS_BD) + (size_t)row * 8; *(f32x4*)bd = (f32x4){bacc[0], bacc[1], bacc[2], bacc[3]}; *(f32x4*)(bd + 4) = (f32x4){bacc[4], bacc[5], bacc[6], bacc[7]}; } }
    }
}
__device__ __forceinline__ void route_phase(Frame& F, const Args& A) {
    const float* logits = (const float*)(F.ws + WS_LOGITS); const float* rbias = A.in[22];
    int* top_idx = (int*)(F.ws + WS_TOPI); float* top_w = (float*)(F.ws + WS_TOPW);
    unsigned* ecnt = (unsigned*)(F.ws + WS_CTL) + CW_ECNT; int* lists = (int*)(F.ws + WS_LIST);
    const int gw = F.vcu * NWAVES + F.wave, NGW = F.G * NWAVES, lane = F.lane;
    const f32x4 rb = *(const f32x4*)(rbias + lane * 4);
    for (int t = gw; t < T; t += NGW) {
        float sc[4], ch[4];
        const f32x4 lg = *(const f32x4*)(logits + (size_t)t * 256 + lane * 4);
#pragma unroll
        for (int i = 0; i < 4; ++i) { sc[i] = 1.f / (1.f + __expf(-lg[i])); ch[i] = sc[i] + rb[i]; }
        float a1 = fmaxf(ch[0], ch[1]), a2 = fminf(ch[0], ch[1]);
        { const float b1 = fmaxf(ch[2], ch[3]), b2 = fminf(ch[2], ch[3]); const float m1 = fmaxf(a1, b1), m2 = fmaxf(fminf(a1, b1), fmaxf(a2, b2)); a1 = m1; a2 = m2; }
#pragma unroll
        for (int o = 1; o < 8; o <<= 1) { const float b1 = __shfl_xor(a1, o), b2 = __shfl_xor(a2, o); const float m1 = fmaxf(a1, b1), m2 = fmaxf(fminf(a1, b1), fmaxf(a2, b2)); a1 = m1; a2 = m2; }
        const float gs = a1 + a2; const int g = lane >> 3;
        int rank = 0;
#pragma unroll
        for (int gg = 0; gg < 8; ++gg) { const float o = __shfl(gs, gg * 8); rank += (o > gs || (o == gs && gg < g)) ? 1 : 0; }
        const bool sel = rank < 4;
        float mc[4];
#pragma unroll
        for (int i = 0; i < 4; ++i) mc[i] = sel ? ch[i] : -INFINITY;
        int my_idx = 0; float my_sc = 0.f, sum = 0.f;
#pragma unroll
        for (int r = 0; r < 8; ++r) {
            float bv = mc[0]; int bi = 0;
#pragma unroll
            for (int i = 1; i < 4; ++i) if (mc[i] > bv) { bv = mc[i]; bi = i; }
            int be = lane * 4 + bi;
#pragma unroll
            for (int o = 1; o < 64; o <<= 1) { const float ov = __shfl_xor(bv, o); const int oe = __shfl_xor(be, o); if (ov > bv || (ov == bv && oe < be)) { bv = ov; be = oe; } }
            float s = 0.f;
            if ((be >> 2) == lane) { const int b2 = be & 3;
                s = b2 == 0 ? sc[0] : b2 == 1 ? sc[1] : b2 == 2 ? sc[2] : sc[3];
                if (b2 == 0) mc[0] = -INFINITY; else if (b2 == 1) mc[1] = -INFINITY; else if (b2 == 2) mc[2] = -INFINITY; else mc[3] = -INFINITY; }
            s = __shfl(s, be >> 2);
            sum += s;
            if (lane == r) { my_idx = be; my_sc = s; }
        }
        if (lane < 8) { top_idx[t * 8 + lane] = my_idx; top_w[t * 8 + lane] = my_sc / sum * 2.5f;
            const unsigned slot = __hip_atomic_fetch_add(ecnt + my_idx, 1u, __ATOMIC_RELAXED, __HIP_MEMORY_SCOPE_AGENT);
            lists[(size_t)my_idx * T + slot] = t * 8 + lane; }
    }
}

typedef float f32x16 __attribute__((ext_vector_type(16)));
constexpr int XT = 256;
constexpr int XA_OFF = 0, XA_STAGE = 16384;
constexpr int XWP_OFF = 32768, XWP_WAVE = 2048;
constexpr int XYS_OFF = 49152, XYS_WAVE = 2560, XYS_STRIDE = 80;
constexpr int XCNT_OFF = XYS_OFF + 8 * XYS_WAVE;
static_assert(XCNT_OFF + 1024 <= CTRL_OFF, "MoE LDS map");
constexpr int CW_MQ = 1024;

struct WRegs { f32x4 v[4]; };
__device__ __forceinline__ void xw_load(WRegs& R, const float* wb, unsigned wo, int ldw, int k0) {
    const float* p = wb + (size_t)k0 * ldw + wo;
#pragma unroll
    for (int i = 0; i < 4; ++i) R.v[i] = *(const f32x4*)(p + (size_t)i * ldw);
}
__device__ __forceinline__ void xw_store(const WRegs& R, LAS unsigned char* wd) {
#pragma unroll
    for (int j = 0; j < 4; ++j) { u32x2 o; o.x = pg8::cvt_pk_bf16(R.v[0][j], R.v[1][j]); o.y = pg8::cvt_pk_bf16(R.v[2][j], R.v[3][j]); *(LAS u32x2*)(wd + j * 16) = o; }
}
template <int NS, int NP, class WOff, class Epi>
__device__ __forceinline__ void xpasses(Frame& F, f32x16 (&acc)[8], const unsigned char* ab0, unsigned o0, unsigned o1, const float* wb, int ldw, WOff wo, Epi epi,
                                        LAS unsigned char* wp, LAS unsigned char* wd, LAS unsigned char* ast, int rd_t0, int rd_t1, int rd_w) {
    LAS unsigned char* lds = F.lds;
    WRegs R[2]; v4u ra[2][2];
#pragma unroll
    for (int tt = 0; tt < 8; ++tt)
#pragma unroll
        for (int q = 0; q < 16; ++q) acc[tt][q] = 0.f;
    asm volatile("s_waitcnt vmcnt(0) lgkmcnt(0)" ::: "memory"); __builtin_amdgcn_s_barrier();
    { const unsigned w0 = wo(0);
      const v4u p0 = *(const v4u*)(ab0 + o0), p1 = *(const v4u*)(ab0 + o1);
      xw_load(R[0], wb, w0, ldw, 0); xw_load(R[1], wb, w0, ldw, 32);
      ra[1][0] = *(const v4u*)(ab0 + 64 + o0); ra[1][1] = *(const v4u*)(ab0 + 64 + o1);
      *(LAS v4u*)ast = p0; *(LAS v4u*)(ast + 1024) = p1; xw_store(R[0], wd); }
    asm volatile("s_waitcnt lgkmcnt(0)" ::: "memory"); __builtin_amdgcn_s_barrier();
#pragma unroll 1
    for (int p = 0; p < NP; ++p) {
        const unsigned wcur = wo(p), wnxt = wo(p + 1 < NP ? p + 1 : p);
#pragma unroll 1
        for (int s2 = 0; s2 < NS; s2 += 2) {
#pragma unroll
            for (int j = 0; j < 2; ++j) { const int s = s2 + j;
                {
                  const bool wrap = s + 2 >= NS; const bool last = p + 1 >= NP;
                  const int sl = wrap ? (last ? NS - 1 : s + 2 - NS) : s + 2;
                  xw_load(R[j], wb, wrap ? wnxt : wcur, ldw, sl * 32); const unsigned char* ap = ab0 + sl * 64; ra[j][0] = *(const v4u*)(ap + o0); ra[j][1] = *(const v4u*)(ap + o1); }
                const LAS unsigned char* ab = lds + XA_OFF + j * XA_STAGE;
#pragma unroll
                for (int ks = 0; ks < 2; ++ks) { const bf16x8 wf = *(const LAS bf16x8*)(wp + rd_w + ks * 1024);
                    bf16x8 tf[8];
#pragma unroll
                    for (int tt = 0; tt < 8; ++tt) tf[tt] = *(const LAS bf16x8*)(ab + (ks ? rd_t1 : rd_t0) + tt * 2048);
#pragma unroll
                    for (int tt = 0; tt < 8; ++tt) acc[tt] = __builtin_amdgcn_mfma_f32_32x32x16_bf16(wf, tf[tt], acc[tt], 0, 0, 0); }
                { asm volatile("s_waitcnt lgkmcnt(0)" ::: "memory"); xw_store(R[j ^ 1], wd);
                  LAS unsigned char* d = ast + (j ^ 1) * XA_STAGE; *(LAS v4u*)d = ra[j ^ 1][0]; *(LAS v4u*)(d + 1024) = ra[j ^ 1][1]; }
                asm volatile("s_waitcnt lgkmcnt(0)" ::: "memory"); __builtin_amdgcn_s_barrier();
            }
        }
        epi(p);
#pragma unroll
        for (int tt = 0; tt < 8; ++tt)
#pragma unroll
            for (int q = 0; q < 16; ++q) acc[tt][q] = 0.f;
    }
}

__device__ __forceinline__ void moe_item(Frame& F, const Args& A, int e, int rt, int total) {
    const int lane = F.lane, wave = F.wave, r31 = lane & 31, hi = lane >> 5;
    LAS unsigned char* lds = F.lds;
    const int* list = (const int*)(F.ws + WS_LIST) + (size_t)e * T;
    const float* top_w = (const float*)(F.ws + WS_TOPW);
    const unsigned char* hsrc = F.ws + WS_H; bf16_t* Y = (bf16_t*)(F.ws + WS_Y);
    unsigned char* xb = F.ws + WS_XA + (size_t)blockIdx.x * XA_BLOCK;
    const float* W1 = A.in[23] + (size_t)e * 1024 * 512; const float* W2 = A.in[24] + (size_t)e * 256 * 1024;
    const int r0 = rt * XT;
    LAS unsigned char* wp = lds + XWP_OFF + wave * XWP_WAVE;
    const int kgrp = lane >> 3;
    LAS unsigned char* wd = wp + ((kgrp >> 1) * 32 + 4 * (lane & 7)) * 16 + (kgrp & 1) * 8;
    const int rl0 = wave * 32 + (lane >> 2), rl1 = rl0 + 16;
    const unsigned sw0 = (unsigned)(((lane & 3) ^ ((rl0 >> 2) & 3)) * 16), sw1 = (unsigned)(((lane & 3) ^ ((rl1 >> 2) & 3)) * 16);
    unsigned g0, g1;
    { int ra_ = r0 + rl0; ra_ = ra_ < total ? ra_ : r0; int rb_ = r0 + rl1; rb_ = rb_ < total ? rb_ : r0;
      g0 = (unsigned)(list[ra_] >> 3) * 2048u + sw0; g1 = (unsigned)(list[rb_] >> 3) * 2048u + sw1; }
    LAS unsigned char* ast = lds + XA_OFF + wave * 2048 + lane * 16;
    const int rd_t0 = r31 * 64 + ((hi ^ ((r31 >> 2) & 3)) * 16), rd_t1 = r31 * 64 + (((2 + hi) ^ ((r31 >> 2) & 3)) * 16);
    const int rd_w = (hi * 32 + r31) * 16;
    f32x16 acc[8];
    xpasses<32, 2>(F, acc, hsrc, g0, g1, W1, 512,
        [&](int p) { return (unsigned)(((lane & 4) ? 256 + 128 * p + 16 * wave : 128 * p + 16 * wave) + 4 * (lane & 3) + (4 * kgrp) * 512); },
        [&](int p) {
            int ln = lane; asm volatile("" : "+v"(ln)); const int e31 = ln & 31, ehi = ln >> 5;
#pragma unroll
            for (int tt = 0; tt < 8; ++tt) { const int rl = 32 * tt + e31; const int r = r0 + rl; const float rw = r < total ? top_w[list[r]] : 0.f;
#pragma unroll
                for (int g = 0; g < 2; ++g) { float a[4];
#pragma unroll
                    for (int q = 0; q < 4; ++q) { const float gt = acc[tt][4 * g + q], up = acc[tt][8 + 4 * g + q]; a[q] = gt / (1.f + __expf(-gt)) * up * rw; }
                    u32x2 w; w.x = pg8::cvt_pk_bf16(a[0], a[1]); w.y = pg8::cvt_pk_bf16(a[2], a[3]);
                    *(u32x2*)(xb + (unsigned)(rl * 512 + (128 * p + 16 * wave + 8 * g + 4 * ehi) * 2)) = w; } } },
        wp, wd, ast, rd_t0, rd_t1, rd_w);
    const unsigned x0 = (unsigned)(rl0 * 512) + sw0, x1 = (unsigned)(rl1 * 512) + sw1;
    xpasses<8, 4>(F, acc, xb, x0, x1, W2, 1024,
        [&](int q4) { return (unsigned)(256 * q4 + 32 * wave + 4 * (lane & 7) + (4 * kgrp) * 1024); },
        [&](int q4) {
            const int col0 = 256 * q4 + 32 * wave;
            int ln = lane; asm volatile("" : "+v"(ln)); const int e31 = ln & 31, ehi = ln >> 5;
            LAS unsigned char* ys = lds + XYS_OFF + wave * XYS_WAVE;
#pragma unroll
            for (int tt = 0; tt < 8; ++tt) {
#pragma unroll
                for (int g = 0; g < 4; ++g) { u32x2 w; w.x = pg8::cvt_pk_bf16(acc[tt][4 * g], acc[tt][4 * g + 1]); w.y = pg8::cvt_pk_bf16(acc[tt][4 * g + 2], acc[tt][4 * g + 3]);
                    *(LAS u32x2*)(ys + e31 * XYS_STRIDE + (8 * g + 4 * ehi) * 2) = w; }
                asm volatile("s_waitcnt lgkmcnt(0)" ::: "memory");
#pragma unroll
                for (int pp = 0; pp < 2; ++pp) { const int rl = 16 * pp + (ln >> 2); const int r = r0 + 32 * tt + rl;
                    const v4u v = *(const LAS v4u*)(ys + rl * XYS_STRIDE + (ln & 3) * 16);
                    if (r < total) *(v4u*)(Y + (size_t)list[r] * 1024 + col0 + (ln & 3) * 8) = v; }
                asm volatile("s_waitcnt lgkmcnt(0)" ::: "memory");
            } },
        wp, wd, ast, rd_t0, rd_t1, rd_w);
}

__device__ __forceinline__ void moe_phase(Frame& F, const Args& A, int rep = 0) {
    LAS int* cnts = (LAS int*)(F.lds + XCNT_OFF);
    const unsigned* ecnt = (const unsigned*)(F.ws + WS_CTL) + CW_ECNT;
    unsigned* mq = (unsigned*)(F.ws + WS_CTL) + CW_MQ + 1024 * rep;
    volatile LAS int* slot = (volatile LAS int*)(F.lds + CTRL_OFF + 64);
    if (F.tid < 256) cnts[F.tid] = (int)ecnt[F.tid];
    __syncthreads();
    const int x0 = (int)(xb_xcc_id() & 7u);
    for (int xi = 0; xi < 8; ++xi) {
        const int x = (x0 + xi) & 7;
        int ntiles = 0;
#pragma unroll 1
        for (int i = 0; i < 32; ++i) ntiles += (cnts[x + 8 * i] + XT - 1) / XT;
        for (;;) {
            __syncthreads();
            if (F.tid == 0) slot[0] = (int)__hip_atomic_fetch_add(mq + 64 * x, 1u, __ATOMIC_RELAXED, __HIP_MEMORY_SCOPE_AGENT);
            __syncthreads();
            int k = slot[0];
            if (k >= ntiles) break;
            int e = x, tot = 0;
#pragma unroll 1
            for (int i = 0; i < 32; ++i) { const int c = cnts[x + 8 * i], t = (c + XT - 1) / XT; if (k < t) { e = x + 8 * i; tot = c; break; } k -= t; }
            moe_item(F, A, __builtin_amdgcn_readfirstlane(e), __builtin_amdgcn_readfirstlane(k), __builtin_amdgcn_readfirstlane(tot));
        }
    }
}
__device__ __forceinline__ void attn_prep_phase(Frame& F, const Args& A) {
    const bf16_t* P = (const bf16_t*)(F.ws + WS_P); bf16_t* QN = (bf16_t*)(F.ws + WS_QN); bf16_t* KN = (bf16_t*)(F.ws + WS_KN);
    const float* qg = A.in[11]; const float* kg = A.in[12];
    const int gw = F.vcu * NWAVES + F.wave, NGW = F.G * NWAVES, lane = F.lane;
    f32x4 gq0 = *(const f32x4*)(qg + (lane & 7) * 8), gq1 = *(const f32x4*)(qg + (lane & 7) * 8 + 4);
    f32x4 gk0 = *(const f32x4*)(kg + (lane & 7) * 8), gk1 = *(const f32x4*)(kg + (lane & 7) * 8 + 4);
    for (int t = gw; t < T; t += NGW) {
#pragma unroll
        for (int which = 0; which < 2; ++which) {
            const v4u w = *(const v4u*)(P + (size_t)t * LDP + (which ? C_KB : C_QB) + lane * 8);
            float v[8] = {pg8::bflo(w.x), pg8::bfhi(w.x), pg8::bflo(w.y), pg8::bfhi(w.y), pg8::bflo(w.z), pg8::bfhi(w.z), pg8::bflo(w.w), pg8::bfhi(w.w)};
            float ss = 0.f;
#pragma unroll
            for (int i = 0; i < 8; ++i) ss += v[i] * v[i];
            ss += __shfl_xor(ss, 1); ss += __shfl_xor(ss, 2); ss += __shfl_xor(ss, 4);
            const float r = rsqrtf(ss * (1.f / 64.f) + EPS) * (which ? 1.f : 0.125f * 1.4426950408889634f);
            const f32x4 g0 = which ? gk0 : gq0, g1 = which ? gk1 : gq1;
            v4u o; o.x = pk2(v[0] * r * g0[0], v[1] * r * g0[1]); o.y = pk2(v[2] * r * g0[2], v[3] * r * g0[3]); o.z = pk2(v[4] * r * g1[0], v[5] * r * g1[1]); o.w = pk2(v[6] * r * g1[2], v[7] * r * g1[3]);
            *(v4u*)((which ? KN : QN) + (size_t)t * 512 + lane * 8) = o;
        }
    }
}

typedef short s16x4 __attribute__((ext_vector_type(4)));
constexpr int AT_KPLANE = 1040;
constexpr int AT_KBYTES = 8 * AT_KPLANE;
constexpr int AT_VROW = 320;
constexpr int AT_VBYTES = 64 * AT_VROW;
constexpr int AT_BUF = AT_KBYTES + AT_VBYTES;
template <int OFF> __device__ __forceinline__ s16x4 tr_read(int vb) {
    s16x4 r; asm volatile("ds_read_b64_tr_b16 %0, %1 offset:%2" : "=&v"(r) : "v"(vb), "i"(OFF) : "memory"); return r;
}
template <int ND> __device__ __forceinline__ void pv_one(f32x16& od, int vb, const bf16x8 (&pf)[4]) {
#define VOFF(mt, s, half) (AT_KBYTES + (32 * (mt) + 16 * (s) + 8 * (half)) * AT_VROW + ND * 64)
    const s16x4 a0 = tr_read<VOFF(0, 0, 0)>(vb), b0 = tr_read<VOFF(0, 0, 1)>(vb), a1 = tr_read<VOFF(0, 1, 0)>(vb), b1 = tr_read<VOFF(0, 1, 1)>(vb);
    const s16x4 a2 = tr_read<VOFF(1, 0, 0)>(vb), b2 = tr_read<VOFF(1, 0, 1)>(vb), a3 = tr_read<VOFF(1, 1, 0)>(vb), b3 = tr_read<VOFF(1, 1, 1)>(vb);
#undef VOFF
    asm volatile("s_waitcnt lgkmcnt(0)" ::: "memory"); __builtin_amdgcn_sched_barrier(0);
#define PK(L, H) (bf16x8){L[0], L[1], L[2], L[3], H[0], H[1], H[2], H[3]}
    od = __builtin_amdgcn_mfma_f32_32x32x16_bf16(PK(a0, b0), pf[0], od, 0, 0, 0);
    od = __builtin_amdgcn_mfma_f32_32x32x16_bf16(PK(a1, b1), pf[1], od, 0, 0, 0);
    od = __builtin_amdgcn_mfma_f32_32x32x16_bf16(PK(a2, b2), pf[2], od, 0, 0, 0);
    od = __builtin_amdgcn_mfma_f32_32x32x16_bf16(PK(a3, b3), pf[3], od, 0, 0, 0);
#undef PK
}
__device__ __forceinline__ void attn_unit(Frame& F, int b, int h, int c, int qb) {
    const int tid = F.tid, lane = F.lane, wave = F.wave, r32 = lane & 31, hi = lane >> 5;
    LAS unsigned char* lds = F.lds;
    const bf16_t* QN = (const bf16_t*)(F.ws + WS_QN); const bf16_t* KN = (const bf16_t*)(F.ws + WS_KN); const bf16_t* P = (const bf16_t*)(F.ws + WS_P);
    const float sl2 = exp2f(-2.f * (float)(h + 1)) * 1.4426950408889634f;
    const float M2 = ((const float*)(F.ws + WS_SCAL))[1];
    const int tq = qb * 256 + wave * 32 + r32;
    const int ctw = 4 * qb + (wave >> 1), ntiles = 4 * qb + 4;
    const float dmax = (2.f * M2 + 40.f) / sl2 + 63.f;
    int tile_lo = (int)ceilf(((float)(qb * 256 - 63) - dmax) * (1.f / 64.f)); tile_lo = tile_lo < 0 ? 0 : tile_lo;
    tile_lo = __builtin_amdgcn_readfirstlane(tile_lo);
    bf16x8 qf[4];
    { const bf16_t* qp = QN + (size_t)(b * S + tq) * 512 + h * 128 + c * 64 + hi * 8;
#pragma unroll
      for (int ks = 0; ks < 4; ++ks) qf[ks] = *(const bf16x8*)(qp + 16 * ks); }
    float koffs[16];
#pragma unroll
    for (int r = 0; r < 16; ++r) koffs[r] = sl2 * (float)((r & 3) + 8 * (r >> 2) + 4 * hi);
    f32x16 oacc[4];
#pragma unroll
    for (int nd = 0; nd < 4; ++nd)
#pragma unroll
        for (int r = 0; r < 16; ++r) oacc[nd][r] = 0.f;
    float lsum = 0.f;
    const int s_key = tid >> 3, s_kg = tid & 7;
    const bf16_t* kg_src = KN + (size_t)(b * S + s_key) * 512 + h * 128 + c * 64 + s_kg * 8;
    const bf16_t* vg_src = P + (size_t)(b * S + s_key) * LDP + C_VB + h * 128 + s_kg * 8;
    const int st_k = s_kg * AT_KPLANE + s_key * 16, st_v = AT_KBYTES + s_key * AT_VROW + s_kg * 16;
    const int rd_k = hi * AT_KPLANE + r32 * 16;
    const int rd_v = (hi * 4 + ((lane & 15) >> 2)) * AT_VROW + ((lane >> 4) & 1) * 32 + (lane & 3) * 8;
    v4u rk, rv0, rv1;
    auto gload = [&](int tile) { rk = *(const v4u*)(kg_src + (size_t)tile * 64 * 512); const bf16_t* vp = vg_src + (size_t)tile * 64 * LDP; rv0 = *(const v4u*)vp; rv1 = *(const v4u*)(vp + 64); };
    auto lstore = [&](int buf) { LAS unsigned char* bb = lds + buf * AT_BUF; *(LAS v4u*)(bb + st_k) = rk; *(LAS v4u*)(bb + st_v) = rv0; *(LAS v4u*)(bb + st_v + 128) = rv1; };
    __syncthreads();
    gload(tile_lo); lstore(tile_lo & 1); __syncthreads();
    for (int tile = tile_lo; tile < ntiles; ++tile) {
        gload(tile + 1 < ntiles ? tile + 1 : tile);
        if (tile <= ctw) {
            const LAS unsigned char* kb = lds + (tile & 1) * AT_BUF;
            f32x16 sacc[2];
            if (tile != ctw) {
                const float ct = sl2 * (float)(64 * tile - tq) - M2;
#pragma unroll
                for (int mt = 0; mt < 2; ++mt)
#pragma unroll
                    for (int r = 0; r < 16; ++r) sacc[mt][r] = koffs[r] + (ct + sl2 * 32.f * mt);
            } else {
                const float base = sl2 * (float)(64 * tile - tq);
#pragma unroll
                for (int mt = 0; mt < 2; ++mt)
#pragma unroll
                    for (int r = 0; r < 16; ++r) sacc[mt][r] = -fabsf(koffs[r] + (base + sl2 * 32.f * mt)) - M2;
            }
#pragma unroll
            for (int ks = 0; ks < 4; ++ks)
#pragma unroll
                for (int mt = 0; mt < 2; ++mt) { const bf16x8 kf = *(const LAS bf16x8*)(kb + rd_k + ks * 2 * AT_KPLANE + mt * 512);
                    sacc[mt] = __builtin_amdgcn_mfma_f32_32x32x16_bf16(kf, qf[ks], sacc[mt], 0, 0, 0); }
            bf16x8 pf[4];
#pragma unroll
            for (int mt = 0; mt < 2; ++mt) {
#pragma unroll
                for (int r = 0; r < 16; ++r) { const float p = __builtin_amdgcn_exp2f(sacc[mt][r]); lsum += p; sacc[mt][r] = p; }
#pragma unroll
                for (int s = 0; s < 2; ++s) { v4u w;
                    w.x = pg8::cvt_pk_bf16(sacc[mt][8 * s + 0], sacc[mt][8 * s + 1]); w.y = pg8::cvt_pk_bf16(sacc[mt][8 * s + 2], sacc[mt][8 * s + 3]);
                    w.z = pg8::cvt_pk_bf16(sacc[mt][8 * s + 4], sacc[mt][8 * s + 5]); w.w = pg8::cvt_pk_bf16(sacc[mt][8 * s + 6], sacc[mt][8 * s + 7]);
                    pf[mt * 2 + s] = __builtin_bit_cast(bf16x8, w); }
            }
            const int vb = (int)(uintptr_t)kb + rd_v;
            pv_one<0>(oacc[0], vb, pf); pv_one<1>(oacc[1], vb, pf); pv_one<2>(oacc[2], vb, pf); pv_one<3>(oacc[3], vb, pf);
        }
        lstore((tile + 1) & 1);
        __syncthreads();
    }
    lsum += __shfl_xor(lsum, 32);
    const float inv = 1.f / lsum;
    bf16_t* ob = (bf16_t*)(F.ws + WS_OB) + (size_t)c * T * 512 + (size_t)(b * S + tq) * 512 + h * 128 + 4 * hi;
#pragma unroll
    for (int nd = 0; nd < 4; ++nd)
#pragma unroll
        for (int g = 0; g < 4; ++g) { uint2 w; w.x = pk2(oacc[nd][4 * g] * inv, oacc[nd][4 * g + 1] * inv); w.y = pk2(oacc[nd][4 * g + 2] * inv, oacc[nd][4 * g + 3] * inv);
            *(uint2*)(ob + 32 * nd + 8 * g) = w; }
}
__device__ __forceinline__ void post_norm_phase(Frame& F, const Args& A) {
    const float* oa = (const float*)(F.ws + WS_OA); const bf16_t* ob = (const bf16_t*)(F.ws + WS_OB); const bf16_t* P = (const bf16_t*)(F.ws + WS_P);
    bf16_t* oan = (bf16_t*)(F.ws + WS_OAN); bf16_t* obn = (bf16_t*)(F.ws + WS_OBN);
    const float* gg = A.in[9]; const float* sg = A.in[17];
    const float lam = ((const float*)(F.ws + WS_SCAL))[0];
    const int gw = F.vcu * NWAVES + F.wave, NGW = F.G * NWAVES, lane = F.lane;
    const int gc = (lane & 15) * 8;
    const f32x4 g0 = *(const f32x4*)(gg + gc), g1 = *(const f32x4*)(gg + gc + 4), s0 = *(const f32x4*)(sg + gc), s1 = *(const f32x4*)(sg + gc + 4);
    for (int t = gw; t < T; t += NGW) {
        { const f32x4 a0 = *(const f32x4*)(oa + (size_t)t * 512 + lane * 8), a1 = *(const f32x4*)(oa + (size_t)t * 512 + lane * 8 + 4);
          float ss = (a0[0] * a0[0] + a0[1] * a0[1]) + (a0[2] * a0[2] + a0[3] * a0[3]) + (a1[0] * a1[0] + a1[1] * a1[1]) + (a1[2] * a1[2] + a1[3] * a1[3]);
          ss += __shfl_xor(ss, 1); ss += __shfl_xor(ss, 2); ss += __shfl_xor(ss, 4); ss += __shfl_xor(ss, 8);
          const float r = rsqrtf(ss * (1.f / 128.f) + EPS);
          const v4u zw = *(const v4u*)(P + (size_t)t * LDP + C_ZA + lane * 8);
          const float z[8] = {pg8::bflo(zw.x), pg8::bfhi(zw.x), pg8::bflo(zw.y), pg8::bfhi(zw.y), pg8::bflo(zw.z), pg8::bfhi(zw.z), pg8::bflo(zw.w), pg8::bfhi(zw.w)};
          float o[8];
#pragma unroll
          for (int i = 0; i < 4; ++i) { o[i] = a0[i] * r * g0[i] * siluf(z[i]); o[4 + i] = a1[i] * r * g1[i] * siluf(z[4 + i]); }
          v4u w; w.x = pk2(o[0], o[1]); w.y = pk2(o[2], o[3]); w.z = pk2(o[4], o[5]); w.w = pk2(o[6], o[7]);
          *(v4u*)(oan + (size_t)t * 512 + lane * 8) = w; }
        { const v4u w1 = *(const v4u*)(ob + (size_t)t * 512 + lane * 8), w2 = *(const v4u*)(ob + (size_t)T * 512 + (size_t)t * 512 + lane * 8);
          float d[8] = {pg8::bflo(w1.x) - lam * pg8::bflo(w2.x), pg8::bfhi(w1.x) - lam * pg8::bfhi(w2.x), pg8::bflo(w1.y) - lam * pg8::bflo(w2.y), pg8::bfhi(w1.y) - lam * pg8::bfhi(w2.y),
                        pg8::bflo(w1.z) - lam * pg8::bflo(w2.z), pg8::bfhi(w1.z) - lam * pg8::bfhi(w2.z), pg8::bflo(w1.w) - lam * pg8::bflo(w2.w), pg8::bfhi(w1.w) - lam * pg8::bfhi(w2.w)};
          float ss = 0.f;
#pragma unroll
          for (int i = 0; i < 8; ++i) ss += d[i] * d[i];
          ss += __shfl_xor(ss, 1); ss += __shfl_xor(ss, 2); ss += __shfl_xor(ss, 4); ss += __shfl_xor(ss, 8);
          const float r = rsqrtf(ss * (1.f / 128.f) + EPS) * (1.f - LAM_INIT);
          v4u w; w.x = pk2(d[0] * r * s0[0], d[1] * r * s0[1]); w.y = pk2(d[2] * r * s0[2], d[3] * r * s0[3]); w.z = pk2(d[4] * r * s1[0], d[5] * r * s1[1]); w.w = pk2(d[6] * r * s1[2], d[7] * r * s1[3]);
          *(v4u*)(obn + (size_t)t * 512 + lane * 8) = w; }
    }
}
constexpr int GD_KA = 0, GD_QA = 17408, GD_VN = 34816, GD_KB = 55296, GD_LM = 75776, GD_T1 = 93184, GD_T2 = 102400, GD_SC = 111616;
constexpr int GD_AQ = 114688;
constexpr int GD_SA = 272, GD_SB = 320, GD_SL = 272, GD_ST = 144;
constexpr size_t GDN_WF = 0, GDN_QF = 16384, GDN_AF = 32768, GDN_KF = 40960, GDN_UF = 57344, GDN_EG = 90112, GDN_ITEM = 90368;
__device__ __forceinline__ int perm16_h(int n) { return (n >> 2) & 1; }
__device__ __forceinline__ int perm16_j(int n) { return (n & 3) + 4 * (n >> 3); }

#ifndef PROBE_SC1
#define PROBE_SC1 0
#endif
#ifndef PROBE_PUB
#define PROBE_PUB 0
#endif
#ifndef PROBE_INPH
#define PROBE_INPH 1
#endif
constexpr int CW_GFLAG = 8192;
constexpr int CW_PQ = 96;
__device__ __forceinline__ void gst16(unsigned char* p, v4u v, bool wt) {
    if (wt) asm volatile("global_store_dwordx4 %0, %1, off sc0 sc1" :: "v"(p), "v"(v) : "memory"); else *(v4u*)p = v; }
__device__ __forceinline__ void gst4(float* p, float v, bool wt) {
    if (wt) asm volatile("global_store_dword %0, %1, off sc0 sc1" :: "v"(p), "v"(v) : "memory"); else *p = v; }
__device__ __forceinline__ void gdn_prep_item(Frame& F, const Args& A, int item, bool publish = false) {
    const int tid = F.tid, lane = F.lane, wave = F.wave, r32 = lane & 31, hi = lane >> 5;
    LAS unsigned char* lds = F.lds;
    const int b = item >> 9, h = (item >> 7) & 3, n = item & 127;
    const int t0 = b * S + n * 64;
    const bf16_t* P = (const bf16_t*)(F.ws + WS_P); const float* bd = (const float*)(F.ws + WS_BD);
    unsigned char* gi = F.ws + WS_GDN + (size_t)item * GDN_ITEM;
    LAS float* sc_g = (LAS float*)(lds + GD_SC);
    LAS float* sc_b = sc_g + 64;
    LAS float* sc_e = sc_g + 128;
    LAS float* sc_l = sc_g + 192;
#ifndef NO_S1
    if (tid < 128) *((LAS float*)(lds + GD_SC + 1024) + tid) = (tid == 63) ? 1.f : 0.f;
    {
        const float* cw = A.in[6];
        float w[3][4][2];
#pragma unroll
        for (int p = 0; p < 3; ++p)
#pragma unroll
            for (int j = 0; j < 4; ++j) { const float2 t = *(const float2*)(cw + j * 1536 + p * 512 + h * 128 + 2 * lane); w[p][j][0] = t.x; w[p][j][1] = t.y; }
        const int rl0 = n * 64 + wave * 8;
#pragma unroll
        for (int p = 0; p < 3; ++p) {
            float x[11][2];
#pragma unroll
            for (int i = 0; i < 11; ++i) { const int tl = rl0 - 3 + i; unsigned u = 0u;
                if (tl >= 0) u = *(const unsigned*)(P + (size_t)(b * S + tl) * LDP + p * 512 + h * 128 + 2 * lane);
                x[i][0] = pg8::bflo(u); x[i][1] = pg8::bfhi(u); }
#pragma unroll
            for (int r = 0; r < 8; ++r) {
                float a0 = 0.f, a1 = 0.f;
#pragma unroll
                for (int j = 0; j < 4; ++j) { a0 += x[r + j][0] * w[p][j][0]; a1 += x[r + j][1] * w[p][j][1]; }
                a0 = siluf(a0); a1 = siluf(a1);
                const int row = wave * 8 + r;
                if (p < 2) { const float ss = wave_sum(a0 * a0 + a1 * a1); const float rs = rsqrtf(ss + EPS) * (p == 0 ? 0.08838834764831845f : 1.f); a0 *= rs; a1 *= rs; }
                const unsigned pk = pk2(a0, a1);
                if (p == 0) *(LAS unsigned*)(lds + GD_QA + row * GD_SA + lane * 4) = pk;
                else if (p == 1) { *(LAS unsigned*)(lds + GD_KA + row * GD_SA + lane * 4) = pk; *(LAS unsigned*)(lds + GD_KB + row * GD_SB + lane * 4) = pk; }
                else *(LAS unsigned*)(lds + GD_VN + row * GD_SB + lane * 4) = pk;
            }
        }
        if (wave == 0) {
            const float bl = bd[(size_t)(t0 + lane) * 8 + h], dl = bd[(size_t)(t0 + lane) * 8 + 4 + h];
            const float beta = 1.f / (1.f + __expf(-bl));
            float g = -expf(A.in[7][h]) * softplusf(dl + A.in[8][h]);
#pragma unroll
            for (int o = 1; o < 64; o <<= 1) { const float up = __shfl_up(g, o); if (lane >= o) g += up; }
            const float glast = __shfl(g, 63);
            sc_g[lane] = g; sc_b[lane] = beta; sc_e[lane] = __expf(g); sc_l[lane] = __expf(glast - g);
            if (lane == 0) gst4((float*)(gi + GDN_EG), __expf(glast), publish);
        }
    }
#endif
    __syncthreads();
#ifndef NO_S2
    {
        const int which = wave >> 2, ti = (wave >> 1) & 1, tj = wave & 1;
        f32x16 acc;
#pragma unroll
        for (int r = 0; r < 16; ++r) acc[r] = 0.f;
        if (ti >= tj) {
            const LAS unsigned char* ap = lds + (which ? GD_QA : GD_KA) + (32 * ti + r32) * GD_SA + hi * 16;
            const LAS unsigned char* bp = lds + GD_KA + (32 * tj + r32) * GD_SA + hi * 16;
#pragma unroll
            for (int ks = 0; ks < 8; ++ks) acc = __builtin_amdgcn_mfma_f32_32x32x16_bf16(*(const LAS bf16x8*)(ap + ks * 32), *(const LAS bf16x8*)(bp + ks * 32), acc, 0, 0, 0);
        }
        const int j = 32 * tj + r32; const float Gj = sc_g[j];
        const int ibase = 32 * ti + 4 * hi, dij = ibase - j;
        const LAS float* gp = sc_g + ibase; const LAS float* bp2 = sc_b + ibase;
        if (which == 0) {
            LAS float* lm = (LAS float*)(lds + GD_LM + ibase * GD_SL + j * 4);
#pragma unroll
            for (int r = 0; r < 16; ++r) { const int off = (r & 3) + 8 * (r >> 2);
                const float v = (off + dij > 0) ? bp2[off] * acc[r] * __expf(fminf(gp[off] - Gj, 0.f)) : 0.f;
                lm[off * (GD_SL / 4)] = v; }
        } else {
            LAS bf16_t* aq = (LAS bf16_t*)(lds + GD_AQ) + ibase * 72 + j;
#pragma unroll
            for (int r = 0; r < 16; ++r) { const int off = (r & 3) + 8 * (r >> 2);
                const float v = (off + dij >= 0) ? acc[r] * __expf(fminf(gp[off] - Gj, 0.f)) : 0.f;
                aq[off * 72] = (bf16_t)f2bf(v); }
        }
    }
#endif
    __syncthreads();
#ifndef NO_S3
    if (wave == 0) {
        int ln = lane; asm volatile("" : "+v"(ln));
        LAS unsigned char* lmb = lds + GD_LM; asm volatile("" : "+v"(lmb));
        const LAS float* zz = (const LAS float*)(lds + GD_SC + 1024) + ln;
        float t[64];
#pragma unroll
        for (int i = 0; i < 64; ++i) {
            float s = zz[63 - i];
            const LAS float* Li = (const LAS float*)(lmb + i * GD_SL);
            float s1 = 0.f, s2 = 0.f, s3 = 0.f;
#pragma unroll
            for (int j4 = 0; j4 < (i + 3) / 4; ++j4) { const f32x4 l4 = *(const LAS f32x4*)(Li + 4 * j4);
                if (4 * j4 + 0 < i) s -= l4[0] * t[4 * j4 + 0];
                if (4 * j4 + 1 < i) s1 -= l4[1] * t[4 * j4 + 1];
                if (4 * j4 + 2 < i) s2 -= l4[2] * t[4 * j4 + 2];
                if (4 * j4 + 3 < i) s3 -= l4[3] * t[4 * j4 + 3]; }
            s = (s + s1) + (s2 + s3);
            t[i] = s;
            __builtin_amdgcn_sched_barrier(0);
        }
        const float bc = sc_b[lane], bec = bc * sc_e[lane];
#pragma unroll
        for (int i = 0; i < 64; ++i) { *(LAS bf16_t*)(lds + GD_T1 + i * GD_ST + lane * 2) = (bf16_t)f2bf(t[i] * bc); *(LAS bf16_t*)(lds + GD_T2 + i * GD_ST + lane * 2) = (bf16_t)f2bf(t[i] * bec); }
    } else {
        for (int cidx = tid - 64; cidx < 2560; cidx += 448) {
            if (cidx >= 2048) {
                const int cc = cidx - 2048, mt = cc >> 8, ks = (cc >> 6) & 3, lp = cc & 63, hp = lp >> 5, rr = lp & 31;
                const LAS unsigned char* ap = lds + GD_AQ + (32 * mt + rr) * 144 + (16 * ks + 4 * hp) * 2;
                const u32x2 lo = *(const LAS u32x2*)ap, hi2 = *(const LAS u32x2*)(ap + 16);
                gst16(gi + GDN_AF + (size_t)cc * 16, (v4u){lo.x, lo.y, hi2.x, hi2.y}, publish);
                continue; }
            const bool isK = cidx >= 1024; const int cc = cidx & 1023; const int lp = cc & 63, hp = lp >> 5, rr = lp & 31;
            unsigned wds[4];
            if (!isK) { const int mt = cc >> 9, ks = (cc >> 6) & 7; const int i = 32 * mt + rr; const float e = sc_e[i];
#pragma unroll
                for (int q = 0; q < 4; ++q) { const int j0 = 2 * q, j1 = 2 * q + 1;
                    const int d0 = 16 * ks + 8 * (j0 >> 2) + 4 * hp + (j0 & 3), d1 = 16 * ks + 8 * (j1 >> 2) + 4 * hp + (j1 & 3);
                    wds[q] = pk2(bf2f(*(const LAS bf16_t*)(lds + GD_QA + i * GD_SA + d0 * 2)) * e, bf2f(*(const LAS bf16_t*)(lds + GD_QA + i * GD_SA + d1 * 2)) * e); }
                gst16(gi + GDN_QF + (size_t)cc * 16, (v4u){wds[0], wds[1], wds[2], wds[3]}, publish);
            } else { const int dt = cc >> 8, ks = (cc >> 6) & 3; const int dk = 32 * dt + rr;
#pragma unroll
                for (int q = 0; q < 4; ++q) { const int j0 = 2 * q, j1 = 2 * q + 1;
                    const int k0 = 16 * ks + 8 * (j0 >> 2) + 4 * hp + (j0 & 3), k1 = 16 * ks + 8 * (j1 >> 2) + 4 * hp + (j1 & 3);
                    wds[q] = pk2(bf2f(*(const LAS bf16_t*)(lds + GD_KA + k0 * GD_SA + dk * 2)) * sc_l[k0], bf2f(*(const LAS bf16_t*)(lds + GD_KA + k1 * GD_SA + dk * 2)) * sc_l[k1]); }
                gst16(gi + GDN_KF + (size_t)cc * 16, (v4u){wds[0], wds[1], wds[2], wds[3]}, publish);
            }
        }
    }
#endif
    __syncthreads();
#ifndef NO_S4
    {
        const int mt = wave >> 2, nt = wave & 3;
        const int trb = (hi * 8 + ((lane & 15) >> 2)) * GD_SB + (32 * nt + ((lane >> 4) & 1) * 16 + (lane & 3) * 4) * 2;
#pragma unroll
        for (int which = 0; which < 2; ++which) {
            f32x16 acc;
#pragma unroll
            for (int r = 0; r < 16; ++r) acc[r] = 0.f;
            const LAS unsigned char* tp = lds + (which ? GD_T2 : GD_T1) + (32 * mt + r32) * GD_ST + hi * 16;
            const int vb = (int)(uintptr_t)(lds + (which ? GD_KB : GD_VN)) + trb;
            s16x4 lo[4], hh[4];
            lo[0] = tr_read<0 * 16 * GD_SB>(vb); hh[0] = tr_read<0 * 16 * GD_SB + 4 * GD_SB>(vb); lo[1] = tr_read<1 * 16 * GD_SB>(vb); hh[1] = tr_read<1 * 16 * GD_SB + 4 * GD_SB>(vb);
            lo[2] = tr_read<2 * 16 * GD_SB>(vb); hh[2] = tr_read<2 * 16 * GD_SB + 4 * GD_SB>(vb); lo[3] = tr_read<3 * 16 * GD_SB>(vb); hh[3] = tr_read<3 * 16 * GD_SB + 4 * GD_SB>(vb);
            asm volatile("s_waitcnt lgkmcnt(0)" ::: "memory"); __builtin_amdgcn_sched_barrier(0);
#pragma unroll
            for (int ks = 0; ks < 4; ++ks) { const bf16x8 bfr = (bf16x8){lo[ks][0], lo[ks][1], lo[ks][2], lo[ks][3], hh[ks][0], hh[ks][1], hh[ks][2], hh[ks][3]};
                acc = __builtin_amdgcn_mfma_f32_32x32x16_bf16(*(const LAS bf16x8*)(tp + ks * 32), bfr, acc, 0, 0, 0); }
            if (which == 0) {
                float* uf = (float*)(gi + GDN_UF) + (size_t)nt * 2048 + (32 * mt + 4 * hi) * 32 + r32;
#pragma unroll
                for (int r = 0; r < 16; ++r) gst4(uf + ((r & 3) + 8 * (r >> 2)) * 32, acc[r], publish);
            } else {
                LAS bf16_t* wq = (LAS bf16_t*)(lds + GD_QA + (32 * mt + 4 * hi) * GD_SA) + 32 * nt + r32;
#pragma unroll
                for (int r = 0; r < 16; ++r) wq[((r & 3) + 8 * (r >> 2)) * (GD_SA / 2)] = (bf16_t)f2bf(acc[r]);
            }
        }
    }
    __syncthreads();
    for (int cc = tid; cc < 1024; cc += NWAVES * 64) { const int mt = cc >> 9, ks = (cc >> 6) & 7, lp = cc & 63, hp = lp >> 5, rr = lp & 31;
        const LAS unsigned char* wq = lds + GD_QA + (32 * mt + rr) * GD_SA + (16 * ks + 4 * hp) * 2;
        const u32x2 lo = *(const LAS u32x2*)wq, hi2 = *(const LAS u32x2*)(wq + 16);
        gst16(gi + GDN_WF + (size_t)cc * 16, (v4u){lo.x, lo.y, hi2.x, hi2.y}, publish); }
#endif
    asm volatile("s_waitcnt vmcnt(0)" ::: "memory");
    __syncthreads();
    if (publish && tid == 0)
        __hip_atomic_store((unsigned*)(F.ws + WS_CTL) + CW_GFLAG + item, 1u, __ATOMIC_RELAXED, __HIP_MEMORY_SCOPE_AGENT);
}
__device__ __forceinline__ void gdn_prep_phase(Frame& F, const Args& A) {
    if (F.G >= 64 && PROBE_INPH) return;
    for (int item = blockIdx.x; item < 1024; item += F.G) gdn_prep_item(F, A, item, PROBE_PUB);
}

__device__ __forceinline__ bf16x8 pack8(const f32x16& a, int s) {
    v4u w; w.x = pg8::cvt_pk_bf16(a[8 * s + 0], a[8 * s + 1]); w.y = pg8::cvt_pk_bf16(a[8 * s + 2], a[8 * s + 3]); w.z = pg8::cvt_pk_bf16(a[8 * s + 4], a[8 * s + 5]); w.w = pg8::cvt_pk_bf16(a[8 * s + 6], a[8 * s + 7]);
    return __builtin_bit_cast(bf16x8, w);
}
constexpr int SC_STAGE = 65536;
template <bool WAITF>
__device__ __forceinline__ void gdn_scan_block(Frame& F, int task, int mode = 0) {
    const int lane = F.lane, wave = F.wave, r32 = lane & 31, hi = lane >> 5;
    const int bh = task >> 2, sl = task & 3, b = bh >> 2, h = bh & 3;
    LAS unsigned char* lds = F.lds;
    float* oa = (float*)(F.ws + WS_OA);
    const unsigned char* g0 = F.ws + WS_GDN + (size_t)(bh * 128) * GDN_ITEM;
    auto wait_group = [&](int n) {
        if (!WAITF) return;
        const unsigned* fl = (const unsigned*)(F.ws + WS_CTL) + CW_GFLAG + bh * 128 + n;
        for (int sp = 0; sp < 400000; ++sp) { unsigned ok = 1u;
#pragma unroll
            for (int i = 0; i < 8; ++i) ok &= __hip_atomic_load(fl + i, __ATOMIC_RELAXED, __HIP_MEMORY_SCOPE_AGENT);
            if (ok) break; __builtin_amdgcn_s_sleep(8); }
        asm volatile("" ::: "memory");
    };
    auto issue = [&](int n) {
        const unsigned char* gi = g0 + (size_t)n * GDN_ITEM; LAS unsigned char* st = lds + (n & 1) * SC_STAGE;
        for (int p = wave - 1; p < 64; p += 7) {
            const unsigned char* src = (p < 56) ? gi + p * 1024 : gi + GDN_UF + (size_t)sl * 8192 + (p - 56) * 1024;
            __builtin_amdgcn_global_load_lds((const unsigned*)(src + lane * 16), (LAS unsigned*)(st + p * 1024), 16, 0, (WAITF || PROBE_SC1) ? 17 : 0);
        }
    };
    f32x16 st4[4];
#pragma unroll
    for (int dt = 0; dt < 4; ++dt)
#pragma unroll
        for (int r = 0; r < 16; ++r) st4[dt][r] = 0.f;
    __syncthreads();
    wait_group(0);
    if (wave != 0) issue(0);
    __syncthreads();
    for (int n = 0; n < 128; ++n) {
        if (((n + 1) & 7) == 0 && n + 1 < 128) wait_group(n + 1);
        if (wave != 0) { if (n + 1 < 128 && !(mode & 1)) issue(n + 1); }
        else if (!(mode & 2)) {
            const LAS unsigned char* sg = lds + (n & 1) * SC_STAGE;
            const LAS bf16x8* wf = (const LAS bf16x8*)(sg + GDN_WF) + lane; const LAS bf16x8* qf = (const LAS bf16x8*)(sg + GDN_QF) + lane;
            const LAS bf16x8* af = (const LAS bf16x8*)(sg + GDN_AF) + lane; const LAS bf16x8* kf = (const LAS bf16x8*)(sg + GDN_KF) + lane;
            const LAS float* ufl = (const LAS float*)(sg + 57344) + 4 * hi * 32 + r32;
            const float egl = WAITF ? __uint_as_float(__hip_atomic_load((const unsigned*)(g0 + (size_t)n * GDN_ITEM + GDN_EG), __ATOMIC_RELAXED, __HIP_MEMORY_SCOPE_AGENT))
                                    : *(const float*)(g0 + (size_t)n * GDN_ITEM + GDN_EG);
            float* oap = oa + (size_t)(b * S + n * 64 + 4 * hi) * 512 + h * 128 + sl * 32 + r32;
            bf16x8 sb[8];
#pragma unroll
            for (int dt = 0; dt < 4; ++dt) { sb[2 * dt] = pack8(st4[dt], 0); sb[2 * dt + 1] = pack8(st4[dt], 1); }
            f32x16 vn[2], oc[2];
#pragma unroll
            for (int mt = 0; mt < 2; ++mt) {
                f32x16 ws_;
#pragma unroll
                for (int r = 0; r < 16; ++r) { ws_[r] = 0.f; oc[mt][r] = 0.f; }
#pragma unroll
                for (int ks = 0; ks < 8; ++ks) { ws_ = __builtin_amdgcn_mfma_f32_32x32x16_bf16(wf[(mt * 8 + ks) * 64], sb[ks], ws_, 0, 0, 0);
                                                 oc[mt] = __builtin_amdgcn_mfma_f32_32x32x16_bf16(qf[(mt * 8 + ks) * 64], sb[ks], oc[mt], 0, 0, 0); }
#pragma unroll
                for (int r = 0; r < 16; ++r) vn[mt][r] = ufl[(32 * mt + (r & 3) + 8 * (r >> 2)) * 32] - ws_[r];
            }
            bf16x8 vb[4];
#pragma unroll
            for (int mt = 0; mt < 2; ++mt) { vb[2 * mt] = pack8(vn[mt], 0); vb[2 * mt + 1] = pack8(vn[mt], 1); }
#pragma unroll
            for (int mt = 0; mt < 2; ++mt) {
#pragma unroll
                for (int ks = 0; ks < 4; ++ks) oc[mt] = __builtin_amdgcn_mfma_f32_32x32x16_bf16(af[(mt * 4 + ks) * 64], vb[ks], oc[mt], 0, 0, 0);
#pragma unroll
                for (int r = 0; r < 16; ++r) oap[(size_t)(32 * mt + (r & 3) + 8 * (r >> 2)) * 512] = oc[mt][r];
            }
#pragma unroll
            for (int dt = 0; dt < 4; ++dt) {
#pragma unroll
                for (int r = 0; r < 16; ++r) st4[dt][r] *= egl;
#pragma unroll
                for (int ks = 0; ks < 4; ++ks) st4[dt] = __builtin_amdgcn_mfma_f32_32x32x16_bf16(kf[(dt * 4 + ks) * 64], vb[ks], st4[dt], 0, 0, 0);
            }
        }
        __syncthreads();
    }
}
constexpr int CW_QUEUE = 64;
__device__ __forceinline__ void mixer_phase(Frame& F, const Args& A, int rep) {
    const bool inphase = F.G >= 64 && PROBE_INPH;
    volatile LAS int* slot = (volatile LAS int*)(F.lds + CTRL_OFF + 64);
    if (blockIdx.x < 32) {
#ifdef PROBE_SC
        if (inphase) gdn_scan_block<true>(F, (int)blockIdx.x, rep ? PROBE_SC : 0); else gdn_scan_block<false>(F, (int)blockIdx.x, rep ? PROBE_SC : 0);
#else
        if (inphase && rep == 0) gdn_scan_block<true>(F, (int)blockIdx.x); else gdn_scan_block<false>(F, (int)blockIdx.x);
#endif
    } else if (inphase && rep == 0) {
        unsigned* pq = (unsigned*)(F.ws + WS_CTL) + CW_PQ;
        for (;;) {
            __syncthreads();
            if (F.tid == 0) slot[0] = (int)__hip_atomic_fetch_add(pq, 1u, __ATOMIC_RELAXED, __HIP_MEMORY_SCOPE_AGENT);
            __syncthreads();
            const int i = slot[0];
            if (i >= 1024) break;
            gdn_prep_item(F, A, (i & 7) * 128 + (i >> 3), true);
        }
    }
    unsigned* qctr = (unsigned*)(F.ws + WS_CTL) + CW_QUEUE + 64 * rep;
    for (;;) {
        __syncthreads();
        if (F.tid == 0) slot[0] = (int)__hip_atomic_fetch_add(qctr, 1u, __ATOMIC_RELAXED, __HIP_MEMORY_SCOPE_AGENT);
        __syncthreads();
        const int i = slot[0];
        if (i >= 512) break;
        const int qb = 31 - (i >> 4), x = i & 15;
        attn_unit(F, x >> 3, (x >> 1) & 3, x & 1, qb);
    }
    __syncthreads();
    if (blockIdx.x >= 32) late_weight_copies(F, A, ((int)blockIdx.x - 32) * NWAVES + F.wave, (F.G - 32) * NWAVES);
    else if (F.G <= 32) late_weight_copies(F, A, (int)blockIdx.x * NWAVES + F.wave, F.G * NWAVES);
}
__global__ void __launch_bounds__(NWAVES * 64, 2) mega(Args args) {
    extern __shared__ __attribute__((aligned(16))) unsigned char lds_raw[];
    Frame F;
    F.lds = (LAS unsigned char*)lds_raw;
    F.MISC = (volatile LAS unsigned*)(F.lds + MISC_OFF);
    F.tid = threadIdx.x; F.lane = F.tid & 63; F.wave = __builtin_amdgcn_readfirstlane(F.tid >> 6);
    F.G = gridDim.x; { const int bx = blockIdx.x; F.vcu = (F.G % 8 == 0) ? (bx % 8) * (F.G / 8) + bx / 8 : bx; }
    F.out = args.out; F.ws = args.ws;
    for (int u = F.tid; u < (LDS_BYTES - CTRL_OFF) / 4; u += NWAVES * 64) ((LAS unsigned*)(F.lds + CTRL_OFF))[u] = 0u;
    __syncthreads();
    const int lo = args.ph_lo, hi = args.ph_hi;
    XcdBarrier bar; bar.bar = (unsigned*)(F.ws + WS_CTL) + CW_BAR; bar.x = 0; bar.st = nullptr;
    if (hi - lo > 1) bar = xcd_barrier_post((unsigned*)(F.ws + WS_CTL) + CW_BAR, F.MISC + 8);
#ifndef PHASE_MASK
#define PHASE_MASK 0xffff
#endif
#ifndef DUP_MASK
#define DUP_MASK 0
#endif
#define IN(k) (((PHASE_MASK >> (k)) & 1) && lo <= (k) && (k) < hi)
    if (IN(0)) { p0_phase(F, args); }
#if (DUP_MASK >> 0) & 1
    if (IN(0)) xcd_barrier(bar);
    if (IN(0)) { p0_phase(F, args); }
#endif
    if (IN(0) && IN(1)) xcd_barrier(bar);
#ifdef PROBE_ATOM
    {
        unsigned* w = (unsigned*)(F.ws + WS_CTL) + 65536 + 64 * (int)blockIdx.x;
        if (F.tid == 0) { unsigned v = 0;
            for (int i = 0; i < 200; ++i) { if (PROBE_ATOM == 1) v += xb_add(w + (v & 1u) * 0, 1u); else v += xb_ld(w + (v & 1u) * 0); asm volatile("" : "+v"(v)); }
            if (v == 0xdeadbeefu) w[1] = v; }
        __syncthreads();
    }
#endif
#ifdef PROBE_BAR
    for (int pb = 0; pb < PROBE_BARN; ++pb) xcd_barrier<PROBE_BAR>(bar);
#endif
    if (IN(1)) { norm_mod_phase<true, true>(F, args, args.in[0], args.in[4], 0, 1024, (bf16_t*)(F.ws + WS_H)); }
#if (DUP_MASK >> 1) & 1
    if (IN(1)) xcd_barrier(bar);
    if (IN(1)) { norm_mod_phase<true, true>(F, args, args.in[0], args.in[4], 0, 1024, (bf16_t*)(F.ws + WS_H)); }
#endif
    if (IN(1) && IN(2)) xcd_barrier(bar);
    if (IN(2)) {
        pg8::Gemm g{(const bf16_t*)(F.ws + WS_H), (const bf16_t*)(F.ws + WS_WIN), T, LDP, D}; pg8::StaticOrder So; So.init(T, LDP, F.G, (int)blockIdx.x);
        pg8::EpiStoreBf16 E{(bf16_t*)(F.ws + WS_P), LDP, 0};
        pg8::gemm_phase<pg8::EpiStoreBf16, pg8::StaticOrder, true, true>(F.lds, g, So, E);
    }
#if (DUP_MASK >> 2) & 1
    if (IN(2)) xcd_barrier(bar);
    if (IN(2)) {
        pg8::Gemm g{(const bf16_t*)(F.ws + WS_H), (const bf16_t*)(F.ws + WS_WIN), T, LDP, D}; pg8::StaticOrder So; So.init(T, LDP, F.G, (int)blockIdx.x);
        pg8::EpiStoreBf16 E{(bf16_t*)(F.ws + WS_P), LDP, 0};
        pg8::gemm_phase<pg8::EpiStoreBf16, pg8::StaticOrder, true, true>(F.lds, g, So, E);
    }
#endif
    if (IN(2) && IN(3)) xcd_barrier(bar);
    if (IN(3)) { attn_prep_phase(F, args); gdn_prep_phase(F, args); }
#if (DUP_MASK >> 3) & 1
    if (IN(3)) xcd_barrier(bar);
    if (IN(3)) { attn_prep_phase(F, args); gdn_prep_phase(F, args); }
#endif
    if (IN(3) && IN(4)) xcd_barrier(bar);
    if (IN(4)) { mixer_phase(F, args, 0); }
#if (DUP_MASK >> 4) & 1
    if (IN(4)) xcd_barrier(bar);
    if (IN(4)) { mixer_phase(F, args, 1); }
#endif
    if (IN(4) && IN(5)) xcd_barrier(bar);
    if (IN(5)) { post_norm_phase(F, args); }
#if (DUP_MASK >> 5) & 1
    if (IN(5)) xcd_barrier(bar);
    if (IN(5)) { post_norm_phase(F, args); }
#endif
    if (IN(5) && IN(6)) xcd_barrier(bar);
    if (IN(6)) {
        { pg8::Gemm g{(const bf16_t*)(F.ws + WS_OAN), (const bf16_t*)(F.ws + WS_WOA), T, 1024, 512}; pg8::StaticOrder So; So.init(T, 1024, F.G, (int)blockIdx.x);
          pg8::EpiGate<false> E{(const bf16_t*)(F.ws + WS_P) + C_GA, nullptr, (bf16_t*)(F.ws + WS_TMPB), LDP, 0};
          pg8::gemm_phase<pg8::EpiGate<false>, pg8::StaticOrder, true, true>(F.lds, g, So, E); }
        { pg8::Gemm g{(const bf16_t*)(F.ws + WS_OBN), (const bf16_t*)(F.ws + WS_WOB), T, 1024, 512}; pg8::StaticOrder So; So.init(T, 1024, F.G, (int)blockIdx.x);
          pg8::EpiGate<true> E{(const bf16_t*)(F.ws + WS_P) + C_GB, (const bf16_t*)(F.ws + WS_TMPB), (bf16_t*)(F.ws + WS_MERGED), LDP, 0};
          pg8::gemm_phase<pg8::EpiGate<true>, pg8::StaticOrder, true, true>(F.lds, g, So, E); }
    }
#if (DUP_MASK >> 6) & 1
    if (IN(6)) xcd_barrier(bar);
    if (IN(6)) {
        { pg8::Gemm g{(const bf16_t*)(F.ws + WS_OAN), (const bf16_t*)(F.ws + WS_WOA), T, 1024, 512}; pg8::StaticOrder So; So.init(T, 1024, F.G, (int)blockIdx.x);
          pg8::EpiGate<false> E{(const bf16_t*)(F.ws + WS_P) + C_GA, nullptr, (bf16_t*)(F.ws + WS_TMPB), LDP, 0};
          pg8::gemm_phase<pg8::EpiGate<false>, pg8::StaticOrder, true, true>(F.lds, g, So, E); }
        { pg8::Gemm g{(const bf16_t*)(F.ws + WS_OBN), (const bf16_t*)(F.ws + WS_WOB), T, 1024, 512}; pg8::StaticOrder So; So.init(T, 1024, F.G, (int)blockIdx.x);
          pg8::EpiGate<true> E{(const bf16_t*)(F.ws + WS_P) + C_GB, (const bf16_t*)(F.ws + WS_TMPB), (bf16_t*)(F.ws + WS_MERGED), LDP, 0};
          pg8::gemm_phase<pg8::EpiGate<true>, pg8::StaticOrder, true, true>(F.lds, g, So, E); }
    }
#endif
    if (IN(6) && IN(7)) xcd_barrier(bar);
    if (IN(7)) {
        pg8::Gemm g{(const bf16_t*)(F.ws + WS_MERGED), (const bf16_t*)(F.ws + WS_WOUT), T, 1024, 1024}; pg8::StaticOrder So; So.init(T, 1024, F.G, (int)blockIdx.x);
        pg8::EpiResid E{args.in[0], (const float*)(F.ws + WS_MOD) + 2048, (float*)(F.ws + WS_X1)};
        pg8::gemm_phase<pg8::EpiResid, pg8::StaticOrder, true, true>(F.lds, g, So, E);
    }
#if (DUP_MASK >> 7) & 1
    if (IN(7)) xcd_barrier(bar);
    if (IN(7)) {
        pg8::Gemm g{(const bf16_t*)(F.ws + WS_MERGED), (const bf16_t*)(F.ws + WS_WOUT), T, 1024, 1024}; pg8::StaticOrder So; So.init(T, 1024, F.G, (int)blockIdx.x);
        pg8::EpiResid E{args.in[0], (const float*)(F.ws + WS_MOD) + 2048, (float*)(F.ws + WS_X1)};
        pg8::gemm_phase<pg8::EpiResid, pg8::StaticOrder, true, true>(F.lds, g, So, E);
    }
#endif
    if (IN(7) && IN(8)) xcd_barrier(bar);
    if (IN(8)) { norm_mod_phase<false, false>(F, args, (const float*)(F.ws + WS_X1), args.in[20], 3072, 4096, (bf16_t*)(F.ws + WS_H)); }
#if (DUP_MASK >> 8) & 1
    if (IN(8)) xcd_barrier(bar);
    if (IN(8)) { norm_mod_phase<false, false>(F, args, (const float*)(F.ws + WS_X1), args.in[20], 3072, 4096, (bf16_t*)(F.ws + WS_H)); }
#endif
    if (IN(8) && IN(9)) xcd_barrier(bar);
    if (IN(9)) {
        pg8::Gemm g{(const bf16_t*)(F.ws + WS_H), (const bf16_t*)(F.ws + WS_W9), T, 768, 1024}; pg8::StaticOrder So; So.init(T, 768, F.G, (int)blockIdx.x);
        pg8::EpiSharedRouter E{(bf16_t*)(F.ws + WS_SACT), (float*)(F.ws + WS_LOGITS)};
        pg8::gemm_phase<pg8::EpiSharedRouter, pg8::StaticOrder, true, true>(F.lds, g, So, E);
    }
#if (DUP_MASK >> 9) & 1
    if (IN(9)) xcd_barrier(bar);
    if (IN(9)) {
        pg8::Gemm g{(const bf16_t*)(F.ws + WS_H), (const bf16_t*)(F.ws + WS_W9), T, 768, 1024}; pg8::StaticOrder So; So.init(T, 768, F.G, (int)blockIdx.x);
        pg8::EpiSharedRouter E{(bf16_t*)(F.ws + WS_SACT), (float*)(F.ws + WS_LOGITS)};
        pg8::gemm_phase<pg8::EpiSharedRouter, pg8::StaticOrder, true, true>(F.lds, g, So, E);
    }
#endif
    if (IN(9) && IN(10)) xcd_barrier(bar);
    if (IN(10)) { route_phase(F, args); }
#if (DUP_MASK >> 10) & 1
    if (IN(10)) xcd_barrier(bar);
    if (IN(10)) { route_phase(F, args); }
#endif
    if (IN(10) && IN(11)) xcd_barrier(bar);
    if (IN(11)) { moe_phase(F, args); }
#if (DUP_MASK >> 11) & 1
    if (IN(11)) xcd_barrier(bar);
    if (IN(11)) { moe_phase(F, args, 1); }
#endif
    if (IN(11) && IN(12)) xcd_barrier(bar);
    if (IN(12)) {
        pg8::Gemm g{(const bf16_t*)(F.ws + WS_SACT), (const bf16_t*)(F.ws + WS_WSD), T, 1024, 256}; pg8::StaticOrder So; So.init(T, 1024, F.G, (int)blockIdx.x);
        pg8::EpiFinal E{(const float*)(F.ws + WS_X1), (const float*)(F.ws + WS_MOD) + 5120, (const bf16_t*)(F.ws + WS_Y), F.out};
        pg8::gemm_phase<pg8::EpiFinal, pg8::StaticOrder, true, true>(F.lds, g, So, E);
    }
#if (DUP_MASK >> 12) & 1
    if (IN(12)) xcd_barrier(bar);
    if (IN(12)) {
        pg8::Gemm g{(const bf16_t*)(F.ws + WS_SACT), (const bf16_t*)(F.ws + WS_WSD), T, 1024, 256}; pg8::StaticOrder So; So.init(T, 1024, F.G, (int)blockIdx.x);
        pg8::EpiFinal E{(const float*)(F.ws + WS_X1), (const float*)(F.ws + WS_MOD) + 5120, (const bf16_t*)(F.ws + WS_Y), F.out};
        pg8::gemm_phase<pg8::EpiFinal, pg8::StaticOrder, true, true>(F.lds, g, So, E);
    }
#endif
#undef IN
}
extern "C" void kernel_launch(void* const* d_in, const int* in_sizes, int n_in, void* d_out, int out_size, void* d_ws, size_t ws_size, hipStream_t stream) {
  static int grid = 0;
  if (grid == 0) {
    int dev = 0, cus = 0;
    if (n_in != 27 || out_size != T * D || ws_size < WS_END) { fprintf(stderr, "kernel_launch: unexpected problem (n_in %d, out %d, ws %zu < %zu)\n", n_in, out_size, ws_size, (size_t)WS_END); grid = -1; return; }
    if (hipGetDevice(&dev) != hipSuccess || hipDeviceGetAttribute(&cus, hipDeviceAttributeMultiprocessorCount, dev) != hipSuccess) { fprintf(stderr, "kernel_launch: device query failed\n"); grid = -1; return; }
    if (hipFuncSetAttribute((const void*)mega, hipFuncAttributeMaxDynamicSharedMemorySize, LDS_BYTES) != hipSuccess) { fprintf(stderr, "kernel_launch: hipFuncSetAttribute failed\n"); grid = -1; return; }
    int per_cu = 0;
    if (hipOccupancyMaxActiveBlocksPerMultiprocessor(&per_cu, (const void*)mega, NWAVES * 64, LDS_BYTES) != hipSuccess || per_cu < 1) fprintf(stderr, "kernel_launch: occupancy query says %d blocks per CU\n", per_cu);
    (void)hipGetLastError();
    grid = cus;
  }
  if (grid < 0) return;
  (void)hipMemsetAsync((unsigned char*)d_ws + WS_CTL, 0, CTL_ZERO_BYTES, stream);
  Args a{};
  for (int i = 0; i < 27; ++i) a.in[i] = (const float*)d_in[i];
  a.out = (float*)d_out; a.ws = (unsigned char*)d_ws;
#ifndef N_LAUNCH_PHASES
  a.ph_lo = 0; a.ph_hi = 13;
  hipLaunchKernelGGL(mega, dim3(grid), dim3(NWAVES * 64), LDS_BYTES, stream, a);
#else
  for (int ph = 0; ph < 13; ++ph) { a.ph_lo = ph; a.ph_hi = ph + 1; hipLaunchKernelGGL(mega, dim3(grid), dim3(NWAVES * 64), LDS_BYTES, stream, a); }
#endif
}
```
